# Optimizing an MI355X kernel written in HIP

```python
import math
import jax, jax.numpy as jnp
from jax import lax
import numpy as np

D_MODEL = 1024
BATCH = 8
SEQ = 4096
DEPTH = 1

PLE_DIM = 256
D_FF = 2816
EPS = 1e-6
SSM_WIDTH = 512
SSM_GROUP = 16
SSM_GROUPS = SSM_WIDTH // SSM_GROUP
SSM_STATE = 64
DT_MIN = 1e-3
DT_MAX = 1e-1
MLA_HEADS = 8
MLA_NOPE = 64
MLA_ROPE = 32
MLA_QK = MLA_NOPE + MLA_ROPE
MLA_V = 64
MLA_WIDTH = MLA_HEADS * MLA_V
Q_LORA = 384
KV_LORA = 256
ROPE_THETA = 10000.0
Q_BLOCK = 128
MIX_WIDTH = SSM_WIDTH + MLA_WIDTH
IN_WIDTH = SSM_WIDTH + Q_LORA + KV_LORA + MLA_ROPE
SPLITS = (SSM_WIDTH, SSM_WIDTH + Q_LORA, SSM_WIDTH + Q_LORA + KV_LORA)

kernel_name = 's5_mla_hymba_macaron'


def rms_norm(x, g):
    xf = x.astype(jnp.float32)
    y = xf * lax.rsqrt(jnp.mean(xf * xf, axis=-1, keepdims=True) + EPS)
    return (y * g.astype(jnp.float32)).astype(x.dtype)


def swiglu(x, w_gate, w_up, w_down):
    return (jax.nn.silu(x @ w_gate) * (x @ w_up)) @ w_down


def apply_rope(x, positions):
    half = x.shape[-1] // 2
    inv = ROPE_THETA ** (-jnp.arange(half, dtype=jnp.float32) / half)
    ang = positions.astype(jnp.float32)[..., None] * inv
    cos = jnp.cos(ang)[:, :, None, :]
    sin = jnp.sin(ang)[:, :, None, :]
    xf = x.astype(jnp.float32)
    x1, x2 = xf[..., :half], xf[..., half:]
    out = jnp.concatenate([x1 * cos - x2 * sin, x1 * sin + x2 * cos], axis=-1)
    return out.astype(x.dtype)


def s5_mixer(u, lam_re, lam_im, log_dt, b_re, b_im, c_re, c_im, d_skip, w_glu, b_glu):
    bsz, seq, _ = u.shape
    uf = u.astype(jnp.float32).reshape(bsz, seq, SSM_GROUPS, SSM_GROUP)
    dt = jnp.exp(log_dt.astype(jnp.float32))[:, None]
    lam = lax.complex(lam_re.astype(jnp.float32), lam_im.astype(jnp.float32))
    lam_bar = jnp.exp(lam * dt)
    coef = (lam_bar - 1.0) / lam
    b = lax.complex(b_re.astype(jnp.float32), b_im.astype(jnp.float32))
    b_bar = coef[..., None] * b
    bu = lax.complex(jnp.einsum('blgh,gph->blgp', uf, b_bar.real),
                     jnp.einsum('blgh,gph->blgp', uf, b_bar.imag))
    a = jnp.broadcast_to(lam_bar, (1, seq, SSM_GROUPS, SSM_STATE))

    def combine(e1, e2):
        a1, s1 = e1
        a2, s2 = e2
        return a2 * a1, a2 * s1 + s2

    _, states = lax.associative_scan(combine, (a, bu), axis=1)
    y = (jnp.einsum('blgp,ghp->blgh', states.real, c_re.astype(jnp.float32))
         - jnp.einsum('blgp,ghp->blgh', states.imag, c_im.astype(jnp.float32)))
    y = y + d_skip.astype(jnp.float32).reshape(SSM_GROUPS, SSM_GROUP) * uf
    y = jax.nn.gelu(y.reshape(bsz, seq, SSM_WIDTH))
    y = y * jax.nn.sigmoid(y @ w_glu.astype(jnp.float32) + b_glu.astype(jnp.float32))
    return y.astype(u.dtype)


def causal_attention(q, k, v):
    bsz, seq, heads, dqk = q.shape
    scale = dqk ** -0.5
    nb = seq // Q_BLOCK
    qb = q.reshape(bsz, nb, Q_BLOCK, heads, dqk).swapaxes(0, 1)
    starts = jnp.arange(nb, dtype=jnp.int32) * Q_BLOCK
    kpos = jnp.arange(seq, dtype=jnp.int32)
    qoff = jnp.arange(Q_BLOCK, dtype=jnp.int32)

    def one_block(args):
        qi, s0 = args
        s = jnp.einsum('bqhd,bkhd->bhqk', qi, k).astype(jnp.float32) * scale
        mask = (s0 + qoff)[:, None] >= kpos[None, :]
        s = jnp.where(mask[None, None], s, -jnp.inf)
        pr = jax.nn.softmax(s, axis=-1).astype(v.dtype)
        return jnp.einsum('bhqk,bkhd->bqhd', pr, v)

    o = lax.map(one_block, (qb, starts))
    return o.swapaxes(0, 1).reshape(bsz, seq, heads * v.shape[-1])


def mla_mixer(c_q, c_kv, k_pe, positions, q_norm, w_uq, kv_norm, w_ukv, qk_norm_q, qk_norm_k):
    bsz, seq, _ = c_q.shape
    q = (rms_norm(c_q, q_norm) @ w_uq).reshape(bsz, seq, MLA_HEADS, MLA_QK)
    kv = (rms_norm(c_kv, kv_norm) @ w_ukv).reshape(bsz, seq, MLA_HEADS, MLA_NOPE + MLA_V)
    k_nope, v = kv[..., :MLA_NOPE], kv[..., MLA_NOPE:]
    k_rope = jnp.broadcast_to(k_pe[:, :, None, :], (bsz, seq, MLA_HEADS, MLA_ROPE))
    k = jnp.concatenate([k_nope, k_rope], axis=-1)
    q = rms_norm(q, qk_norm_q)
    k = rms_norm(k, qk_norm_k)
    q = jnp.concatenate([q[..., :MLA_NOPE], apply_rope(q[..., MLA_NOPE:], positions)], axis=-1)
    k = jnp.concatenate([k[..., :MLA_NOPE], apply_rope(k[..., MLA_NOPE:], positions)], axis=-1)
    return causal_attention(q, k, v)


def setup_inputs(seed: int = 0) -> dict:
    key = jax.random.key(seed)
    ks = iter(jax.random.split(key, 48))

    def nrm(shape, scale):
        return jax.random.normal(next(ks), shape, jnp.float32) * scale

    def gain(dim):
        return 1.0 + nrm((DEPTH, dim), 0.02)

    L = DEPTH
    x = nrm((BATCH, SEQ, D_MODEL), 1.0)
    p = nrm((DEPTH, BATCH, SEQ, PLE_DIM), 1.0)
    positions = (jnp.arange(SEQ, dtype=jnp.int32)[None, :]
                 + jax.random.randint(next(ks), (BATCH, 1), 0, 512, dtype=jnp.int32))
    lam_re = -0.5 * (1.0 + nrm((L, SSM_GROUPS, SSM_STATE), 0.02))
    lam_im = jnp.broadcast_to(math.pi * jnp.arange(SSM_STATE, dtype=jnp.float32),
                              (L, SSM_GROUPS, SSM_STATE))
    log_dt = jax.random.uniform(next(ks), (L, SSM_GROUPS), jnp.float32,
                                math.log(DT_MIN), math.log(DT_MAX))
    return {
        'x': x, 'p': p, 'positions': positions,
        'norm_ffn1': gain(D_MODEL),
        'ffn1_w_gate': nrm((L, D_MODEL, D_FF), D_MODEL ** -0.5),
        'ffn1_w_up': nrm((L, D_MODEL, D_FF), D_MODEL ** -0.5),
        'ffn1_w_down': nrm((L, D_FF, D_MODEL), D_FF ** -0.5),
        'norm_mix': gain(D_MODEL),
        'w_in': nrm((L, D_MODEL, IN_WIDTH), D_MODEL ** -0.5),
        'ssm_lam_re': lam_re,
        'ssm_lam_im': lam_im,
        'ssm_log_dt': log_dt,
        'ssm_b_re': nrm((L, SSM_GROUPS, SSM_STATE, SSM_GROUP), (2 * SSM_GROUP) ** -0.5),
        'ssm_b_im': nrm((L, SSM_GROUPS, SSM_STATE, SSM_GROUP), (2 * SSM_GROUP) ** -0.5),
        'ssm_c_re': nrm((L, SSM_GROUPS, SSM_GROUP, SSM_STATE), (2 * SSM_STATE) ** -0.5),
        'ssm_c_im': nrm((L, SSM_GROUPS, SSM_GROUP, SSM_STATE), (2 * SSM_STATE) ** -0.5),
        'ssm_d': nrm((L, SSM_WIDTH), 1.0),
        'ssm_w_glu': nrm((L, SSM_WIDTH, SSM_WIDTH), SSM_WIDTH ** -0.5),
        'ssm_b_glu': nrm((L, SSM_WIDTH), 0.01),
        'mla_q_norm': gain(Q_LORA),
        'mla_w_uq': nrm((L, Q_LORA, MLA_HEADS * MLA_QK), Q_LORA ** -0.5),
        'mla_kv_norm': gain(KV_LORA),
        'mla_w_ukv': nrm((L, KV_LORA, MLA_HEADS * (MLA_NOPE + MLA_V)), KV_LORA ** -0.5),
        'mla_qk_norm_q': gain(MLA_QK),
        'mla_qk_norm_k': gain(MLA_QK),
        'out_norm_ssm': gain(SSM_WIDTH),
        'out_norm_attn': gain(MLA_WIDTH),
        'w_out': nrm((L, MIX_WIDTH, D_MODEL), MIX_WIDTH ** -0.5),
        'norm_ffn2': gain(D_MODEL),
        'ffn2_w_gate': nrm((L, D_MODEL, D_FF), D_MODEL ** -0.5),
        'ffn2_w_up': nrm((L, D_MODEL, D_FF), D_MODEL ** -0.5),
        'ffn2_w_down': nrm((L, D_FF, D_MODEL), D_FF ** -0.5),
        'norm_ple': gain(D_MODEL),
        'ple_w_gate': nrm((L, D_MODEL, D_MODEL), D_MODEL ** -0.5),
        'ple_w_proj': nrm((L, PLE_DIM, D_MODEL), PLE_DIM ** -0.5),
    }


def reference(x, p, positions, norm_ffn1, ffn1_w_gate, ffn1_w_up, ffn1_w_down,
              norm_mix, w_in, ssm_lam_re, ssm_lam_im, ssm_log_dt, ssm_b_re, ssm_b_im,
              ssm_c_re, ssm_c_im, ssm_d, ssm_w_glu, ssm_b_glu,
              mla_q_norm, mla_w_uq, mla_kv_norm, mla_w_ukv, mla_qk_norm_q, mla_qk_norm_k,
              out_norm_ssm, out_norm_attn, w_out,
              norm_ffn2, ffn2_w_gate, ffn2_w_up, ffn2_w_down,
              norm_ple, ple_w_gate, ple_w_proj):
    h = x
    for i in range(DEPTH):
        h = h + 0.5 * swiglu(rms_norm(h, norm_ffn1[i]), ffn1_w_gate[i], ffn1_w_up[i], ffn1_w_down[i])
        n = rms_norm(h, norm_mix[i])
        z = n @ w_in[i]
        u, c_q, c_kv, k_pe = jnp.split(z, SPLITS, axis=-1)
        y_ssm = s5_mixer(u, ssm_lam_re[i], ssm_lam_im[i], ssm_log_dt[i], ssm_b_re[i], ssm_b_im[i],
                         ssm_c_re[i], ssm_c_im[i], ssm_d[i], ssm_w_glu[i], ssm_b_glu[i])
        y_att = mla_mixer(c_q, c_kv, k_pe, positions, mla_q_norm[i], mla_w_uq[i],
                          mla_kv_norm[i], mla_w_ukv[i], mla_qk_norm_q[i], mla_qk_norm_k[i])
        y = jnp.concatenate([rms_norm(y_ssm, out_norm_ssm[i]),
                             rms_norm(y_att, out_norm_attn[i])], axis=-1)
        h = h + y @ w_out[i]
        h = h + 0.5 * swiglu(rms_norm(h, norm_ffn2[i]), ffn2_w_gate[i], ffn2_w_up[i], ffn2_w_down[i])
        gate = jax.nn.sigmoid(rms_norm(h, norm_ple[i]) @ ple_w_gate[i])
        h = h + gate * (p[i] @ ple_w_proj[i])
    return h.astype(x.dtype)
```

```cpp
#include <hip/hip_runtime.h>
#include <hip/hip_cooperative_groups.h>
#include <cstdint>
#include <cstdio>
namespace cg = cooperative_groups;

typedef unsigned short bf16_t;
typedef short bf16x8 __attribute__((ext_vector_type(8)));
typedef float f32x4 __attribute__((ext_vector_type(4)));
typedef float f32x16 __attribute__((ext_vector_type(16)));
typedef unsigned u32x2 __attribute__((ext_vector_type(2)));
typedef unsigned u32x4 __attribute__((ext_vector_type(4)));

#ifndef MK_MULTI
#define MK_MULTI 0
#endif
#ifndef PROBE_MASK
#define PROBE_MASK 0
#endif
#ifndef PROBE_SEL
#define PROBE_SEL 0
#endif

constexpr int M_TOK = 32768, DM = 1024, DFF = 2816, SEQ = 4096;
constexpr int BM = 256, BK = 64, HALF = 128, HT = HALF * BK, SHM_B = 8 * HT * 2;
constexpr float EPS = 1e-6f;

constexpr size_t SZ_SS = (size_t)48 * M_TOK * 4;
constexpr size_t OFF_SS = 0;
constexpr size_t OFF_W1 = OFF_SS + SZ_SS;
constexpr size_t OFF_WD1 = OFF_W1 + (size_t)5632 * 1024 * 2;
constexpr size_t OFF_W2 = OFF_WD1 + (size_t)1024 * 2816 * 2;
constexpr size_t OFF_WD2 = OFF_W2 + (size_t)5632 * 1024 * 2;
constexpr size_t OFF_WIN = OFF_WD2 + (size_t)1024 * 2816 * 2;
constexpr size_t OFF_WUQ = OFF_WIN + (size_t)1280 * 1024 * 2;
constexpr size_t OFF_WUKV = OFF_WUQ + (size_t)768 * 384 * 2;
constexpr size_t OFF_WGLU = OFF_WUKV + (size_t)1024 * 256 * 2;
constexpr size_t OFF_WOUT = OFF_WGLU + (size_t)512 * 512 * 2;
constexpr size_t OFF_WPG = OFF_WOUT + (size_t)1024 * 1024 * 2;
constexpr size_t OFF_WPP = OFF_WPG + (size_t)1024 * 1024 * 2;
constexpr size_t OFF_TAB = OFF_WPP + (size_t)1024 * 256 * 2;
constexpr size_t OFF_KTAB = OFF_TAB + (size_t)M_TOK * 32 * 4;
constexpr size_t OFF_PB = OFF_KTAB + (size_t)32 * 32 * 256 * 4;
constexpr size_t OFF_HB = OFF_PB + (size_t)M_TOK * 256 * 2;
constexpr size_t OFF_HBUF = OFF_HB + (size_t)M_TOK * 1024 * 2;
constexpr size_t OFF_S5 = OFF_HBUF + (size_t)M_TOK * 1024 * 4;
constexpr size_t OFF_MQ = OFF_S5;
constexpr size_t OFF_PM = OFF_MQ + (size_t)32 * 512 * 640 * 2;
constexpr size_t OFF_A2 = OFF_PM + (size_t)32 * 256 * 512 * 2;
constexpr size_t OFF_PP = OFF_HBUF + (size_t)64 * 1024 * 1024;
constexpr size_t OFF_ACT = OFF_A2 + (size_t)32 * 1024 * 640 * 2;
constexpr size_t OFF_CQB = OFF_ACT;
constexpr size_t OFF_CKVB = OFF_CQB + (size_t)M_TOK * 384 * 2;
constexpr size_t OFF_KPE = OFF_CKVB + (size_t)M_TOK * 256 * 2;
constexpr size_t OFF_QRAW = OFF_KPE + (size_t)M_TOK * 32 * 4;
constexpr size_t OFF_KVRAW = OFF_QRAW + (size_t)M_TOK * 768 * 2;
constexpr size_t OFF_E = OFF_KVRAW + (size_t)M_TOK * 1024 * 2;
constexpr size_t OFF_ACT_END = OFF_E + (size_t)32 * 1024 * 128 * 4;
constexpr size_t WS_END = OFF_ACT + (size_t)M_TOK * 2816 * 2;
static_assert(OFF_ACT_END <= WS_END, "act region overflow");
static_assert(OFF_PP + (size_t)M_TOK * 1024 * 2 <= OFF_S5, "pp overflow");
constexpr size_t OFF_BAR = WS_END;
static_assert(OFF_BAR + 16384 <= (size_t)536870912, "workspace too large");

struct Params {
    const float *x, *p; const int* pos;
    const float *norm_ffn1, *w1g, *w1u, *w1d, *norm_mix, *w_in, *lam_re, *lam_im, *log_dt, *b_re, *b_im, *c_re, *c_im, *ssm_d, *w_glu, *b_glu,
        *q_norm, *w_uq, *kv_norm, *w_ukv, *qkn_q, *qkn_k, *on_ssm, *on_att, *w_out, *norm_ffn2, *w2g, *w2u, *w2d, *norm_ple, *w_pg, *w_pp;
    float* out; char* ws;
    int ph_lo, ph_hi; long atom_off;
};

extern __shared__ __attribute__((aligned(16))) bf16_t shm[];
#ifndef PROBE_PH
#define PROBE_PH -1
#endif
#if PROBE_PH >= 0
__shared__ long s_aoff;
#define ATOM_OFF s_aoff
#else
#define ATOM_OFF 0
#endif

__device__ __forceinline__ unsigned pk_bf16(float lo, float hi) { unsigned r; asm volatile("v_cvt_pk_bf16_f32 %0, %1, %2" : "=v"(r) : "v"(lo), "v"(hi)); return r; }
__device__ __forceinline__ float bf_lo(unsigned u) { return __uint_as_float(u << 16); }
__device__ __forceinline__ float bf_hi(unsigned u) { return __uint_as_float(u & 0xffff0000u); }
__device__ __forceinline__ float sigmoidf_(float v) { return __builtin_amdgcn_rcpf(1.f + __expf(-v)); }
__device__ __forceinline__ void cisf(float ang, float& c, float& s) { float r = ang * 0.15915494309189535f; r -= floorf(r); c = __builtin_amdgcn_cosf(r); s = __builtin_amdgcn_sinf(r); }

__device__ __forceinline__ int lds_byte(int r, int c) { int st = (r >> 4) * 2 + (c >> 5), rr = r & 15, cc = c & 31, ob = rr * 64 + cc * 2; return st * 1024 + (ob ^ (((ob >> 9) & 1) << 5)); }
__device__ __forceinline__ void stage_rc(int b, int& R, int& C) { int st = b / 1024, sb = b % 1024, swz = sb ^ (((sb >> 9) & 1) << 5); R = (st >> 1) * 16 + swz / 64; C = (st & 1) * 32 + (swz % 64) / 2; }

#define LAS __attribute__((address_space(3)))
constexpr int HTB = HT * 2;
#define SA(b, h) (((b) * 2 + (h)) * HTB)
#define SB(b, h) ((4 + (b) * 2 + (h)) * HTB)
#define STAGE(bufoff, gbase, voff) do { _Pragma("unroll") for (int _i = 0; _i < 2; ++_i) \
    __builtin_amdgcn_global_load_lds((const unsigned*)((const char*)(gbase) + (voff)[_i]), (LAS unsigned*)(lds + (bufoff) + ldsw + _i * 8192), 16, 0, 0); } while (0)
#define LDA(dst, b, h) do { _Pragma("unroll") for (int m = 0; m < 4; ++m) _Pragma("unroll") for (int k = 0; k < 2; ++k) dst[m][k] = *(const LAS bf16x8*)(lds + SA(b, h) + aoff + m * 2048 + k * 1024); } while (0)
#define LDB(dst, b, h) do { _Pragma("unroll") for (int n = 0; n < 2; ++n) _Pragma("unroll") for (int k = 0; k < 2; ++k) dst[n][k] = *(const LAS bf16x8*)(lds + SB(b, h) + boff + n * 2048 + k * 1024); } while (0)
#define MMA(ai, bj, At_, Bt_) do { __builtin_amdgcn_s_setprio(1); _Pragma("unroll") for (int m = 0; m < 4; ++m) _Pragma("unroll") for (int n = 0; n < 2; ++n) _Pragma("unroll") for (int k = 0; k < 2; ++k) \
      acc[ai][bj][m][n] = __builtin_amdgcn_mfma_f32_16x16x32_bf16(Bt_[n][k], At_[m][k], acc[ai][bj][m][n], 0, 0, 0); \
    __builtin_amdgcn_s_setprio(0); } while (0)
#define WAIT_V(n) asm volatile("s_waitcnt vmcnt(" #n ")" ::: "memory")
#define WAIT_L(n) asm volatile("s_waitcnt lgkmcnt(" #n ")" ::: "memory")
#define BAR __builtin_amdgcn_s_barrier()
#define SCHED __builtin_amdgcn_sched_barrier(0)

__device__ __forceinline__ void gemm_pre(const char* cA, int lda, const char* cB, int ldb) {
    LAS unsigned char* lds = (LAS unsigned char*)shm;
    int tid = threadIdx.x; asm volatile("" : "+v"(tid));
    const int wid = __builtin_amdgcn_readfirstlane(tid >> 6);
    unsigned voffA[2], voffB[2];
#pragma unroll
    for (int i = 0; i < 2; ++i) { int R, C; stage_rc(tid * 16 + i * 8192, R, C); const int rho = R & 31, Rb = (R & ~31) + 8 * ((rho & 15) >> 2) + 4 * (rho >> 4) + (rho & 3);
        voffA[i] = (unsigned)(R * lda + C) * 2u; voffB[i] = (unsigned)(Rb * ldb + C) * 2u; }
    const size_t hA = (size_t)HALF * lda * 2, hB = (size_t)HALF * ldb * 2;
    const unsigned ldsw = (unsigned)wid * 1024u;
    STAGE(SB(0, 0), cB, voffB); STAGE(SA(0, 0), cA, voffA); STAGE(SB(0, 1), cB + hB, voffB); STAGE(SA(0, 1), cA + hA, voffA);
}
__device__ __forceinline__ void gemm_loop(f32x4 (&acc)[2][2][4][2], const char* cA, int lda, const char* cB, int ldb, int nt, bool pre) {
    LAS unsigned char* lds = (LAS unsigned char*)shm;
    int tid = threadIdx.x; asm volatile("" : "+v"(tid));
    const int wid = __builtin_amdgcn_readfirstlane(tid >> 6), lane = tid & 63, wr = wid >> 2, wc = wid & 3, fr = lane & 15, fq = lane >> 4;
    unsigned voffA[2], voffB[2];
#pragma unroll
    for (int i = 0; i < 2; ++i) { int R, C; stage_rc(tid * 16 + i * 8192, R, C); const int rho = R & 31, Rb = (R & ~31) + 8 * ((rho & 15) >> 2) + 4 * (rho >> 4) + (rho & 3);
        voffA[i] = (unsigned)(R * lda + C) * 2u; voffB[i] = (unsigned)(Rb * ldb + C) * 2u; }
    const size_t hA = (size_t)HALF * lda * 2, hB = (size_t)HALF * ldb * 2, kstep = BK * 2;
    const unsigned ldsw = (unsigned)wid * 1024u;
    const int aoff = lds_byte(wr * 64 + fr, fq * 8), boff = lds_byte(wc * 32 + fr, fq * 8);
    bf16x8 At[4][2], B0[2][2], B1[2][2];
    if (!pre) { STAGE(SB(0, 0), cB, voffB); STAGE(SA(0, 0), cA, voffA); STAGE(SB(0, 1), cB + hB, voffB); STAGE(SA(0, 1), cA + hA, voffA); }
    if (wr == 1) BAR;
    WAIT_V(4); BAR;
    STAGE(SB(1, 0), cB + kstep, voffB); STAGE(SA(1, 0), cA + kstep, voffA); STAGE(SB(1, 1), cB + hB + kstep, voffB);
    WAIT_V(6); BAR;
    for (int t = 0; t < nt - 2; t += 2) {
        const char* a1 = cA + (size_t)(t + 1) * kstep; const char* a2 = a1 + kstep; const char* a3 = a2 + kstep;
        const char* b2 = cB + (size_t)(t + 2) * kstep; const char* b3 = b2 + kstep;
        LDB(B0, 0, 0); SCHED; LDA(At, 0, 0); STAGE(SA(1, 1), a1 + hA, voffA);
        WAIT_L(8); BAR; WAIT_L(0); MMA(0, 0, At, B0); BAR; SCHED;
        LDB(B1, 0, 1); STAGE(SB(0, 0), b2, voffB);
        BAR; WAIT_L(0); MMA(0, 1, At, B1); BAR;
        LDA(At, 0, 1); STAGE(SA(0, 0), a2, voffA);
        BAR; WAIT_L(0); MMA(1, 0, At, B0); BAR; SCHED;
        STAGE(SB(0, 1), b2 + hB, voffB);
        WAIT_V(6); BAR; MMA(1, 1, At, B1); BAR;
        LDB(B0, 1, 0); SCHED; LDA(At, 1, 0); STAGE(SA(0, 1), a2 + hA, voffA);
        WAIT_L(8); BAR; WAIT_L(0); MMA(0, 0, At, B0); BAR; SCHED;
        LDB(B1, 1, 1); STAGE(SB(1, 0), b3, voffB);
        BAR; WAIT_L(0); MMA(0, 1, At, B1); BAR;
        LDA(At, 1, 1); STAGE(SA(1, 0), a3, voffA);
        BAR; WAIT_L(0); MMA(1, 0, At, B0); BAR; SCHED;
        STAGE(SB(1, 1), b3 + hB, voffB);
        WAIT_V(6); BAR; MMA(1, 1, At, B1); BAR;
    }
    { const char* a1 = cA + (size_t)(nt - 1) * kstep;
      LDB(B0, 0, 0); LDA(At, 0, 0); STAGE(SA(1, 1), a1 + hA, voffA);
      BAR; WAIT_L(0); MMA(0, 0, At, B0); BAR;
      LDB(B1, 0, 1); BAR; WAIT_L(0); MMA(0, 1, At, B1); BAR;
      LDA(At, 0, 1); WAIT_V(4); BAR; WAIT_L(0); MMA(1, 0, At, B0); MMA(1, 1, At, B1); BAR; }
    { LDB(B0, 1, 0); LDA(At, 1, 0); WAIT_V(2); BAR; WAIT_L(0); MMA(0, 0, At, B0); BAR;
      LDB(B1, 1, 1); WAIT_V(0); BAR; WAIT_L(0); MMA(0, 1, At, B1); BAR;
      LDA(At, 1, 1); BAR; WAIT_L(0); MMA(1, 0, At, B0); MMA(1, 1, At, B1); BAR; }
    if (wr == 0) BAR;
}

__device__ __forceinline__ void tile_map(int L, int nM, int nN, int& pm, int& pn) {
    const int nwg = nM * nN, q = nwg / 8, r = nwg % 8, xcd = L % 8, off = L / 8;
    const int wgid = (xcd < r ? xcd * (q + 1) : r * (q + 1) + (xcd - r) * q) + off;
    const int nig = 8 * nN, gid = wgid / nig, fm = gid * 8, gsz = (nM - fm) < 8 ? (nM - fm) : 8;
    pm = fm + ((wgid % nig) % gsz); pn = (wgid % nig) / gsz;
}

__device__ __forceinline__ void ld8(const bf16_t* p, float (&v)[8]) { const u32x4 w = *(const u32x4*)p;
    v[0] = bf_lo(w.x); v[1] = bf_hi(w.x); v[2] = bf_lo(w.y); v[3] = bf_hi(w.y); v[4] = bf_lo(w.z); v[5] = bf_hi(w.z); v[6] = bf_lo(w.w); v[7] = bf_hi(w.w); }
__device__ __forceinline__ void ld8f(const float* p, float (&v)[8]) { const f32x4 a = *(const f32x4*)p, b = *(const f32x4*)(p + 4);
    v[0] = a[0]; v[1] = a[1]; v[2] = a[2]; v[3] = a[3]; v[4] = b[0]; v[5] = b[1]; v[6] = b[2]; v[7] = b[3]; }
__device__ __forceinline__ void st8(bf16_t* p, const float (&v)[8]) { u32x4 w; w.x = pk_bf16(v[0], v[1]); w.y = pk_bf16(v[2], v[3]); w.z = pk_bf16(v[4], v[5]); w.w = pk_bf16(v[6], v[7]); *(u32x4*)p = w; }
__device__ __forceinline__ float sq8(const float (&v)[8]) { float s = 0.f;
#pragma unroll
    for (int i = 0; i < 8; ++i) s += v[i] * v[i]; return s; }


enum { E_SWIGLU = 0, E_DOWN, E_WIN, E_QRAW, E_KVRAW, E_S5E, E_S5Y, E_GLU, E_WOUT, E_PP, E_PLE };

#define WSP(T, off) ((T*)(P.ws + (off)))

__device__ __forceinline__ void store_bf4(bf16_t* p, f32x4 v) { u32x2 w; w.x = pk_bf16(v[0], v[1]); w.y = pk_bf16(v[2], v[3]); *(u32x2*)p = w; }

template <int MODE> __device__ __forceinline__ void epilogue(const f32x4 (&acc)[2][2][4][2], const Params& P, int brow, int bcol, int aux) {
    int tid_ = threadIdx.x; asm volatile("" : "+v"(tid_));
    const int wid = tid_ >> 6, lane = tid_ & 63, wr = wid >> 2, wc = wid & 3, fr = lane & 15, fq = lane >> 4;
    float* ss = WSP(float, OFF_SS);
#pragma unroll
    for (int ai = 0; ai < 2; ++ai)
#pragma unroll
        for (int m = 0; m < 4; ++m) {
            const int row = brow + ai * HALF + wr * 64 + m * 16 + fr;
            if constexpr (MODE == E_SWIGLU) {
                const float rs = rsqrtf(ss[(aux ? 2 : 0) * M_TOK + row] * (1.f / 1024.f) + EPS);
                bf16_t* act = WSP(bf16_t, OFF_ACT);
                float o[8];
#pragma unroll
                for (int n = 0; n < 2; ++n) {
                    const f32x4 g = acc[ai][0][m][n] * rs, u = acc[ai][1][m][n] * rs;
#pragma unroll
                    for (int j = 0; j < 4; ++j) o[n * 4 + j] = g[j] * sigmoidf_(g[j]) * u[j];
                }
                st8(act + (long)row * DFF + (bcol >> 1) + wc * 32 + fq * 8, o);
            } else if constexpr (MODE == E_DOWN || MODE == E_WOUT) {
                bf16_t* hb = WSP(bf16_t, OFF_HB);
                float sc = 0.5f; int ssi = aux ? 3 : 1;
                if constexpr (MODE == E_WOUT) { sc = rsqrtf(ss[7 * M_TOK + row] * (1.f / 512.f) + EPS); ssi = 2; }
                float sq = 0.f;
                if constexpr (MODE == E_DOWN || MODE == E_WOUT) {
                    u32x4 rr8[2];
#pragma unroll
                    for (int bj = 0; bj < 2; ++bj) rr8[bj] = *(const u32x4*)(hb + (long)row * DM + bcol + bj * HALF + wc * 32 + fq * 8);
#pragma unroll
                    for (int bj = 0; bj < 2; ++bj) {
                        const f32x4 r0 = {bf_lo(rr8[bj].x), bf_hi(rr8[bj].x), bf_lo(rr8[bj].y), bf_hi(rr8[bj].y)}, r1 = {bf_lo(rr8[bj].z), bf_hi(rr8[bj].z), bf_lo(rr8[bj].w), bf_hi(rr8[bj].w)};
                        const f32x4 v0 = r0 + acc[ai][bj][m][0] * sc, v1 = r1 + acc[ai][bj][m][1] * sc;
                        u32x4 w; w.x = pk_bf16(v0[0], v0[1]); w.y = pk_bf16(v0[2], v0[3]); w.z = pk_bf16(v1[0], v1[1]); w.w = pk_bf16(v1[2], v1[3]);
                        *(u32x4*)(hb + (long)row * DM + bcol + bj * HALF + wc * 32 + fq * 8) = w;
                        sq += v0[0] * v0[0] + v0[1] * v0[1] + v0[2] * v0[2] + v0[3] * v0[3] + v1[0] * v1[0] + v1[1] * v1[1] + v1[2] * v1[2] + v1[3] * v1[3];
                    }
                } else {
                u32x2 rr[2][2];
#pragma unroll
                for (int bj = 0; bj < 2; ++bj)
#pragma unroll
                    for (int n = 0; n < 2; ++n) rr[bj][n] = *(const u32x2*)(hb + (long)row * DM + bcol + bj * HALF + wc * 32 + n * 16 + fq * 4);
#pragma unroll
                for (int bj = 0; bj < 2; ++bj)
#pragma unroll
                    for (int n = 0; n < 2; ++n) {
                        const int col = bcol + bj * HALF + wc * 32 + n * 16 + fq * 4;
                        const f32x4 r = {bf_lo(rr[bj][n].x), bf_hi(rr[bj][n].x), bf_lo(rr[bj][n].y), bf_hi(rr[bj][n].y)};
                        const f32x4 v = r + acc[ai][bj][m][n] * sc;
                        store_bf4(hb + (long)row * DM + col, v);
                        sq += v[0] * v[0] + v[1] * v[1] + v[2] * v[2] + v[3] * v[3];
                    }
                }
                sq += __shfl_xor(sq, 16); sq += __shfl_xor(sq, 32);
                if (fq == 0) unsafeAtomicAdd(ss + ATOM_OFF + ssi * M_TOK + row, sq);
            } else if constexpr (MODE == E_WIN) {
                const float rs = rsqrtf(ss[1 * M_TOK + row] * (1.f / 1024.f) + EPS);
#pragma unroll
                for (int bj = 0; bj < 2; ++bj) {
                    const int seg = (bcol >> 7) + bj;
                    const int col0 = bcol + bj * HALF + wc * 32 + fq * 8;
                    const f32x4 v0 = acc[ai][bj][m][0] * rs, v1 = acc[ai][bj][m][1] * rs;
                    u32x4 w; w.x = pk_bf16(v0[0], v0[1]); w.y = pk_bf16(v0[2], v0[3]); w.z = pk_bf16(v1[0], v1[1]); w.w = pk_bf16(v1[2], v1[3]);
                    float sq = v0[0] * v0[0] + v0[1] * v0[1] + v0[2] * v0[2] + v0[3] * v0[3] + v1[0] * v1[0] + v1[1] * v1[1] + v1[2] * v1[2] + v1[3] * v1[3];
                    if (seg < 4) {
                        const int g = col0 >> 4, hi = col0 & 15;
                        *(u32x4*)(WSP(bf16_t, OFF_A2) + ((long)g * 1024 + (row >> 5)) * 640 + (row & 31) * 16 + hi) = w;
                    } else if (seg < 7) {
                        *(u32x4*)(WSP(bf16_t, OFF_CQB) + (long)row * 384 + (col0 - 512)) = w;
                    } else if (seg < 9) {
                        *(u32x4*)(WSP(bf16_t, OFF_CKVB) + (long)row * 256 + (col0 - 896)) = w;
                    } else if (wc == 0) {
                        float mine[8] = {v0[0], v0[1], v0[2], v0[3], v1[0], v1[1], v1[2], v1[3]}, oth[8];
#pragma unroll
                        for (int i = 0; i < 8; ++i) oth[i] = __shfl_xor(mine[i], 32);
                        float q2 = sq; q2 += __shfl_xor(q2, 16); q2 += __shfl_xor(q2, 32);
                        if (fq == 0) ss[8 * M_TOK + row] = q2;
                        const int ib = (fq & 1) * 8;
                        float cs[8], sn[8], g1[8], g2[8], o[8];
                        ld8f(WSP(float, OFF_TAB) + (long)row * 32 + ib, cs); ld8f(WSP(float, OFF_TAB) + (long)row * 32 + 16 + ib, sn);
                        ld8f(P.qkn_k + 64 + ib, g1); ld8f(P.qkn_k + 80 + ib, g2);
#pragma unroll
                        for (int i = 0; i < 8; ++i) { const float x1 = (fq < 2 ? mine[i] : oth[i]) * g1[i], x2 = (fq < 2 ? oth[i] : mine[i]) * g2[i];
                            o[i] = fq < 2 ? (x1 * cs[i] - x2 * sn[i]) : (x1 * sn[i] + x2 * cs[i]); }
                        st8(WSP(bf16_t, OFF_KPE) + (long)row * 32 + (fq < 2 ? 0 : 16) + ib, o);
                    }
                    if (seg >= 4 && seg < 9) {
                        sq += __shfl_xor(sq, 16); sq += __shfl_xor(sq, 32);
                        if (fq == 0) unsafeAtomicAdd(ss + ATOM_OFF + (seg < 7 ? 4 : 5) * M_TOK + row, sq);
                    }
                }
            } else if constexpr (MODE == E_QRAW || MODE == E_KVRAW) {
                const float rs = (MODE == E_QRAW) ? rsqrtf(ss[4 * M_TOK + row] * (1.f / 384.f) + EPS) : rsqrtf(ss[5 * M_TOK + row] * (1.f / 256.f) + EPS);
                bf16_t* o = (MODE == E_QRAW) ? WSP(bf16_t, OFF_QRAW) : WSP(bf16_t, OFF_KVRAW);
                const int ld = (MODE == E_QRAW) ? 768 : 1024;
#pragma unroll
                for (int bj = 0; bj < 2; ++bj) {
                    const f32x4 v0 = acc[ai][bj][m][0] * rs, v1 = acc[ai][bj][m][1] * rs;
                    u32x4 w; w.x = pk_bf16(v0[0], v0[1]); w.y = pk_bf16(v0[2], v0[3]); w.z = pk_bf16(v1[0], v1[1]); w.w = pk_bf16(v1[2], v1[3]);
                    *(u32x4*)(o + (long)row * ld + bcol + bj * HALF + wc * 32 + fq * 8) = w;
                }
            } else if constexpr (MODE == E_S5E) {
                float* E = WSP(float, OFF_E) + (long)aux * 1024 * 128 + (long)row * 128 + wc * 32 + fq * 8;
                *(f32x4*)E = acc[ai][0][m][0]; *(f32x4*)(E + 4) = acc[ai][0][m][1];
            } else if constexpr (MODE == E_S5Y) {
                bf16_t* yg = (bf16_t*)P.out + (long)M_TOK * 1024;
#pragma unroll
                for (int bj = 0; bj < 2; ++bj) {
                    const int col = bcol + bj * HALF + wc * 32 + fq * 8, t = col >> 4, ho = col & 15;
                    float o[8];
#pragma unroll
                    for (int j = 0; j < 4; ++j) { const float a = acc[ai][bj][m][0][j], b = acc[ai][bj][m][1][j];
                        o[j] = a * sigmoidf_(1.5957691216f * (a + 0.044715f * a * a * a)); o[4 + j] = b * sigmoidf_(1.5957691216f * (b + 0.044715f * b * b * b)); }
                    st8(yg + ((long)row * 32 + t) * 512 + aux * 16 + ho, o);
                }
            } else if constexpr (MODE == E_GLU) {
                const bf16_t* yg = (const bf16_t*)P.out + (long)M_TOK * 1024; bf16_t* ymix = (bf16_t*)P.out;
                float sq = 0.f;
#pragma unroll
                for (int bj = 0; bj < 2; ++bj) {
                    const int col = bcol + bj * HALF + wc * 32 + fq * 8;
                    float bb[8], yy[8], o[8];
                    ld8f(P.b_glu + col, bb); ld8(yg + (long)row * 512 + col, yy);
#pragma unroll
                    for (int j = 0; j < 4; ++j) { o[j] = yy[j] * sigmoidf_(acc[ai][bj][m][0][j] + bb[j]); o[4 + j] = yy[4 + j] * sigmoidf_(acc[ai][bj][m][1][j] + bb[4 + j]); }
                    st8(ymix + (long)row * 1024 + col, o);
                    sq += sq8(o);
                }
                sq += __shfl_xor(sq, 16); sq += __shfl_xor(sq, 32);
                if (fq == 0) unsafeAtomicAdd(ss + ATOM_OFF + 6 * M_TOK + row, sq);
            } else if constexpr (MODE == E_PP) {
                bf16_t* pp = WSP(bf16_t, OFF_PP);
#pragma unroll
                for (int bj = 0; bj < 2; ++bj) {
                    const f32x4 v0 = acc[ai][bj][m][0], v1 = acc[ai][bj][m][1];
                    u32x4 w; w.x = pk_bf16(v0[0], v0[1]); w.y = pk_bf16(v0[2], v0[3]); w.z = pk_bf16(v1[0], v1[1]); w.w = pk_bf16(v1[2], v1[3]);
                    *(u32x4*)(pp + (long)row * 1024 + bcol + bj * HALF + wc * 32 + fq * 8) = w;
                }
            } else if constexpr (MODE == E_PLE) {
                const float rs = rsqrtf(ss[3 * M_TOK + row] * (1.f / 1024.f) + EPS);
                const bf16_t* pp = WSP(bf16_t, OFF_PP); const bf16_t* hb = WSP(bf16_t, OFF_HB);
#pragma unroll
                for (int bj = 0; bj < 2; ++bj) {
                    const int col = bcol + bj * HALF + wc * 32 + fq * 8;
                    float h8[8], p8[8];
                    ld8(hb + (long)row * DM + col, h8); ld8(pp + (long)row * 1024 + col, p8);
                    f32x4 o0, o1;
#pragma unroll
                    for (int j = 0; j < 4; ++j) { o0[j] = h8[j] + sigmoidf_(acc[ai][bj][m][0][j] * rs) * p8[j]; o1[j] = h8[4 + j] + sigmoidf_(acc[ai][bj][m][1][j] * rs) * p8[4 + j]; }
                    *(f32x4*)(P.out + (long)row * DM + col) = o0; *(f32x4*)(P.out + (long)row * DM + col + 4) = o1;
                }
            }
        }
}

__device__ __forceinline__ void epilogue_kv(const f32x4 (&acc)[2][2][4][2], const Params& P, int brow, int bcol) {
    int tid_ = threadIdx.x; asm volatile("" : "+v"(tid_));
    const int wid = tid_ >> 6, lane = tid_ & 63, wr = wid >> 2, wc = wid & 3, fr = lane & 15, fq = lane >> 4;
    const float* ss = WSP(float, OFF_SS);
    float* exch = (float*)((char*)shm + 32768);
    if (wc < 2) {
#pragma unroll
        for (int ai = 0; ai < 2; ++ai)
#pragma unroll
            for (int m = 0; m < 4; ++m) {
                const int rl = ai * HALF + wr * 64 + m * 16 + fr;
                const float rs = rsqrtf(ss[5 * M_TOK + brow + rl] * (1.f / 256.f) + EPS);
#pragma unroll
                for (int bj = 0; bj < 2; ++bj) {
                    float sq = 0.f;
#pragma unroll
                    for (int n = 0; n < 2; ++n) { const f32x4 v = acc[ai][bj][m][n] * rs; sq += v[0] * v[0] + v[1] * v[1] + v[2] * v[2] + v[3] * v[3]; }
                    sq += __shfl_xor(sq, 16); sq += __shfl_xor(sq, 32);
                    if (fq == 0) exch[(rl * 2 + bj) * 2 + wc] = sq;
                }
            }
    }
    __syncthreads();
#pragma unroll
    for (int ai = 0; ai < 2; ++ai)
#pragma unroll
        for (int m = 0; m < 4; ++m) {
            const int rl = ai * HALF + wr * 64 + m * 16 + fr, row = brow + rl, b = row >> 12, l = row & 4095;
            const float rs = rsqrtf(ss[5 * M_TOK + row] * (1.f / 256.f) + EPS), pe = ss[8 * M_TOK + row];
#pragma unroll
            for (int bj = 0; bj < 2; ++bj) {
                const int h = (bcol >> 7) + bj;
                const float rk = rsqrtf((exch[(rl * 2 + bj) * 2] + exch[(rl * 2 + bj) * 2 + 1] + pe) * (1.f / 96.f) + EPS);
                bf16_t* kf = WSP(bf16_t, OFF_HBUF) + ((long)(b * 8 + h) * SEQ + l) * 96;
                if (wc < 2) {
                    const f32x4 v0 = acc[ai][bj][m][0] * (rs * rk), v1 = acc[ai][bj][m][1] * (rs * rk);
                    u32x4 w; w.x = pk_bf16(v0[0], v0[1]); w.y = pk_bf16(v0[2], v0[3]); w.z = pk_bf16(v1[0], v1[1]); w.w = pk_bf16(v1[2], v1[3]);
                    *(u32x4*)(kf + wc * 32 + fq * 8) = w;
                } else {
                    const f32x4 v0 = acc[ai][bj][m][0] * rs, v1 = acc[ai][bj][m][1] * rs;
                    u32x4 w; w.x = pk_bf16(v0[0], v0[1]); w.y = pk_bf16(v0[2], v0[3]); w.z = pk_bf16(v1[0], v1[1]); w.w = pk_bf16(v1[2], v1[3]);
                    *(u32x4*)(WSP(bf16_t, OFF_KVRAW) + (long)row * 1024 + bcol + bj * HALF + wc * 32 + fq * 8) = w;
                    if (wc == 2 + bj) {
                        float kv[8]; ld8(WSP(bf16_t, OFF_KPE) + (long)row * 32 + fq * 8, kv);
#pragma unroll
                        for (int i = 0; i < 8; ++i) kv[i] *= rk;
                        st8(kf + 64 + fq * 8, kv);
                    }
                }
            }
        }
}

namespace pg8 {
#define PG8_LAS __attribute__((address_space(3)))
typedef unsigned short bf16_t;
typedef short bf16x8 __attribute__((ext_vector_type(8)));
typedef float f32x4 __attribute__((ext_vector_type(4)));
typedef unsigned u32x4 __attribute__((ext_vector_type(4)));
constexpr int BM = 256, BK = 64, HALF = 128, HTB = HALF * BK * 2  , STAGE_BYTES = 8 * HTB, NXCD = 8, WGM = 8;

__host__ __device__ __forceinline__ int lds_byte(int r, int c) { const int st = (r >> 4) * 2 + (c >> 5), rr = r & 15, cc = c & 31, ob = rr * 64 + cc * 2; return st * 1024 + (ob ^ (((ob >> 9) & 1) << 5)); }
__host__ __device__ __forceinline__ void stage_rc(int b, int& R, int& C) { const int st = b / 1024, sb = b % 1024, swz = sb ^ (((sb >> 9) & 1) << 5); R = (st >> 1) * 16 + swz / 64; C = (st & 1) * 32 + (swz % 64) / 2; }
__host__ __device__ __forceinline__ int perm32(int rho) { const int n = rho >> 4, i = rho & 15; return 8 * (i >> 2) + 4 * n + (i & 3); }

struct Unit { int pm, pn; };
struct Gemm { const bf16_t* A; const bf16_t* Bt; int M, N, K; };

struct StaticOrder {
    int nM, nN, nwg, G, c;
    __host__ __device__ void init(int M, int N, int G_, int c_) { nM = M / BM; nN = N / BM; nwg = nM * nN; G = G_; c = c_; }
    __host__ __device__ bool next(int i, Unit& u) const {
        const long L = (long)i * G + c; if (L >= nwg) return false;
        int wgid = (int)L; { const int q = nwg / NXCD, r = nwg % NXCD, xcd = wgid % NXCD, off = wgid / NXCD; wgid = (xcd < r ? xcd * (q + 1) : r * (q + 1) + (xcd - r) * q) + off; }
        const int nig = WGM * nN, gid = wgid / nig, fm = gid * WGM, gsz = (nM - fm) < WGM ? (nM - fm) : WGM;
        u.pm = fm + ((wgid % nig) % gsz); u.pn = (wgid % nig) / gsz; return true;
    }
    __device__ __forceinline__ void a_ready(const Unit&) const {}
    __device__ __forceinline__ void done(const Unit&) const {}
};
template <class Epi, class Sched, bool ALIGN_EPI = false, bool SP2 = false>
__device__ __forceinline__ void gemm_phase(PG8_LAS unsigned char* lds, const Gemm g, const Sched& S, const Epi& E) {
    int tid = threadIdx.x; asm volatile("" : "+v"(tid));
    const int wid = __builtin_amdgcn_readfirstlane(tid >> 6), lane = tid & 63, wr = wid >> 2, wc = wid & 3, fr = lane & 15, fq = lane >> 4;
    const int K = g.K, nt = K / BK;
    unsigned voffA[2], voffB[2];
#pragma unroll
    for (int i = 0; i < 2; ++i) { int R, C; stage_rc(tid * 16 + i * 8192, R, C); const int Rb = Epi::PERM ? ((R & ~31) + perm32(R & 31)) : R;
        voffA[i] = (unsigned)(R * K + C) * 2u; voffB[i] = (unsigned)(Rb * K + C) * 2u; }
    const size_t kstep = (size_t)(BK * 2);
    const size_t hstep = (size_t)HALF * K * 2;
    const size_t tstep = 2 * hstep;
    const unsigned ldsw = (unsigned)wid * 1024u;
    const int aoff = lds_byte(wr * 64 + fr, fq * 8), boff = lds_byte(wc * 32 + fr, fq * 8);
#define PG8_SA(b, h) (((b) * 2 + (h)) * HTB)
#define PG8_SB(b, h) ((4 + (b) * 2 + (h)) * HTB)
#define PG8_STAGE(bufoff, gbase, voff) do { _Pragma("unroll") for (int _i = 0; _i < 2; ++_i) \
        __builtin_amdgcn_global_load_lds((const unsigned*)((const char*)(gbase) + (voff)[_i]), (PG8_LAS unsigned*)(lds + (bufoff) + ldsw + _i * 8192), 16, 0, 0); } while (0)
#define PG8_LDA(dst, b, h) do { _Pragma("unroll") for (int m = 0; m < 4; ++m) _Pragma("unroll") for (int k = 0; k < 2; ++k) dst[m][k] = *(const PG8_LAS bf16x8*)(lds + PG8_SA(b, h) + aoff + m * 2048 + k * 1024); } while (0)
#define PG8_LDB(dst, b, h) do { _Pragma("unroll") for (int n = 0; n < 2; ++n) _Pragma("unroll") for (int k = 0; k < 2; ++k) dst[n][k] = *(const PG8_LAS bf16x8*)(lds + PG8_SB(b, h) + boff + n * 2048 + k * 1024); } while (0)
#define PG8_MMA(ai, bj, At, Bt) do { __builtin_amdgcn_s_setprio(1); _Pragma("unroll") for (int m = 0; m < 4; ++m) _Pragma("unroll") for (int n = 0; n < 2; ++n) _Pragma("unroll") for (int k = 0; k < 2; ++k) \
        acc[ai][bj][m][n] = __builtin_amdgcn_mfma_f32_16x16x32_bf16(Bt[n][k], At[m][k], acc[ai][bj][m][n], 0, 0, 0); __builtin_amdgcn_s_setprio(0); } while (0)
#define PG8_WAIT_V(n) asm volatile("s_waitcnt vmcnt(" #n ")" ::: "memory")
#define PG8_WAIT_L(n) asm volatile("s_waitcnt lgkmcnt(" #n ")" ::: "memory")
#define PG8_BAR __builtin_amdgcn_s_barrier()
#define PG8_SCHED __builtin_amdgcn_sched_barrier(0)
    Unit cur, nxt; int ui = 0;
    if (!S.next(0, cur)) return;
    f32x4 acc[2][2][4][2];
#pragma unroll
    for (int a = 0; a < 2; ++a)
#pragma unroll
        for (int b = 0; b < 2; ++b)
#pragma unroll
            for (int m = 0; m < 4; ++m)
#pragma unroll
                for (int n = 0; n < 2; ++n) acc[a][b][m][n] = (f32x4){0.f, 0.f, 0.f, 0.f};
    bf16x8 At[4][2], B0[2][2], B1[2][2];
    const char* cA = (const char*)g.A + (size_t)cur.pm * tstep; const char* cB = (const char*)g.Bt + (size_t)cur.pn * tstep;
    S.a_ready(cur);
    if constexpr (SP2) {
        PG8_STAGE(PG8_SB(0, 0), cB, voffB); PG8_STAGE(PG8_SB(0, 1), cB + hstep, voffB); PG8_STAGE(PG8_SA(0, 0), cA, voffA); PG8_STAGE(PG8_SA(0, 1), cA + hstep, voffA);
        if (wr == 1) PG8_BAR;
        PG8_WAIT_V(2); PG8_BAR;
        PG8_STAGE(PG8_SB(1, 0), cB + kstep, voffB); PG8_STAGE(PG8_SA(1, 0), cA + kstep, voffA); PG8_STAGE(PG8_SB(1, 1), cB + hstep + kstep, voffB);
        PG8_WAIT_V(6); PG8_BAR;
    } else {
        PG8_STAGE(PG8_SB(0, 0), cB, voffB); PG8_STAGE(PG8_SA(0, 0), cA, voffA); PG8_STAGE(PG8_SB(0, 1), cB + hstep, voffB); PG8_STAGE(PG8_SA(0, 1), cA + hstep, voffA);
        if (wr == 1) PG8_BAR;
        PG8_WAIT_V(4); PG8_BAR;
        PG8_STAGE(PG8_SB(1, 0), cB + kstep, voffB); PG8_STAGE(PG8_SA(1, 0), cA + kstep, voffA); PG8_STAGE(PG8_SB(1, 1), cB + hstep + kstep, voffB);
        PG8_WAIT_V(6); PG8_BAR;
    }
    for (;;) {
        const bool has_next = S.next(ui + 1, nxt);
        const char* nA = has_next ? (const char*)g.A + (size_t)nxt.pm * tstep : cA; const char* nB = has_next ? (const char*)g.Bt + (size_t)nxt.pn * tstep : cB;
        for (int t = 0; t < nt; t += 2) {
            const bool last = (t == nt - 2);
            const char* a1 = cA + (size_t)(t + 1) * kstep;
            const char* a2 = last ? nA : cA + (size_t)(t + 2) * kstep; const char* b2 = last ? nB : cB + (size_t)(t + 2) * kstep;
            const char* a3 = a2 + kstep; const char* b3 = b2 + kstep;
            if (last && has_next) S.a_ready(nxt);
            if constexpr (SP2) {
            PG8_LDB(B0, 0, 0); PG8_LDB(B1, 0, 1); PG8_SCHED; PG8_LDA(At, 0, 0); PG8_STAGE(PG8_SA(1, 1), a1 + hstep, voffA);
            PG8_WAIT_V(8); PG8_WAIT_L(0); PG8_BAR; PG8_MMA(0, 0, At, B0); PG8_MMA(0, 1, At, B1); PG8_BAR; PG8_SCHED;
            PG8_LDA(At, 0, 1); PG8_STAGE(PG8_SB(0, 0), b2, voffB); PG8_STAGE(PG8_SB(0, 1), b2 + hstep, voffB); PG8_STAGE(PG8_SA(0, 0), a2, voffA);
            PG8_WAIT_V(8); PG8_WAIT_L(0); PG8_BAR; PG8_MMA(1, 0, At, B0); PG8_MMA(1, 1, At, B1); PG8_BAR; PG8_SCHED;
            PG8_LDB(B0, 1, 0); PG8_LDB(B1, 1, 1); PG8_SCHED; PG8_LDA(At, 1, 0); PG8_STAGE(PG8_SA(0, 1), a2 + hstep, voffA);
            PG8_WAIT_V(8); PG8_WAIT_L(0); PG8_BAR; PG8_MMA(0, 0, At, B0); PG8_MMA(0, 1, At, B1); PG8_BAR; PG8_SCHED;
            PG8_LDA(At, 1, 1); PG8_STAGE(PG8_SB(1, 0), b3, voffB); PG8_STAGE(PG8_SB(1, 1), b3 + hstep, voffB); PG8_STAGE(PG8_SA(1, 0), a3, voffA);
            PG8_WAIT_V(8); PG8_WAIT_L(0); PG8_BAR; PG8_MMA(1, 0, At, B0); PG8_MMA(1, 1, At, B1); PG8_BAR; PG8_SCHED;
            } else {
            PG8_LDB(B0, 0, 0); PG8_SCHED; PG8_LDA(At, 0, 0); PG8_STAGE(PG8_SA(1, 1), a1 + hstep, voffA);
            PG8_WAIT_L(8); PG8_BAR; PG8_WAIT_L(0); PG8_MMA(0, 0, At, B0); PG8_BAR; PG8_SCHED;
            PG8_LDB(B1, 0, 1); PG8_STAGE(PG8_SB(0, 0), b2, voffB);
            PG8_BAR; PG8_WAIT_L(0); PG8_MMA(0, 1, At, B1); PG8_BAR;
            PG8_LDA(At, 0, 1); PG8_STAGE(PG8_SA(0, 0), a2, voffA);
            PG8_BAR; PG8_WAIT_L(0); PG8_MMA(1, 0, At, B0); PG8_BAR; PG8_SCHED;
            PG8_STAGE(PG8_SB(0, 1), b2 + hstep, voffB);
            PG8_WAIT_V(6); PG8_BAR; PG8_MMA(1, 1, At, B1); PG8_BAR;
            PG8_LDB(B0, 1, 0); PG8_SCHED; PG8_LDA(At, 1, 0); PG8_STAGE(PG8_SA(0, 1), a2 + hstep, voffA);
            PG8_WAIT_L(8); PG8_BAR; PG8_WAIT_L(0); PG8_MMA(0, 0, At, B0); PG8_BAR; PG8_SCHED;
            PG8_LDB(B1, 1, 1); PG8_STAGE(PG8_SB(1, 0), b3, voffB);
            PG8_BAR; PG8_WAIT_L(0); PG8_MMA(0, 1, At, B1); PG8_BAR;
            PG8_LDA(At, 1, 1); PG8_STAGE(PG8_SA(1, 0), a3, voffA);
            PG8_BAR; PG8_WAIT_L(0); PG8_MMA(1, 0, At, B0); PG8_BAR; PG8_SCHED;
            PG8_STAGE(PG8_SB(1, 1), b3 + hstep, voffB);
            PG8_WAIT_V(6); PG8_BAR; PG8_MMA(1, 1, At, B1); PG8_BAR;
            }
        }
        if constexpr (ALIGN_EPI) { if (wr == 0) PG8_BAR; }
        if constexpr (!Epi::AFTER_DRAIN) { E(acc, cur, wr, wc, fr, fq); S.done(cur); }
        if (!has_next) break;
#pragma unroll
        for (int a = 0; a < 2; ++a)
#pragma unroll
            for (int b = 0; b < 2; ++b)
#pragma unroll
                for (int m = 0; m < 4; ++m)
#pragma unroll
                    for (int n = 0; n < 2; ++n) acc[a][b][m][n] = (f32x4){0.f, 0.f, 0.f, 0.f};
        cur = nxt; cA = nA; cB = nB; ++ui;
        if constexpr (ALIGN_EPI) { if (wr == 1) PG8_BAR; }
    }
    PG8_WAIT_V(0);
    if constexpr (!ALIGN_EPI) { if (wr == 0) PG8_BAR; }
    PG8_BAR;
    if constexpr (Epi::AFTER_DRAIN) { E.fused(acc, cur, wr, wc, fr, fq, lds, wid, lane); S.done(cur); }
#undef PG8_SA
#undef PG8_SB
#undef PG8_STAGE
#undef PG8_LDA
#undef PG8_LDB
#undef PG8_MMA
#undef PG8_WAIT_V
#undef PG8_WAIT_L
#undef PG8_BAR
#undef PG8_SCHED
}
}

template <int MODE> struct EpiAd {
    static constexpr bool PERM = true, AFTER_DRAIN = false;
    const Params& P; int aux;
    __device__ __forceinline__ void operator()(const f32x4 (&acc)[2][2][4][2], const pg8::Unit& u, int, int, int, int) const { epilogue<MODE>(acc, P, u.pm * 256, u.pn * 256, aux); }
};
template <int MODE> __device__ __forceinline__ void stream_gemm(const Params& P, const bf16_t* A, const bf16_t* Bt, int N, int K, int aux) {
    pg8::Gemm g; g.A = A; g.Bt = Bt; g.M = M_TOK; g.N = N; g.K = K;
    pg8::StaticOrder S; S.init(M_TOK, N, (int)gridDim.x, (int)blockIdx.x);
    const EpiAd<MODE> E{P, aux};
    pg8::gemm_phase<EpiAd<MODE>, pg8::StaticOrder, true, true>((PG8_LAS unsigned char*)shm, g, S, E);
}

struct WtDesc { const float* W; const float* g1; const float* g2; bf16_t* out; int N, ksplit, ldo, mode, k0, n0; };
__device__ __forceinline__ WtDesc wt_desc(const Params& P, int task) {
    WtDesc d; int tile;
    if (task < 2112) { const int wsel = task / 352; tile = task % 352; const int f2 = wsel >= 3, k = wsel % 3;
        const float* nf = f2 ? P.norm_ffn2 : P.norm_ffn1;
        if (k == 2) { d.W = f2 ? P.w2d : P.w1d; d.N = 1024; d.g1 = nullptr; d.g2 = nullptr; d.ksplit = 0; d.out = WSP(bf16_t, f2 ? OFF_WD2 : OFF_WD1); d.ldo = 2816; d.mode = 0; }
        else { d.W = k == 0 ? (f2 ? P.w2g : P.w1g) : (f2 ? P.w2u : P.w1u); d.N = 2816; d.g1 = nf; d.g2 = nf; d.ksplit = 1024; d.out = WSP(bf16_t, f2 ? OFF_W2 : OFF_W1); d.ldo = 1024; d.mode = k == 0 ? 1 : 2; }
    } else if (task < 2272) { tile = task - 2112; d.W = P.w_in; d.N = 1184; d.g1 = P.norm_mix; d.g2 = P.norm_mix; d.ksplit = 1024; d.out = WSP(bf16_t, OFF_WIN); d.ldo = 1024; d.mode = 0; }
    else if (task < 2308) { tile = task - 2272; d.W = P.w_uq; d.N = 768; d.g1 = P.q_norm; d.g2 = P.q_norm; d.ksplit = 384; d.out = WSP(bf16_t, OFF_WUQ); d.ldo = 384; d.mode = 0; }
    else if (task < 2340) { tile = task - 2308; d.W = P.w_ukv; d.N = 1024; d.g1 = P.kv_norm; d.g2 = P.kv_norm; d.ksplit = 256; d.out = WSP(bf16_t, OFF_WUKV); d.ldo = 256; d.mode = 0; }
    else if (task < 2372) { tile = task - 2340; d.W = P.w_glu; d.N = 512; d.g1 = nullptr; d.g2 = nullptr; d.ksplit = 0; d.out = WSP(bf16_t, OFF_WGLU); d.ldo = 512; d.mode = 0; }
    else if (task < 2500) { tile = task - 2372; d.W = P.w_out; d.N = 1024; d.g1 = P.on_ssm; d.g2 = P.on_att; d.ksplit = 512; d.out = WSP(bf16_t, OFF_WOUT); d.ldo = 1024; d.mode = 0; }
    else if (task < 2628) { tile = task - 2500; d.W = P.w_pg; d.N = 1024; d.g1 = P.norm_ple; d.g2 = P.norm_ple; d.ksplit = 1024; d.out = WSP(bf16_t, OFF_WPG); d.ldo = 1024; d.mode = 0; }
    else { tile = task - 2628; d.W = P.w_pp; d.N = 1024; d.g1 = nullptr; d.g2 = nullptr; d.ksplit = 0; d.out = WSP(bf16_t, OFF_WPP); d.ldo = 256; d.mode = 0; }
    const int ntn = (d.N + 127) >> 7, tk = tile / ntn, tn = tile - tk * ntn; d.k0 = tk * 64; d.n0 = tn * 128;
    return d;
}
constexpr int NWT = 2660;
__device__ __forceinline__ void wt_load(const WtDesc& d, f32x4 (&r)[4]) {
    int t = threadIdx.x; asm volatile("" : "+v"(t));
    const int n = d.n0 + (t & 31) * 4;
#pragma unroll
    for (int i = 0; i < 4; ++i) {
        const int kk = d.k0 + (t >> 5) + 16 * i;
        f32x4 v = {0.f, 0.f, 0.f, 0.f};
        if (n < d.N) { v = *(const f32x4*)(d.W + (long)kk * d.N + n); if (d.g1) v *= (kk < d.ksplit ? d.g1[kk] : d.g2[kk - d.ksplit]); }
        r[i] = v;
    }
}
__device__ __forceinline__ void wt_store(const WtDesc& d, const f32x4 (&r)[4]) {
    float* tl = (float*)shm;
    int t = threadIdx.x; asm volatile("" : "+v"(t));
#pragma unroll
    for (int i = 0; i < 4; ++i) { float* q = tl + ((t >> 5) + 16 * i) * 129 + (t & 31) * 4; q[0] = r[i][0]; q[1] = r[i][1]; q[2] = r[i][2]; q[3] = r[i][3]; }
    __syncthreads();
#pragma unroll
    for (int i = 0; i < 2; ++i) {
        const int n = (t >> 3) + 64 * i, kc = (t & 7) * 8, nn = d.n0 + n;
        if (nn < d.N) {
            const int orow = d.mode == 0 ? nn : ((nn >> 7) * 256 + (d.mode == 2 ? 128 : 0) + (nn & 127));
            u32x4 w;
            w.x = pk_bf16(tl[(kc + 0) * 129 + n], tl[(kc + 1) * 129 + n]); w.y = pk_bf16(tl[(kc + 2) * 129 + n], tl[(kc + 3) * 129 + n]);
            w.z = pk_bf16(tl[(kc + 4) * 129 + n], tl[(kc + 5) * 129 + n]); w.w = pk_bf16(tl[(kc + 6) * 129 + n], tl[(kc + 7) * 129 + n]);
            *(u32x4*)(d.out + (long)orow * d.ldo + d.k0 + kc) = w;
        }
    }
    __syncthreads();
}

struct S5Mode { float lr, li, dt, cr, ci; };
__device__ __forceinline__ S5Mode s5_mode(const Params& P, int g, int p) {
    S5Mode m; m.lr = P.lam_re[g * 64 + p]; m.li = P.lam_im[g * 64 + p]; m.dt = __expf(P.log_dt[g]);
    float c, s; cisf(m.li * m.dt, c, s); const float e = __expf(m.lr * m.dt);
    const float nr = e * c - 1.f, ni = e * s, den = 1.f / (m.lr * m.lr + m.li * m.li);
    m.cr = (nr * m.lr + ni * m.li) * den; m.ci = (ni * m.lr - nr * m.li) * den;
    return m;
}
__device__ __forceinline__ void s5_pow(const S5Mode& m, float tau, float& zr, float& zi) {
    float c, s; cisf(m.li * m.dt * tau, c, s); const float e = __expf(m.lr * m.dt * tau); zr = e * c; zi = e * s;
}

__constant__ float c_inv_freq[16] = {1.0f, 0.5623413251903491f, 0.31622776601683794f, 0.1778279410038923f, 0.1f, 0.05623413251903491f, 0.03162277660168379f, 0.01778279410038923f,
    0.01f, 0.005623413251903491f, 0.0031622776601683794f, 0.0017782794100389228f, 0.001f, 0.0005623413251903491f, 0.00031622776601683794f, 0.00017782794100389227f};

typedef short s16x4 __attribute__((ext_vector_type(4)));
__device__ __forceinline__ u32x4 scale8(u32x4 w, float s) { u32x4 o;
    o.x = pk_bf16(bf_lo(w.x) * s, bf_hi(w.x) * s); o.y = pk_bf16(bf_lo(w.y) * s, bf_hi(w.y) * s); o.z = pk_bf16(bf_lo(w.z) * s, bf_hi(w.z) * s); o.w = pk_bf16(bf_lo(w.w) * s, bf_hi(w.w) * s); return o; }
__device__ __forceinline__ void attn_item(const Params& P, int bh, int qb) {
    int tid = threadIdx.x; asm volatile("" : "+v"(tid));
    const int w = tid >> 6, lane = tid & 63, l32 = lane & 31, hi = lane >> 5;
    const int b = bh >> 3, h = bh & 7;
    const bf16_t* kvraw = WSP(bf16_t, OFF_KVRAW) + (long)b * SEQ * 1024 + h * 128;
    const bf16_t* kfp = WSP(bf16_t, OFF_HBUF) + (long)bh * SEQ * 96;
    LAS unsigned char* lds = (LAS unsigned char*)shm;
    const int wq = __builtin_amdgcn_readfirstlane(w);
    const int q0 = qb * 256, qrow = q0 + w * 32 + l32, wmin = q0 + wq * 32;
    bf16x8 qf[6];
    {
        const long tokq = (long)b * SEQ + qrow;
        const bf16_t* qr = WSP(bf16_t, OFF_QRAW) + tokq * 768 + h * 96 + hi * 8;
        float qv[6][8]; float sq = 0.f;
#pragma unroll
        for (int ks = 0; ks < 6; ++ks) { ld8(qr + ks * 16, qv[ks]); sq += sq8(qv[ks]); }
        sq += __shfl_xor(sq, 32);
        const float rs = rsqrtf(sq * (1.f / 96.f) + EPS), qs = 0.10206207261596575f * 1.4426950408889634f;
        float cs[8], sn[8];
        ld8f(WSP(float, OFF_TAB) + tokq * 32 + hi * 8, cs); ld8f(WSP(float, OFF_TAB) + tokq * 32 + 16 + hi * 8, sn);
#pragma unroll
        for (int ks = 0; ks < 4; ++ks) { float g[8], gk[8]; ld8f(P.qkn_q + ks * 16 + hi * 8, g); ld8f(P.qkn_k + ks * 16 + hi * 8, gk);
#pragma unroll
            for (int i = 0; i < 8; ++i) qv[ks][i] *= rs * g[i] * gk[i] * qs; }
        { float g1[8], g2[8]; ld8f(P.qkn_q + 64 + hi * 8, g1); ld8f(P.qkn_q + 80 + hi * 8, g2);
#pragma unroll
            for (int i = 0; i < 8; ++i) { const float x1 = qv[4][i] * rs * g1[i] * qs, x2 = qv[5][i] * rs * g2[i] * qs; qv[4][i] = x1 * cs[i] - x2 * sn[i]; qv[5][i] = x1 * sn[i] + x2 * cs[i]; } }
#pragma unroll
        for (int ks = 0; ks < 6; ++ks) { union { bf16x8 v; unsigned u[4]; } t;
#pragma unroll
            for (int i = 0; i < 4; ++i) t.u[i] = pk_bf16(qv[ks][2 * i], qv[ks][2 * i + 1]);
            qf[ks] = t.v; }
    }
    f32x16 o0, o1;
#pragma unroll
    for (int r = 0; r < 16; ++r) { o0[r] = 0.f; o1[r] = 0.f; }
    f32x16 lacc;
#pragma unroll
    for (int r = 0; r < 16; ++r) lacc[r] = 0.f;
    bf16x8 ones8;
#pragma unroll
    for (int i = 0; i < 8; ++i) ones8[i] = (short)0x3F80;
    const int nkt = 4 * (qb + 1);
    constexpr int KSLOT = 12288, VSLOT = 8192, VRING = 3 * KSLOT;
    int kga0, kga1, vga;
    { const int p0 = 64 * wq + lane, k0_ = p0 / 12, c0_ = p0 - 12 * k0_; const int cc0 = (c0_ - ((k0_ >> 2) & 3) + 12) % 12; kga0 = k0_ * 96 + cc0 * 8;
      const int p1 = 64 * ((wq & 3) + 8) + lane, k1_ = p1 / 12, c1_ = p1 - 12 * k1_; const int cc1 = (c1_ - ((k1_ >> 2) & 3) + 12) % 12; kga1 = k1_ * 96 + cc1 * 8;
      const int vkey = 8 * wq + (lane >> 3), vc = (lane & 7) ^ (((vkey >> 1) & 1) << 1); vga = vkey * 1024 + 64 + vc * 8; }
#define ATT_DMA_K(kt_, slot_) do { const bf16_t* g_ = kfp + (long)(kt_) * 64 * 96; \
        __builtin_amdgcn_global_load_lds((const unsigned*)(g_ + kga0), (LAS unsigned*)(lds + (slot_) * KSLOT + wq * 1024), 16, 0, 0); \
        if (wq < 4) __builtin_amdgcn_global_load_lds((const unsigned*)(g_ + kga1), (LAS unsigned*)(lds + (slot_) * KSLOT + (wq + 8) * 1024), 16, 0, 0); } while (0)
#define ATT_DMA_V(kt_, slot_) do { const bf16_t* g_ = kvraw + (long)(kt_) * 64 * 1024; \
        __builtin_amdgcn_global_load_lds((const unsigned*)(g_ + vga), (LAS unsigned*)(lds + VRING + (slot_) * VSLOT + wq * 1024), 16, 0, 0); } while (0)
    int koff[6];
#pragma unroll
    for (int ks = 0; ks < 6; ++ks) koff[ks] = (l32 * 12 + ((2 * ks + hi + ((l32 >> 2) & 3)) % 12)) * 16;
    const int g16 = lane >> 4, dhalf = g16 & 1, tr_r = (lane & 15) >> 2, tr_c = lane & 3;
    const int vtr_off = (4 * hi + tr_r) * 128 + (((dhalf ^ ((tr_r >> 1) & 1)) * 2 + (tr_c >> 1)) * 16) + (tr_c & 1) * 8;
    const unsigned lds_base = (unsigned)(unsigned long long)lds;
#define TR_RD(dst, addr, off) asm volatile("ds_read_b64_tr_b16 %0, %1 offset:" #off : "=v"(dst) : "v"(addr))
#define QK_TILE(S0, S1, kslot_) do { bf16x8 kf[12]; const LAS unsigned char* kb_ = lds + (kslot_) * KSLOT; \
        _Pragma("unroll") for (int ks = 0; ks < 6; ++ks) { kf[2 * ks] = *(const LAS bf16x8*)(kb_ + koff[ks]); kf[2 * ks + 1] = *(const LAS bf16x8*)(kb_ + koff[ks] + 6144); } \
        __builtin_amdgcn_sched_barrier(0); \
        _Pragma("unroll") for (int r = 0; r < 16; ++r) { S0[r] = 0.f; S1[r] = 0.f; } \
        __builtin_amdgcn_s_setprio(1); \
        _Pragma("unroll") for (int ks = 0; ks < 6; ++ks) { \
            S0 = __builtin_amdgcn_mfma_f32_32x32x16_bf16(kf[2 * ks], qf[ks], S0, 0, 0, 0); \
            S1 = __builtin_amdgcn_mfma_f32_32x32x16_bf16(kf[2 * ks + 1], qf[ks], S1, 0, 0, 0); } \
        __builtin_amdgcn_s_setprio(0); \
        __builtin_amdgcn_sched_barrier(0); } while (0)
#define ATT_BODY(KT, GEN) do { const int kt = (KT); \
        { const int ktn = kt + 2 < nkt ? kt + 2 : nkt - 1; ATT_DMA_K(ktn, s2_); ATT_DMA_V(ktn, s2_); } \
        if (!(GEN) || kt * 64 <= wmin + 31) { \
            f32x16 S0, S1; \
            QK_TILE(S0, S1, s0_); \
            const unsigned vb = lds_base + VRING + s0_ * VSLOT + vtr_off; \
            s16x4 vf[16]; \
            TR_RD(vf[0], vb, 0); TR_RD(vf[1], vb, 1024); TR_RD(vf[2], vb, 64); TR_RD(vf[3], vb, 1088); \
            TR_RD(vf[4], vb, 2048); TR_RD(vf[5], vb, 3072); TR_RD(vf[6], vb, 2112); TR_RD(vf[7], vb, 3136); \
            TR_RD(vf[8], vb, 4096); TR_RD(vf[9], vb, 5120); TR_RD(vf[10], vb, 4160); TR_RD(vf[11], vb, 5184); \
            TR_RD(vf[12], vb, 6144); TR_RD(vf[13], vb, 7168); TR_RD(vf[14], vb, 6208); TR_RD(vf[15], vb, 7232); \
            __builtin_amdgcn_sched_barrier(0); \
            if ((GEN) && kt * 64 + 63 > wmin) { \
                _Pragma("unroll") for (int r = 0; r < 16; ++r) { \
                    const int key = kt * 64 + 8 * (r >> 2) + 4 * hi + (r & 3); \
                    if (key > qrow) S0[r] = -1e30f; \
                    if (key + 32 > qrow) S1[r] = -1e30f; } } \
              \
              \
            _Pragma("unroll") for (int r = 0; r < 16; ++r) { S0[r] = __builtin_amdgcn_exp2f(S0[r]); S1[r] = __builtin_amdgcn_exp2f(S1[r]); } \
            asm volatile("s_waitcnt lgkmcnt(0)" : "+v"(vf[0]), "+v"(vf[1]), "+v"(vf[2]), "+v"(vf[3]), "+v"(vf[4]), "+v"(vf[5]), "+v"(vf[6]), "+v"(vf[7]), \
                         "+v"(vf[8]), "+v"(vf[9]), "+v"(vf[10]), "+v"(vf[11]), "+v"(vf[12]), "+v"(vf[13]), "+v"(vf[14]), "+v"(vf[15]) :: "memory"); \
            _Pragma("unroll") for (int q = 0; q < 4; ++q) { \
                union { bf16x8 v; unsigned u[4]; } pf; \
                _Pragma("unroll") for (int i = 0; i < 4; ++i) pf.u[i] = (q >> 1) == 0 ? pk_bf16(S0[8 * (q & 1) + 2 * i], S0[8 * (q & 1) + 2 * i + 1]) : pk_bf16(S1[8 * (q & 1) + 2 * i], S1[8 * (q & 1) + 2 * i + 1]); \
                union { bf16x8 v; s16x4 h[2]; } va, vb2; \
                va.h[0] = vf[4 * q + 0]; va.h[1] = vf[4 * q + 1]; vb2.h[0] = vf[4 * q + 2]; vb2.h[1] = vf[4 * q + 3]; \
                o0 = __builtin_amdgcn_mfma_f32_32x32x16_bf16(va.v, pf.v, o0, 0, 0, 0); \
                o1 = __builtin_amdgcn_mfma_f32_32x32x16_bf16(vb2.v, pf.v, o1, 0, 0, 0); \
                lacc = __builtin_amdgcn_mfma_f32_32x32x16_bf16(ones8, pf.v, lacc, 0, 0, 0); } \
        } \
          \
        if (wq < 4) asm volatile("s_waitcnt vmcnt(3)" ::: "memory"); else asm volatile("s_waitcnt vmcnt(2)" ::: "memory"); \
        __builtin_amdgcn_s_barrier(); \
        { const int t_ = s0_; s0_ = s1_; s1_ = s2_; s2_ = t_; } } while (0)
    __syncthreads();
    ATT_DMA_K(0, 0); ATT_DMA_K(1, 1); ATT_DMA_V(0, 0); ATT_DMA_V(1, 1);
    asm volatile("s_waitcnt vmcnt(0)" ::: "memory");
    __builtin_amdgcn_s_barrier();
    int s0_ = 0, s1_ = 1, s2_ = 2;
    int kfull = (wmin + 1) >> 6; kfull = kfull < nkt ? kfull : nkt;
    int kti = 0;
    for (; kti < kfull; ++kti) ATT_BODY(kti, 0);
    for (; kti < nkt; ++kti) ATT_BODY(kti, 1);
    asm volatile("s_waitcnt vmcnt(0)" ::: "memory");
    __builtin_amdgcn_s_barrier();
#undef QK_TILE
#undef TR_RD
#undef ATT_BODY
#undef ATT_DMA_K
#undef ATT_DMA_V
    const float inv = 1.f / lacc[0];
    const long tok = (long)b * SEQ + qrow;
    bf16_t* ymix = ((bf16_t*)P.out) + tok * 1024 + 512 + h * 64;
    float sq = 0.f;
#pragma unroll
    for (int g4 = 0; g4 < 4; ++g4) {
        f32x4 a, c;
#pragma unroll
        for (int j = 0; j < 4; ++j) { a[j] = o0[g4 * 4 + j] * inv; c[j] = o1[g4 * 4 + j] * inv; sq += a[j] * a[j] + c[j] * c[j]; }
        store_bf4(ymix + 8 * g4 + 4 * hi, a);
        store_bf4(ymix + 32 + 8 * g4 + 4 * hi, c);
    }
    sq += __shfl_xor(sq, 32);
    if (hi == 0) unsafeAtomicAdd(WSP(float, OFF_SS) + ATOM_OFF + 7 * M_TOK + tok, sq);
}

__device__ __forceinline__ void s5_scan_task(const Params& P, int g, int b, float* T) {
    int tid = threadIdx.x; asm volatile("" : "+v"(tid));
    const int p = tid & 63, part = tid >> 6;
    const S5Mode md = s5_mode(P, g, p); float ar, ai, a16r, a16i; s5_pow(md, 32.f, ar, ai); s5_pow(md, 512.f, a16r, a16i);
    const float* E = WSP(float, OFF_E) + ((long)g * 1024 + b * 128 + part * 16) * 128;
    bf16_t* A2 = WSP(bf16_t, OFF_A2) + ((long)g * 1024 + b * 128 + part * 16) * 640 + 512;
    float er[16], ei[16], lr[16], li[16];
#pragma unroll
    for (int j = 0; j < 16; ++j) { er[j] = E[(long)j * 128 + p]; ei[j] = E[(long)j * 128 + 64 + p]; }
    float sr = 0.f, si = 0.f;
#pragma unroll
    for (int j = 0; j < 16; ++j) { lr[j] = sr; li[j] = si; const float nr = ar * sr - ai * si + er[j], ni = ar * si + ai * sr + ei[j]; sr = nr; si = ni; }
    __syncthreads();
    T[(part * 2 + 0) * 64 + p] = sr; T[(part * 2 + 1) * 64 + p] = si;
    __syncthreads();
    float wr_ = 0.f, wi_ = 0.f;
    for (int k = 0; k < part; ++k) { const float tr = T[(k * 2 + 0) * 64 + p], ti = T[(k * 2 + 1) * 64 + p]; const float nr = a16r * wr_ - a16i * wi_ + tr, ni = a16r * wi_ + a16i * wr_ + ti; wr_ = nr; wi_ = ni; }
#pragma unroll
    for (int j = 0; j < 16; ++j) {
        A2[(long)j * 640 + p] = (bf16_t)(pk_bf16(lr[j] + wr_, 0.f) & 0xffff); A2[(long)j * 640 + 64 + p] = (bf16_t)(pk_bf16(li[j] + wi_, 0.f) & 0xffff);
        const float nr = ar * wr_ - ai * wi_, ni = ar * wi_ + ai * wr_; wr_ = nr; wi_ = ni;
    }
    __syncthreads();
}

#define XB_TMO      128
#define XB_XCNT(j)  (256  + 64 * (j))
#define XB_XSUB(j)  (1280 + 64 * (j))
#define XB_XGEN(j)  (2304 + 64 * (j))
#define XB_TOP      3328
#define XB_TOPGEN   3392
#define XCD_BAR_WORDS 3456
#define XB_SPIN_CAP (1u << 18)

__device__ __forceinline__ unsigned xb_ld(unsigned* p)              { return __hip_atomic_load(p, __ATOMIC_RELAXED, __HIP_MEMORY_SCOPE_AGENT); }
__device__ __forceinline__ unsigned xb_add(unsigned* p, unsigned v) { return __hip_atomic_fetch_add(p, v, __ATOMIC_RELAXED, __HIP_MEMORY_SCOPE_AGENT); }
__device__ __forceinline__ unsigned xb_xcc_id() { return (unsigned)__builtin_amdgcn_s_getreg((3 << 11) | 20) & 0xFu; }
#define XB_SPIN(cond, bar) do { unsigned _sp = 0; while (cond) { __builtin_amdgcn_s_sleep(1); \
    if ((++_sp & 255u) == 0u) { if (xb_ld(&(bar)[XB_TMO])) break; if (_sp > XB_SPIN_CAP) { atomicAdd(&(bar)[XB_TMO], 1u); break; } } } } while (0)

struct XcdBarrier {
    unsigned* bar; unsigned x;
    volatile LAS unsigned* st;
};

__device__ __forceinline__ XcdBarrier xcd_barrier_post(unsigned* bar, volatile LAS unsigned* st) {
    XcdBarrier b; b.bar = bar; b.x = xb_xcc_id(); b.st = st;
    if (threadIdx.x == 0) (void)xb_add(&bar[XB_XCNT(b.x)], 1u);
    return b;
}
__device__ __forceinline__ void xcd_barrier_complete(unsigned* bar, unsigned x, unsigned& nloc, unsigned& nx) {
    const unsigned G = gridDim.x * gridDim.y * gridDim.z;
    unsigned sum, cnt, mine, sp = 0u;
    for (;;) {
        sum = 0u; cnt = 0u; mine = 0u;
#pragma unroll
        for (unsigned j = 0; j < 16; ++j) { const unsigned c = xb_ld(&bar[XB_XCNT(j)]); sum += c; cnt += (c > 0u) ? 1u : 0u; mine = (j == x) ? c : mine; }
        if (sum == G) break;
        __builtin_amdgcn_s_sleep(1);
        if ((++sp & 255u) == 0u) { if (xb_ld(&bar[XB_TMO])) break; if (sp > XB_SPIN_CAP) { atomicAdd(&bar[XB_TMO], 1u); break; } }
    }
    nloc = mine > 0u ? mine : 1u; nx = cnt > 0u ? cnt : 1u;
}

__device__ __forceinline__ void xcd_barrier(const XcdBarrier& b) {
    asm volatile("s_waitcnt vmcnt(0)" ::: "memory");
    __syncthreads();
    if (threadIdx.x == 0) {
        unsigned* bar = b.bar;
        __builtin_amdgcn_s_waitcnt(0);
        unsigned nloc = b.st[0], nx = b.st[1];
        if (nloc == 0u) { xcd_barrier_complete(bar, b.x, nloc, nx); b.st[0] = nloc; b.st[1] = nx; }
        const unsigned old = xb_add(&bar[XB_XSUB(b.x)], 1u);
        const unsigned gen = old / nloc;
        if (old + 1u == (gen + 1u) * nloc) {
            __builtin_amdgcn_fence(__ATOMIC_RELEASE, "agent");
            asm volatile("s_waitcnt vmcnt(0)" ::: "memory");
            const unsigned og = xb_add(&bar[XB_TOP], 1u);
            const unsigned tg = og / nx;
            if (og + 1u == (tg + 1u) * nx) xb_add(&bar[XB_TOPGEN], 1u);
            else XB_SPIN(xb_ld(&bar[XB_TOPGEN]) == tg, bar);
            __builtin_amdgcn_fence(__ATOMIC_ACQUIRE, "agent");
            xb_add(&bar[XB_XGEN(b.x)], 1u);
            asm volatile("s_waitcnt vmcnt(0)" ::: "memory");
        } else {
            XB_SPIN(xb_ld(&bar[XB_XGEN(b.x)]) == gen, bar);
            __builtin_amdgcn_fence(__ATOMIC_ACQUIRE, "agent");
            asm volatile("s_waitcnt vmcnt(0)" ::: "memory");
        }
    }
    __syncthreads();
}


__global__ void __launch_bounds__(512, 2) mega(Params P) {
    const int G = gridDim.x, cb = blockIdx.x;
    __shared__ uint4 xb_words;
    if (threadIdx.x == 0) xb_words = make_uint4(0u, 0u, 0u, 0u);
    __syncthreads();
    const XcdBarrier xbar = xcd_barrier_post((unsigned*)(P.ws + OFF_BAR), (volatile LAS unsigned*)&xb_words);
    for (int phr = P.ph_lo * 2; phr < P.ph_hi * 2; ++phr) {
        const int ph = phr >> 1;
        if ((phr & 1) && ph != PROBE_PH) continue;
        if (ph == 5) continue;
#if PROBE_PH >= 0
        __syncthreads(); if (threadIdx.x == 0) s_aoff = (phr & 1) ? (long)24 * M_TOK : 0; __syncthreads();
#endif
        if (phr > P.ph_lo * 2) { if (P.ph_lo < 0) cg::this_grid().sync(); else xcd_barrier(xbar); }
        int tid = threadIdx.x; asm volatile("" : "+v"(tid));
        if (ph == 0) {
            for (int task = cb; task < NWT; task += 2 * G) {
                const WtDesc d0 = wt_desc(P, task); f32x4 r0[4]; wt_load(d0, r0);
                const int t1 = task + G;
                if (t1 < NWT) { const WtDesc d1 = wt_desc(P, t1); f32x4 r1[4]; wt_load(d1, r1); wt_store(d0, r0); wt_store(d1, r1); }
                else wt_store(d0, r0);
            }
            constexpr int R8 = 0, R9 = R8 + 1024  , R10 = R9 + 512  , R11 = R10 + 120  , R12 = R11 + 1024  , R13 = R12 + 512  ,
                          R14 = R13 + 256  , R15 = R14 + 128  , R16 = R15 + 1  ;
            for (int task = cb; task < R16; task += G) {
                if (task < R9) {
                    const int lane = tid & 63, row0 = (task - R8) * 32 + (tid >> 6) * 4;
                    f32x4 v[4][4];
#pragma unroll
                    for (int rr = 0; rr < 4; ++rr)
#pragma unroll
                        for (int i = 0; i < 4; ++i) v[rr][i] = *(const f32x4*)(P.x + (long)(row0 + rr) * DM + i * 256 + lane * 4);
#pragma unroll
                    for (int rr = 0; rr < 4; ++rr) {
                        bf16_t* xb = WSP(bf16_t, OFF_HB) + (long)(row0 + rr) * DM; float sq = 0.f;
#pragma unroll
                        for (int i = 0; i < 4; ++i) { const f32x4 a = v[rr][i]; sq += a[0] * a[0] + a[1] * a[1] + a[2] * a[2] + a[3] * a[3]; store_bf4(xb + i * 256 + lane * 4, a); }
#pragma unroll
                        for (int o = 32; o > 0; o >>= 1) sq += __shfl_xor(sq, o);
                        if (lane == 0) WSP(float, OFF_SS)[row0 + rr] = sq;
                    }
                } else if (task < R10) {
                    f32x4 a[4], b[4];
#pragma unroll
                    for (int i = 0; i < 4; ++i) { const long e = ((long)(task - R9) * 2048 + i * 512 + tid) * 8; a[i] = *(const f32x4*)(P.p + e); b[i] = *(const f32x4*)(P.p + e + 4); }
#pragma unroll
                    for (int i = 0; i < 4; ++i) { const long e = ((long)(task - R9) * 2048 + i * 512 + tid) * 8;
                        u32x4 w; w.x = pk_bf16(a[i][0], a[i][1]); w.y = pk_bf16(a[i][2], a[i][3]); w.z = pk_bf16(b[i][0], b[i][1]); w.w = pk_bf16(b[i][2], b[i][3]);
                        *(u32x4*)(WSP(bf16_t, OFF_PB) + e) = w; }
                } else if (task < R11) {
                    const int zt = task - R10;
                    const long e = (zt < 56 ? (long)M_TOK : (long)16 * M_TOK - (long)56 * 4096) + ((long)zt * 512 + tid) * 8;
                    const f32x4 z = {0.f, 0.f, 0.f, 0.f};
                    *(f32x4*)(WSP(float, OFF_SS) + e) = z; *(f32x4*)(WSP(float, OFF_SS) + e + 4) = z;
                } else if (task < R12) {
                    const int id = (task - R11) * 512 + tid, m = id >> 4, i = id & 15;
                    const double ang = (double)P.pos[m] * (double)c_inv_freq[i];
                    double r = ang * 0.15915494309189535; r -= floor(r);
                    float* tab = WSP(float, OFF_TAB) + (long)m * 32;
                    tab[i] = __builtin_amdgcn_cosf((float)r); tab[16 + i] = __builtin_amdgcn_sinf((float)r);
                } else if (task < R13) {
                    const int g = (task - R12) >> 4, tau0 = ((task - R12) & 15) * 2;
                    float* wre = (float*)shm; float* wim = wre + 2048; float* cre = wim + 2048; float* cim = cre + 1024;
                    __syncthreads();
#pragma unroll
                    for (int i = 0; i < 4; ++i) { const int idx = i * 512 + tid, hi_ = idx & 15, p = (idx >> 4) & 63, tl_ = idx >> 10;
                        const S5Mode md = s5_mode(P, g, p); float zr, zi; s5_pow(md, (float)(tau0 + tl_), zr, zi);
                        const float br = P.b_re[(g * 64 + p) * 16 + hi_], bi = P.b_im[(g * 64 + p) * 16 + hi_];
                        const float bbr = md.cr * br - md.ci * bi, bbi = md.cr * bi + md.ci * br;
                        wre[idx] = zr * bbr - zi * bbi; wim[idx] = zr * bbi + zi * bbr; }
#pragma unroll
                    for (int i = 0; i < 2; ++i) { const int idx = i * 512 + tid; cre[idx] = P.c_re[g * 1024 + idx]; cim[idx] = P.c_im[g * 1024 + idx]; }
                    __syncthreads();
                    const int hi_ = tid & 15, ho = (tid >> 4) & 15, tl_ = tid >> 8;
                    float a = 0.f;
#pragma unroll 8
                    for (int p = 0; p < 64; ++p) a += cre[ho * 64 + p] * wre[(tl_ * 64 + p) * 16 + hi_] - cim[ho * 64 + p] * wim[(tl_ * 64 + p) * 16 + hi_];
                    if (tau0 + tl_ == 0 && ho == hi_) a += P.ssm_d[g * 16 + ho];
                    WSP(float, OFF_KTAB)[((g * 32 + tau0 + tl_) * 16 + ho) * 16 + hi_] = a;
                    __syncthreads();
                } else if (task < R14) {
                    const int id = (task - R13) * 512 + tid, s = id & 31, j = (id >> 5) & 127, g = id >> 12, p = j & 63;
                    const S5Mode md = s5_mode(P, g, p); float zr, zi; s5_pow(md, (float)(31 - s), zr, zi);
                    float br[16], bi[16];
#pragma unroll
                    for (int q = 0; q < 4; ++q) { const f32x4 a = *(const f32x4*)(P.b_re + (g * 64 + p) * 16 + q * 4), b = *(const f32x4*)(P.b_im + (g * 64 + p) * 16 + q * 4);
#pragma unroll
                        for (int e = 0; e < 4; ++e) { br[q * 4 + e] = a[e]; bi[q * 4 + e] = b[e]; } }
                    float o[16];
#pragma unroll
                    for (int h = 0; h < 16; ++h) { const float bbr = md.cr * br[h] - md.ci * bi[h], bbi = md.cr * bi[h] + md.ci * br[h]; o[h] = j < 64 ? (zr * bbr - zi * bbi) : (zr * bbi + zi * bbr); }
                    bf16_t* dst = WSP(bf16_t, OFF_PM) + ((long)g * 128 + j) * 512 + s * 16;
                    u32x4 w0, w1; w0.x = pk_bf16(o[0], o[1]); w0.y = pk_bf16(o[2], o[3]); w0.z = pk_bf16(o[4], o[5]); w0.w = pk_bf16(o[6], o[7]);
                    w1.x = pk_bf16(o[8], o[9]); w1.y = pk_bf16(o[10], o[11]); w1.z = pk_bf16(o[12], o[13]); w1.w = pk_bf16(o[14], o[15]);
                    *(u32x4*)dst = w0; *(u32x4*)(dst + 8) = w1;
                } else if (task < R15) {
                    const int id = (task - R14) * 512 + tid, p = id & 63, t = (id >> 6) & 31, g = id >> 11;
                    const S5Mode md = s5_mode(P, g, p); float zr, zi; s5_pow(md, (float)(t + 1), zr, zi);
                    bf16_t* dst = WSP(bf16_t, OFF_MQ) + ((long)g * 512 + t * 16) * 640 + 512 + p;
#pragma unroll
                    for (int ho = 0; ho < 16; ++ho) { const float cr = P.c_re[(g * 16 + ho) * 64 + p], ci = P.c_im[(g * 16 + ho) * 64 + p];
                        dst[(long)ho * 640] = (bf16_t)(pk_bf16(cr * zr - ci * zi, 0.f) & 0xffff); dst[(long)ho * 640 + 64] = (bf16_t)(pk_bf16(-(cr * zi + ci * zr), 0.f) & 0xffff); }
                } else {
                    for (int e = tid; e < 96 * 1024 / 8; e += 512) { const u32x4 z = {0u, 0u, 0u, 0u}; *(u32x4*)(WSP(bf16_t, OFF_WIN) + (long)1184 * 1024 + (long)e * 8) = z; }
                }
            }
        } else if (ph == 4) {
            for (int task = cb; task < 2048; task += G) {
                const int id = task * 512 + tid, c8 = id & 63, rowq = (id >> 6) & 511, g = id >> 15;
                const int t = rowq >> 4, ho = rowq & 15, s = c8 >> 1, hi0 = (c8 & 1) * 8;
                u32x4 w = {0u, 0u, 0u, 0u};
                if (s <= t) { const float* kt = WSP(float, OFF_KTAB) + (((long)g * 32 + (t - s)) * 16 + ho) * 16 + hi0;
                    const f32x4 a = *(const f32x4*)kt, b = *(const f32x4*)(kt + 4);
                    w.x = pk_bf16(a[0], a[1]); w.y = pk_bf16(a[2], a[3]); w.z = pk_bf16(b[0], b[1]); w.w = pk_bf16(b[2], b[3]); }
                *(u32x4*)(WSP(bf16_t, OFF_MQ) + ((long)g * 512 + rowq) * 640 + c8 * 8) = w;
            }
        } else if (ph == 6) {
            for (int it = cb; it < 1024; it += G) {
                const int r = (it >> 6) & 3, j = it >> 8, bh = it & 63;
                const int qb = (j & 1) ? (15 - 4 * j - (3 - r)) : (15 - 4 * j - r);
                attn_item(P, bh, qb);
            }
        }
        switch (ph) {
            case 1: stream_gemm<E_SWIGLU>(P, WSP(bf16_t, OFF_HB), WSP(bf16_t, OFF_W1), 5632, 1024, 0); break;
            case 9: stream_gemm<E_SWIGLU>(P, WSP(bf16_t, OFF_HB), WSP(bf16_t, OFF_W2), 5632, 1024, 1); break;
            case 2: stream_gemm<E_DOWN>(P, WSP(bf16_t, OFF_ACT), WSP(bf16_t, OFF_WD1), 1024, 2816, 0); break;
            case 10: stream_gemm<E_DOWN>(P, WSP(bf16_t, OFF_ACT), WSP(bf16_t, OFF_WD2), 1024, 2816, 1); break;
            case 3: stream_gemm<E_WIN>(P, WSP(bf16_t, OFF_HB), WSP(bf16_t, OFF_WIN), 1280, 1024, 0); break;
            case 7: stream_gemm<E_GLU>(P, (const bf16_t*)P.out + (long)M_TOK * 1024, WSP(bf16_t, OFF_WGLU), 512, 512, 0); break;
            case 11: stream_gemm<E_PLE>(P, WSP(bf16_t, OFF_HB), WSP(bf16_t, OFF_WPG), 1024, 1024, 0); break;
            default: break;
        }
        int ntiles = 0;
        switch (ph) {
            case 4: ntiles = 128 * 3 + 128 * 4 + 128; break;
            case 6: ntiles = 256; break;
            case 8: ntiles = 128 * 4; break;
            case 3: ntiles = 128 * 4; break;
            default: break;
        }
        struct TD { const char *Ap, *Bp, *Ap2, *Bp2; int lda, ldb, nt, nt2, mode, aux, brow, bcol; };
        auto make_td = [&](int L) -> TD {
            const bf16_t *A = nullptr, *Bt = nullptr, *A2p = nullptr, *B2p = nullptr; int lda = 0, ldb = 0, nt = 0, mode = 0, aux = 0, pm = 0, pn = 0, nt2 = 0;
            switch (ph) {
                case 4:
                    if (L < 384) { tile_map(L, 128, 3, pm, pn); A = WSP(bf16_t, OFF_CQB); lda = 384; Bt = WSP(bf16_t, OFF_WUQ); ldb = 384; nt = 6; mode = E_QRAW; }
                    else if (L < 896) { tile_map(L - 384, 128, 4, pm, pn); A = WSP(bf16_t, OFF_CKVB); lda = 256; Bt = WSP(bf16_t, OFF_WUKV); ldb = 256; nt = 4; mode = E_KVRAW; }
                    else { const int tl = L - 896; aux = tl >> 2; pm = tl & 3; pn = 0; A = WSP(bf16_t, OFF_A2) + (long)aux * 1024 * 640; lda = 640; Bt = WSP(bf16_t, OFF_PM) + (long)aux * 128 * 512; ldb = 512; nt = 8; mode = E_S5E; }
                    break;
                case 6: { aux = L >> 3; pm = (L & 7) >> 1; pn = L & 1; A = WSP(bf16_t, OFF_A2) + (long)aux * 1024 * 640; lda = 640; Bt = WSP(bf16_t, OFF_MQ) + (long)aux * 512 * 640; ldb = 640; nt = 10; mode = E_S5Y; } break;
                case 8: tile_map(L, 128, 4, pm, pn); A = (const bf16_t*)P.out; lda = 1024; Bt = WSP(bf16_t, OFF_WOUT); ldb = 1024; nt = 8; nt2 = 8; A2p = A + 512; B2p = Bt + 512; mode = E_WOUT; break;
                case 3: { tile_map(L, 128, 4, pm, pn); A = WSP(bf16_t, OFF_PB); lda = 256; Bt = WSP(bf16_t, OFF_WPP); ldb = 256; nt = 4; mode = E_PP; } break;
                default: break;
            }
            TD d; d.lda = lda; d.ldb = ldb; d.nt = nt; d.nt2 = nt2; d.mode = mode; d.aux = aux; d.brow = pm * BM; d.bcol = pn * BM;
            d.Ap = (const char*)(A + (long)d.brow * lda); d.Bp = (const char*)(Bt + (long)d.bcol * ldb);
            d.Ap2 = nt2 ? (const char*)(A2p + (long)d.brow * lda) : d.Ap; d.Bp2 = nt2 ? (const char*)(B2p + (long)d.bcol * ldb) : d.Bp;
            return d;
        };
        TD cur{}; bool pre = false;
        int L0 = cb, Lstep = G;
        if (ph == 3) { Lstep = G / 2; if (cb >= G / 2) { L0 = cb - G / 2; ntiles = 3 * (G / 2) < ntiles ? 3 * (G / 2) : ntiles; } else L0 = 3 * (G / 2) + cb; }
        if (L0 < ntiles) cur = make_td(L0);
        for (int L = L0; L < ntiles; L += Lstep) {
            const int lda = cur.lda, ldb = cur.ldb, nt = cur.nt, nt2 = cur.nt2, mode = cur.mode, aux = cur.aux;
            const int brow = cur.brow, bcol = cur.bcol;
            f32x4 acc[2][2][4][2];
#pragma unroll
            for (int a = 0; a < 2; ++a)
#pragma unroll
                for (int b = 0; b < 2; ++b)
#pragma unroll
                    for (int m = 0; m < 4; ++m)
#pragma unroll
                        for (int n = 0; n < 2; ++n) acc[a][b][m][n] = (f32x4){0.f, 0.f, 0.f, 0.f};
            const char* Ap = cur.Ap; const char* Bp = cur.Bp; int ntc = nt;
            for (int part = 0; part < (nt2 ? 2 : 1); ++part) {
                gemm_loop(acc, Ap, lda, Bp, ldb, ntc, pre && part == 0);
                if (nt2 && part == 0) {
                    int tid_ = threadIdx.x; asm volatile("" : "+v"(tid_));
                    const int wid = tid_ >> 6, lane = tid_ & 63, wr = wid >> 2, fr = lane & 15;
                    const float* ss = WSP(float, OFF_SS);
#pragma unroll
                    for (int a = 0; a < 2; ++a)
#pragma unroll
                        for (int m = 0; m < 4; ++m) {
                            const int row = brow + a * HALF + wr * 64 + m * 16 + fr;
                            const float ratio = rsqrtf(ss[6 * M_TOK + row] * (1.f / 512.f) + EPS) / rsqrtf(ss[7 * M_TOK + row] * (1.f / 512.f) + EPS);
#pragma unroll
                            for (int b = 0; b < 2; ++b)
#pragma unroll
                                for (int n = 0; n < 2; ++n) acc[a][b][m][n] *= ratio;
                        }
                    Ap = cur.Ap2; Bp = cur.Bp2; ntc = nt2;
                }
            }
            TD nxt = cur; pre = false;
            if (L + Lstep < ntiles) { nxt = make_td(L + Lstep); gemm_pre(nxt.Ap, nxt.lda, nxt.Bp, nxt.ldb); pre = true; }
            switch (mode) {
                case E_SWIGLU: epilogue<E_SWIGLU>(acc, P, brow, bcol, aux); break;
                case E_DOWN: epilogue<E_DOWN>(acc, P, brow, bcol, aux); break;
                case E_WIN: epilogue<E_WIN>(acc, P, brow, bcol, aux); break;
                case E_QRAW: epilogue<E_QRAW>(acc, P, brow, bcol, aux); break;
                case E_KVRAW: epilogue_kv(acc, P, brow, bcol); break;
                case E_S5E: epilogue<E_S5E>(acc, P, brow, bcol, aux);
                    __syncthreads();
                    s5_scan_task(P, aux, 2 * (brow >> 8), (float*)((char*)shm + 32768)); s5_scan_task(P, aux, 2 * (brow >> 8) + 1, (float*)((char*)shm + 32768));
                    break;
                case E_S5Y: epilogue<E_S5Y>(acc, P, brow, bcol, aux); break;
                case E_GLU: epilogue<E_GLU>(acc, P, brow, bcol, aux); break;
                case E_WOUT: epilogue<E_WOUT>(acc, P, brow, bcol, aux); break;
                case E_PP: epilogue<E_PP>(acc, P, brow, bcol, aux); break;
                default: epilogue<E_PLE>(acc, P, brow, bcol, aux); break;
            }
            cur = nxt;
        }
    }
}

extern "C" void kernel_launch(void* const* d_in, const int* in_sizes, int n_in, void* d_out, int out_size, void* d_ws, size_t ws_size, hipStream_t stream) {
    static int grid = 0;
    if (grid == 0) {
        if (n_in != 35 || ws_size < OFF_BAR + 16384 || out_size != M_TOK * DM) { fprintf(stderr, "kernel_launch: unexpected problem (n_in %d, ws %zu need %zu, out %d)\n", n_in, ws_size, (size_t)WS_END, out_size); grid = -1; return; }
        int dev = 0, cus = 0, per_cu = 0;
        hipGetDevice(&dev); hipDeviceGetAttribute(&cus, hipDeviceAttributeMultiprocessorCount, dev);
        if (hipFuncSetAttribute((const void*)mega, hipFuncAttributeMaxDynamicSharedMemorySize, SHM_B) != hipSuccess) { fprintf(stderr, "kernel_launch: hipFuncSetAttribute failed\n"); grid = -1; return; }
        if (hipOccupancyMaxActiveBlocksPerMultiprocessor(&per_cu, (const void*)mega, 512, SHM_B) != hipSuccess || per_cu < 1) { fprintf(stderr, "kernel_launch: occupancy query failed (%d)\n", per_cu); (void)hipGetLastError(); per_cu = 1; }
        grid = cus * per_cu;
        if (grid > 256) grid = 256;
        grid &= ~7;
    }
    if (grid <= 0) return;
    Params P{};
    const float** fp = (const float**)&P.norm_ffn1;
    P.x = (const float*)d_in[0]; P.p = (const float*)d_in[1]; P.pos = (const int*)d_in[2];
    for (int i = 3; i < 35; ++i) fp[i - 3] = (const float*)d_in[i];
    P.out = (float*)d_out; P.ws = (char*)d_ws;
#if MK_MULTI
    for (int ph = 0; ph < 12; ++ph) { P.ph_lo = ph; P.ph_hi = ph + 1; hipLaunchKernelGGL(mega, dim3(grid), dim3(512), SHM_B, stream, P); }
#else
    P.ph_lo = 0; P.ph_hi = 12;
    (void)hipMemsetAsync((char*)d_ws + OFF_BAR, 0, 16384, stream);
    void* args[] = {&P};
    hipError_t e = hipLaunchCooperativeKernel((void*)mega, dim3(grid), dim3(512), args, SHM_B, stream);
    if (e != hipSuccess) fprintf(stderr, "cooperative launch failed: %s (grid %d)\n", hipGetErrorString(e), grid);
#endif
}
```

```cpp
#include <hip/hip_runtime.h>
#include <hip/hip_cooperative_groups.h>
#include <cstdint>
#include <cstdio>
namespace cg = cooperative_groups;

typedef unsigned short bf16_t;
typedef short bf16x8 __attribute__((ext_vector_type(8)));
typedef float f32x4 __attribute__((ext_vector_type(4)));
typedef float f32x16 __attribute__((ext_vector_type(16)));
typedef unsigned u32x2 __attribute__((ext_vector_type(2)));
typedef unsigned u32x4 __attribute__((ext_vector_type(4)));

#ifndef MK_MULTI
#define MK_MULTI 0
#endif
#ifndef PROBE_MASK
#define PROBE_MASK 0
#endif
#ifndef PROBE_SEL
#define PROBE_SEL 0
#endif

constexpr int M_TOK = 32768, DM = 1024, DFF = 2816, SEQ = 4096;
constexpr int BM = 256, BK = 64, HALF = 128, HT = HALF * BK, SHM_B = 8 * HT * 2;
constexpr float EPS = 1e-6f;

constexpr size_t SZ_SS = (size_t)48 * M_TOK * 4;
constexpr size_t OFF_SS = 0;
constexpr size_t OFF_W1 = OFF_SS + SZ_SS;
constexpr size_t OFF_WD1 = OFF_W1 + (size_t)5632 * 1024 * 2;
constexpr size_t OFF_W2 = OFF_WD1 + (size_t)1024 * 2816 * 2;
constexpr size_t OFF_WD2 = OFF_W2 + (size_t)5632 * 1024 * 2;
constexpr size_t OFF_WIN = OFF_WD2 + (size_t)1024 * 2816 * 2;
constexpr size_t OFF_WUQ = OFF_WIN + (size_t)1280 * 1024 * 2;
constexpr size_t OFF_WUKV = OFF_WUQ + (size_t)768 * 384 * 2;
constexpr size_t OFF_WGLU = OFF_WUKV + (size_t)1024 * 256 * 2;
constexpr size_t OFF_WOUT = OFF_WGLU + (size_t)512 * 512 * 2;
constexpr size_t OFF_WPG = OFF_WOUT + (size_t)1024 * 1024 * 2;
constexpr size_t OFF_WPP = OFF_WPG + (size_t)1024 * 1024 * 2;
constexpr size_t OFF_TAB = OFF_WPP + (size_t)1024 * 256 * 2;
constexpr size_t OFF_KTAB = OFF_TAB + (size_t)M_TOK * 32 * 4;
constexpr size_t OFF_PB = OFF_KTAB + (size_t)32 * 32 * 256 * 4;
constexpr size_t OFF_HB = OFF_PB + (size_t)M_TOK * 256 * 2;
constexpr size_t OFF_HBUF = OFF_HB + (size_t)M_TOK * 1024 * 2;
constexpr size_t OFF_S5 = OFF_HBUF + (size_t)M_TOK * 1024 * 4;
constexpr size_t OFF_MQ = OFF_S5;
constexpr size_t OFF_PM = OFF_MQ + (size_t)32 * 512 * 640 * 2;
constexpr size_t OFF_A2 = OFF_PM + (size_t)32 * 256 * 512 * 2;
constexpr size_t OFF_PP = OFF_HBUF + (size_t)64 * 1024 * 1024;
constexpr size_t OFF_ACT = OFF_A2 + (size_t)32 * 1024 * 640 * 2;
constexpr size_t OFF_CQB = OFF_ACT;
constexpr size_t OFF_CKVB = OFF_CQB + (size_t)M_TOK * 384 * 2;
constexpr size_t OFF_KPE = OFF_CKVB + (size_t)M_TOK * 256 * 2;
constexpr size_t OFF_QRAW = OFF_KPE + (size_t)M_TOK * 32 * 4;
constexpr size_t OFF_KVRAW = OFF_QRAW + (size_t)M_TOK * 768 * 2;
constexpr size_t OFF_E = OFF_KVRAW + (size_t)M_TOK * 1024 * 2;
constexpr size_t OFF_ACT_END = OFF_E + (size_t)32 * 1024 * 128 * 4;
constexpr size_t WS_END = OFF_ACT + (size_t)M_TOK * 2816 * 2;
static_assert(OFF_ACT_END <= WS_END, "act region overflow");
static_assert(OFF_PP + (size_t)M_TOK * 1024 * 2 <= OFF_S5, "pp overflow");
constexpr size_t OFF_BAR = WS_END;
static_assert(OFF_BAR + 16384 <= (size_t)536870912, "workspace too large");

struct Params {
    const float *x, *p; const int* pos;
    const float *norm_ffn1, *w1g, *w1u, *w1d, *norm_mix, *w_in, *lam_re, *lam_im, *log_dt, *b_re, *b_im, *c_re, *c_im, *ssm_d, *w_glu, *b_glu,
        *q_norm, *w_uq, *kv_norm, *w_ukv, *qkn_q, *qkn_k, *on_ssm, *on_att, *w_out, *norm_ffn2, *w2g, *w2u, *w2d, *norm_ple, *w_pg, *w_pp;
    float* out; char* ws;
    int ph_lo, ph_hi; long atom_off;
};

extern __shared__ __attribute__((aligned(16))) bf16_t shm[];
#ifndef PROBE_PH
#define PROBE_PH -1
#endif
#if PROBE_PH >= 0
__shared__ long s_aoff;
#define ATOM_OFF s_aoff
#else
#define ATOM_OFF 0
#endif

__device__ __forceinline__ unsigned pk_bf16(float lo, float hi) { unsigned r; asm volatile("v_cvt_pk_bf16_f32 %0, %1, %2" : "=v"(r) : "v"(lo), "v"(hi)); return r; }
__device__ __forceinline__ float bf_lo(unsigned u) { return __uint_as_float(u << 16); }
__device__ __forceinline__ float bf_hi(unsigned u) { return __uint_as_float(u & 0xffff0000u); }
__device__ __forceinline__ float sigmoidf_(float v) { return __builtin_amdgcn_rcpf(1.f + __expf(-v)); }
__device__ __forceinline__ void cisf(float ang, float& c, float& s) { float r = ang * 0.15915494309189535f; r -= floorf(r); c = __builtin_amdgcn_cosf(r); s = __builtin_amdgcn_sinf(r); }

__device__ __forceinline__ int lds_byte(int r, int c) { int st = (r >> 4) * 2 + (c >> 5), rr = r & 15, cc = c & 31, ob = rr * 64 + cc * 2; return st * 1024 + (ob ^ (((ob >> 9) & 1) << 5)); }
__device__ __forceinline__ void stage_rc(int b, int& R, int& C) { int st = b / 1024, sb = b % 1024, swz = sb ^ (((sb >> 9) & 1) << 5); R = (st >> 1) * 16 + swz / 64; C = (st & 1) * 32 + (swz % 64) / 2; }

#define LAS __attribute__((address_space(3)))
constexpr int HTB = HT * 2;
#define SA(b, h) (((b) * 2 + (h)) * HTB)
#define SB(b, h) ((4 + (b) * 2 + (h)) * HTB)
#define STAGE(bufoff, gbase, voff) do { _Pragma("unroll") for (int _i = 0; _i < 2; ++_i) \
    __builtin_amdgcn_global_load_lds((const unsigned*)((const char*)(gbase) + (voff)[_i]), (LAS unsigned*)(lds + (bufoff) + ldsw + _i * 8192), 16, 0, 0); } while (0)
#define LDA(dst, b, h) do { _Pragma("unroll") for (int m = 0; m < 4; ++m) _Pragma("unroll") for (int k = 0; k < 2; ++k) dst[m][k] = *(const LAS bf16x8*)(lds + SA(b, h) + aoff + m * 2048 + k * 1024); } while (0)
#define LDB(dst, b, h) do { _Pragma("unroll") for (int n = 0; n < 2; ++n) _Pragma("unroll") for (int k = 0; k < 2; ++k) dst[n][k] = *(const LAS bf16x8*)(lds + SB(b, h) + boff + n * 2048 + k * 1024); } while (0)
#define MMA(ai, bj, At_, Bt_) do { __builtin_amdgcn_s_setprio(1); _Pragma("unroll") for (int m = 0; m < 4; ++m) _Pragma("unroll") for (int n = 0; n < 2; ++n) _Pragma("unroll") for (int k = 0; k < 2; ++k) \
      acc[ai][bj][m][n] = __builtin_amdgcn_mfma_f32_16x16x32_bf16(Bt_[n][k], At_[m][k], acc[ai][bj][m][n], 0, 0, 0); \
    __builtin_amdgcn_s_setprio(0); } while (0)
#define WAIT_V(n) asm volatile("s_waitcnt vmcnt(" #n ")" ::: "memory")
#define WAIT_L(n) asm volatile("s_waitcnt lgkmcnt(" #n ")" ::: "memory")
#define BAR __builtin_amdgcn_s_barrier()
#define SCHED __builtin_amdgcn_sched_barrier(0)

__device__ __forceinline__ void gemm_pre(const char* cA, int lda, const char* cB, int ldb) {
    LAS unsigned char* lds = (LAS unsigned char*)shm;
    int tid = threadIdx.x; asm volatile("" : "+v"(tid));
    const int wid = __builtin_amdgcn_readfirstlane(tid >> 6);
    unsigned voffA[2], voffB[2];
#pragma unroll
    for (int i = 0; i < 2; ++i) { int R, C; stage_rc(tid * 16 + i * 8192, R, C); const int rho = R & 31, Rb = (R & ~31) + 8 * ((rho & 15) >> 2) + 4 * (rho >> 4) + (rho & 3);
        voffA[i] = (unsigned)(R * lda + C) * 2u; voffB[i] = (unsigned)(Rb * ldb + C) * 2u; }
    const size_t hA = (size_t)HALF * lda * 2, hB = (size_t)HALF * ldb * 2;
    const unsigned ldsw = (unsigned)wid * 1024u;
    STAGE(SB(0, 0), cB, voffB); STAGE(SA(0, 0), cA, voffA); STAGE(SB(0, 1), cB + hB, voffB); STAGE(SA(0, 1), cA + hA, voffA);
}
__device__ __forceinline__ void gemm_loop(f32x4 (&acc)[2][2][4][2], const char* cA, int lda, const char* cB, int ldb, int nt, bool pre) {
    LAS unsigned char* lds = (LAS unsigned char*)shm;
    int tid = threadIdx.x; asm volatile("" : "+v"(tid));
    const int wid = __builtin_amdgcn_readfirstlane(tid >> 6), lane = tid & 63, wr = wid >> 2, wc = wid & 3, fr = lane & 15, fq = lane >> 4;
    unsigned voffA[2], voffB[2];
#pragma unroll
    for (int i = 0; i < 2; ++i) { int R, C; stage_rc(tid * 16 + i * 8192, R, C); const int rho = R & 31, Rb = (R & ~31) + 8 * ((rho & 15) >> 2) + 4 * (rho >> 4) + (rho & 3);
        voffA[i] = (unsigned)(R * lda + C) * 2u; voffB[i] = (unsigned)(Rb * ldb + C) * 2u; }
    const size_t hA = (size_t)HALF * lda * 2, hB = (size_t)HALF * ldb * 2, kstep = BK * 2;
    const unsigned ldsw = (unsigned)wid * 1024u;
    const int aoff = lds_byte(wr * 64 + fr, fq * 8), boff = lds_byte(wc * 32 + fr, fq * 8);
    bf16x8 At[4][2], B0[2][2], B1[2][2];
    if (!pre) { STAGE(SB(0, 0), cB, voffB); STAGE(SA(0, 0), cA, voffA); STAGE(SB(0, 1), cB + hB, voffB); STAGE(SA(0, 1), cA + hA, voffA); }
    if (wr == 1) BAR;
    WAIT_V(4); BAR;
    STAGE(SB(1, 0), cB + kstep, voffB); STAGE(SA(1, 0), cA + kstep, voffA); STAGE(SB(1, 1), cB + hB + kstep, voffB);
    WAIT_V(6); BAR;
    for (int t = 0; t < nt - 2; t += 2) {
        const char* a1 = cA + (size_t)(t + 1) * kstep; const char* a2 = a1 + kstep; const char* a3 = a2 + kstep;
        const char* b2 = cB + (size_t)(t + 2) * kstep; const char* b3 = b2 + kstep;
        LDB(B0, 0, 0); SCHED; LDA(At, 0, 0); STAGE(SA(1, 1), a1 + hA, voffA);
        WAIT_L(8); BAR; WAIT_L(0); MMA(0, 0, At, B0); BAR; SCHED;
        LDB(B1, 0, 1); STAGE(SB(0, 0), b2, voffB);
        BAR; WAIT_L(0); MMA(0, 1, At, B1); BAR;
        LDA(At, 0, 1); STAGE(SA(0, 0), a2, voffA);
        BAR; WAIT_L(0); MMA(1, 0, At, B0); BAR; SCHED;
        STAGE(SB(0, 1), b2 + hB, voffB);
        WAIT_V(6); BAR; MMA(1, 1, At, B1); BAR;
        LDB(B0, 1, 0); SCHED; LDA(At, 1, 0); STAGE(SA(0, 1), a2 + hA, voffA);
        WAIT_L(8); BAR; WAIT_L(0); MMA(0, 0, At, B0); BAR; SCHED;
        LDB(B1, 1, 1); STAGE(SB(1, 0), b3, voffB);
        BAR; WAIT_L(0); MMA(0, 1, At, B1); BAR;
        LDA(At, 1, 1); STAGE(SA(1, 0), a3, voffA);
        BAR; WAIT_L(0); MMA(1, 0, At, B0); BAR; SCHED;
        STAGE(SB(1, 1), b3 + hB, voffB);
        WAIT_V(6); BAR; MMA(1, 1, At, B1); BAR;
    }
    { const char* a1 = cA + (size_t)(nt - 1) * kstep;
      LDB(B0, 0, 0); LDA(At, 0, 0); STAGE(SA(1, 1), a1 + hA, voffA);
      BAR; WAIT_L(0); MMA(0, 0, At, B0); BAR;
      LDB(B1, 0, 1); BAR; WAIT_L(0); MMA(0, 1, At, B1); BAR;
      LDA(At, 0, 1); WAIT_V(4); BAR; WAIT_L(0); MMA(1, 0, At, B0); MMA(1, 1, At, B1); BAR; }
    { LDB(B0, 1, 0); LDA(At, 1, 0); WAIT_V(2); BAR; WAIT_L(0); MMA(0, 0, At, B0); BAR;
      LDB(B1, 1, 1); WAIT_V(0); BAR; WAIT_L(0); MMA(0, 1, At, B1); BAR;
      LDA(At, 1, 1); BAR; WAIT_L(0); MMA(1, 0, At, B0); MMA(1, 1, At, B1); BAR; }
    if (wr == 0) BAR;
}

__device__ __forceinline__ void tile_map(int L, int nM, int nN, int& pm, int& pn) {
    const int nwg = nM * nN, q = nwg / 8, r = nwg % 8, xcd = L % 8, off = L / 8;
    const int wgid = (xcd < r ? xcd * (q + 1) : r * (q + 1) + (xcd - r) * q) + off;
    const int nig = 8 * nN, gid = wgid / nig, fm = gid * 8, gsz = (nM - fm) < 8 ? (nM - fm) : 8;
    pm = fm + ((wgid % nig) % gsz); pn = (wgid % nig) / gsz;
}

__device__ __forceinline__ void ld8(const bf16_t* p, float (&v)[8]) { const u32x4 w = *(const u32x4*)p;
    v[0] = bf_lo(w.x); v[1] = bf_hi(w.x); v[2] = bf_lo(w.y); v[3] = bf_hi(w.y); v[4] = bf_lo(w.z); v[5] = bf_hi(w.z); v[6] = bf_lo(w.w); v[7] = bf_hi(w.w); }
__device__ __forceinline__ void ld8f(const float* p, float (&v)[8]) { const f32x4 a = *(const f32x4*)p, b = *(const f32x4*)(p + 4);
    v[0] = a[0]; v[1] = a[1]; v[2] = a[2]; v[3] = a[3]; v[4] = b[0]; v[5] = b[1]; v[6] = b[2]; v[7] = b[3]; }
__device__ __forceinline__ void st8(bf16_t* p, const float (&v)[8]) { u32x4 w; w.x = pk_bf16(v[0], v[1]); w.y = pk_bf16(v[2], v[3]); w.z = pk_bf16(v[4], v[5]); w.w = pk_bf16(v[6], v[7]); *(u32x4*)p = w; }
__device__ __forceinline__ float sq8(const float (&v)[8]) { float s = 0.f;
#pragma unroll
    for (int i = 0; i < 8; ++i) s += v[i] * v[i]; return s; }


enum { E_SWIGLU = 0, E_DOWN, E_WIN, E_QRAW, E_KVRAW, E_S5E, E_S5Y, E_GLU, E_WOUT, E_PP, E_PLE };

#define WSP(T, off) ((T*)(P.ws + (off)))

__device__ __forceinline__ void store_bf4(bf16_t* p, f32x4 v) { u32x2 w; w.x = pk_bf16(v[0], v[1]); w.y = pk_bf16(v[2], v[3]); *(u32x2*)p = w; }

template <int MODE> __device__ __forceinline__ void epilogue(const f32x4 (&acc)[2][2][4][2], const Params& P, int brow, int bcol, int aux) {
    int tid_ = threadIdx.x; asm volatile("" : "+v"(tid_));
    const int wid = tid_ >> 6, lane = tid_ & 63, wr = wid >> 2, wc = wid & 3, fr = lane & 15, fq = lane >> 4;
    float* ss = WSP(float, OFF_SS);
#pragma unroll
    for (int ai = 0; ai < 2; ++ai)
#pragma unroll
        for (int m = 0; m < 4; ++m) {
            const int row = brow + ai * HALF + wr * 64 + m * 16 + fr;
            if constexpr (MODE == E_SWIGLU) {
                const float rs = rsqrtf(ss[(aux ? 2 : 0) * M_TOK + row] * (1.f / 1024.f) + EPS);
                bf16_t* act = WSP(bf16_t, OFF_ACT);
                float o[8];
#pragma unroll
                for (int n = 0; n < 2; ++n) {
                    const f32x4 g = acc[ai][0][m][n] * rs, u = acc[ai][1][m][n] * rs;
#pragma unroll
                    for (int j = 0; j < 4; ++j) o[n * 4 + j] = g[j] * sigmoidf_(g[j]) * u[j];
                }
                st8(act + (long)row * DFF + (bcol >> 1) + wc * 32 + fq * 8, o);
            } else if constexpr (MODE == E_DOWN || MODE == E_WOUT) {
                bf16_t* hb = WSP(bf16_t, OFF_HB);
                float sc = 0.5f; int ssi = aux ? 3 : 1;
                if constexpr (MODE == E_WOUT) { sc = rsqrtf(ss[7 * M_TOK + row] * (1.f / 512.f) + EPS); ssi = 2; }
                float sq = 0.f;
                if constexpr (MODE == E_DOWN || MODE == E_WOUT) {
                    u32x4 rr8[2];
#pragma unroll
                    for (int bj = 0; bj < 2; ++bj) rr8[bj] = *(const u32x4*)(hb + (long)row * DM + bcol + bj * HALF + wc * 32 + fq * 8);
#pragma unroll
                    for (int bj = 0; bj < 2; ++bj) {
                        const f32x4 r0 = {bf_lo(rr8[bj].x), bf_hi(rr8[bj].x), bf_lo(rr8[bj].y), bf_hi(rr8[bj].y)}, r1 = {bf_lo(rr8[bj].z), bf_hi(rr8[bj].z), bf_lo(rr8[bj].w), bf_hi(rr8[bj].w)};
                        const f32x4 v0 = r0 + acc[ai][bj][m][0] * sc, v1 = r1 + acc[ai][bj][m][1] * sc;
                        u32x4 w; w.x = pk_bf16(v0[0], v0[1]); w.y = pk_bf16(v0[2], v0[3]); w.z = pk_bf16(v1[0], v1[1]); w.w = pk_bf16(v1[2], v1[3]);
                        *(u32x4*)(hb + (long)row * DM + bcol + bj * HALF + wc * 32 + fq * 8) = w;
                        sq += v0[0] * v0[0] + v0[1] * v0[1] + v0[2] * v0[2] + v0[3] * v0[3] + v1[0] * v1[0] + v1[1] * v1[1] + v1[2] * v1[2] + v1[3] * v1[3];
                    }
                } else {
                u32x2 rr[2][2];
#pragma unroll
                for (int bj = 0; bj < 2; ++bj)
#pragma unroll
                    for (int n = 0; n < 2; ++n) rr[bj][n] = *(const u32x2*)(hb + (long)row * DM + bcol + bj * HALF + wc * 32 + n * 16 + fq * 4);
#pragma unroll
                for (int bj = 0; bj < 2; ++bj)
#pragma unroll
                    for (int n = 0; n < 2; ++n) {
                        const int col = bcol + bj * HALF + wc * 32 + n * 16 + fq * 4;
                        const f32x4 r = {bf_lo(rr[bj][n].x), bf_hi(rr[bj][n].x), bf_lo(rr[bj][n].y), bf_hi(rr[bj][n].y)};
                        const f32x4 v = r + acc[ai][bj][m][n] * sc;
                        store_bf4(hb + (long)row * DM + col, v);
                        sq += v[0] * v[0] + v[1] * v[1] + v[2] * v[2] + v[3] * v[3];
                    }
                }
                sq += __shfl_xor(sq, 16); sq += __shfl_xor(sq, 32);
                if (fq == 0) unsafeAtomicAdd(ss + ATOM_OFF + ssi * M_TOK + row, sq);
            } else if constexpr (MODE == E_WIN) {
                const float rs = rsqrtf(ss[1 * M_TOK + row] * (1.f / 1024.f) + EPS);
#pragma unroll
                for (int bj = 0; bj < 2; ++bj) {
                    const int seg = (bcol >> 7) + bj;
                    const int col0 = bcol + bj * HALF + wc * 32 + fq * 8;
                    const f32x4 v0 = acc[ai][bj][m][0] * rs, v1 = acc[ai][bj][m][1] * rs;
                    u32x4 w; w.x = pk_bf16(v0[0], v0[1]); w.y = pk_bf16(v0[2], v0[3]); w.z = pk_bf16(v1[0], v1[1]); w.w = pk_bf16(v1[2], v1[3]);
                    float sq = v0[0] * v0[0] + v0[1] * v0[1] + v0[2] * v0[2] + v0[3] * v0[3] + v1[0] * v1[0] + v1[1] * v1[1] + v1[2] * v1[2] + v1[3] * v1[3];
                    if (seg < 4) {
                        const int g = col0 >> 4, hi = col0 & 15;
                        *(u32x4*)(WSP(bf16_t, OFF_A2) + ((long)g * 1024 + (row >> 5)) * 640 + (row & 31) * 16 + hi) = w;
                    } else if (seg < 7) {
                        *(u32x4*)(WSP(bf16_t, OFF_CQB) + (long)row * 384 + (col0 - 512)) = w;
                    } else if (seg < 9) {
                        *(u32x4*)(WSP(bf16_t, OFF_CKVB) + (long)row * 256 + (col0 - 896)) = w;
                    } else if (wc == 0) {
                        float mine[8] = {v0[0], v0[1], v0[2], v0[3], v1[0], v1[1], v1[2], v1[3]}, oth[8];
#pragma unroll
                        for (int i = 0; i < 8; ++i) oth[i] = __shfl_xor(mine[i], 32);
                        float q2 = sq; q2 += __shfl_xor(q2, 16); q2 += __shfl_xor(q2, 32);
                        if (fq == 0) ss[8 * M_TOK + row] = q2;
                        const int ib = (fq & 1) * 8;
                        float cs[8], sn[8], g1[8], g2[8], o[8];
                        ld8f(WSP(float, OFF_TAB) + (long)row * 32 + ib, cs); ld8f(WSP(float, OFF_TAB) + (long)row * 32 + 16 + ib, sn);
                        ld8f(P.qkn_k + 64 + ib, g1); ld8f(P.qkn_k + 80 + ib, g2);
#pragma unroll
                        for (int i = 0; i < 8; ++i) { const float x1 = (fq < 2 ? mine[i] : oth[i]) * g1[i], x2 = (fq < 2 ? oth[i] : mine[i]) * g2[i];
                            o[i] = fq < 2 ? (x1 * cs[i] - x2 * sn[i]) : (x1 * sn[i] + x2 * cs[i]); }
                        st8(WSP(bf16_t, OFF_KPE) + (long)row * 32 + (fq < 2 ? 0 : 16) + ib, o);
                    }
                    if (seg >= 4 && seg < 9) {
                        sq += __shfl_xor(sq, 16); sq += __shfl_xor(sq, 32);
                        if (fq == 0) unsafeAtomicAdd(ss + ATOM_OFF + (seg < 7 ? 4 : 5) * M_TOK + row, sq);
                    }
                }
            } else if constexpr (MODE == E_QRAW || MODE == E_KVRAW) {
                const float rs = (MODE == E_QRAW) ? rsqrtf(ss[4 * M_TOK + row] * (1.f / 384.f) + EPS) : rsqrtf(ss[5 * M_TOK + row] * (1.f / 256.f) + EPS);
                bf16_t* o = (MODE == E_QRAW) ? WSP(bf16_t, OFF_QRAW) : WSP(bf16_t, OFF_KVRAW);
                const int ld = (MODE == E_QRAW) ? 768 : 1024;
#pragma unroll
                for (int bj = 0; bj < 2; ++bj) {
                    const f32x4 v0 = acc[ai][bj][m][0] * rs, v1 = acc[ai][bj][m][1] * rs;
                    u32x4 w; w.x = pk_bf16(v0[0], v0[1]); w.y = pk_bf16(v0[2], v0[3]); w.z = pk_bf16(v1[0], v1[1]); w.w = pk_bf16(v1[2], v1[3]);
                    *(u32x4*)(o + (long)row * ld + bcol + bj * HALF + wc * 32 + fq * 8) = w;
                }
            } else if constexpr (MODE == E_S5E) {
                float* E = WSP(float, OFF_E) + (long)aux * 1024 * 128 + (long)row * 128 + wc * 32 + fq * 8;
                *(f32x4*)E = acc[ai][0][m][0]; *(f32x4*)(E + 4) = acc[ai][0][m][1];
            } else if constexpr (MODE == E_S5Y) {
                bf16_t* yg = (bf16_t*)P.out + (long)M_TOK * 1024;
#pragma unroll
                for (int bj = 0; bj < 2; ++bj) {
                    const int col = bcol + bj * HALF + wc * 32 + fq * 8, t = col >> 4, ho = col & 15;
                    float o[8];
#pragma unroll
                    for (int j = 0; j < 4; ++j) { const float a = acc[ai][bj][m][0][j], b = acc[ai][bj][m][1][j];
                        o[j] = a * sigmoidf_(1.5957691216f * (a + 0.044715f * a * a * a)); o[4 + j] = b * sigmoidf_(1.5957691216f * (b + 0.044715f * b * b * b)); }
                    st8(yg + ((long)row * 32 + t) * 512 + aux * 16 + ho, o);
                }
            } else if constexpr (MODE == E_GLU) {
                const bf16_t* yg = (const bf16_t*)P.out + (long)M_TOK * 1024; bf16_t* ymix = (bf16_t*)P.out;
                float sq = 0.f;
#pragma unroll
                for (int bj = 0; bj < 2; ++bj) {
                    const int col = bcol + bj * HALF + wc * 32 + fq * 8;
                    float bb[8], yy[8], o[8];
                    ld8f(P.b_glu + col, bb); ld8(yg + (long)row * 512 + col, yy);
#pragma unroll
                    for (int j = 0; j < 4; ++j) { o[j] = yy[j] * sigmoidf_(acc[ai][bj][m][0][j] + bb[j]); o[4 + j] = yy[4 + j] * sigmoidf_(acc[ai][bj][m][1][j] + bb[4 + j]); }
                    st8(ymix + (long)row * 1024 + col, o);
                    sq += sq8(o);
                }
                sq += __shfl_xor(sq, 16); sq += __shfl_xor(sq, 32);
                if (fq == 0) unsafeAtomicAdd(ss + ATOM_OFF + 6 * M_TOK + row, sq);
            } else if constexpr (MODE == E_PP) {
                bf16_t* pp = WSP(bf16_t, OFF_PP);
#pragma unroll
                for (int bj = 0; bj < 2; ++bj) {
                    const f32x4 v0 = acc[ai][bj][m][0], v1 = acc[ai][bj][m][1];
                    u32x4 w; w.x = pk_bf16(v0[0], v0[1]); w.y = pk_bf16(v0[2], v0[3]); w.z = pk_bf16(v1[0], v1[1]); w.w = pk_bf16(v1[2], v1[3]);
                    *(u32x4*)(pp + (long)row * 1024 + bcol + bj * HALF + wc * 32 + fq * 8) = w;
                }
            } else if constexpr (MODE == E_PLE) {
                const float rs = rsqrtf(ss[3 * M_TOK + row] * (1.f / 1024.f) + EPS);
                const bf16_t* pp = WSP(bf16_t, OFF_PP); const bf16_t* hb = WSP(bf16_t, OFF_HB);
#pragma unroll
                for (int bj = 0; bj < 2; ++bj) {
                    const int col = bcol + bj * HALF + wc * 32 + fq * 8;
                    float h8[8], p8[8];
                    ld8(hb + (long)row * DM + col, h8); ld8(pp + (long)row * 1024 + col, p8);
                    f32x4 o0, o1;
#pragma unroll
                    for (int j = 0; j < 4; ++j) { o0[j] = h8[j] + sigmoidf_(acc[ai][bj][m][0][j] * rs) * p8[j]; o1[j] = h8[4 + j] + sigmoidf_(acc[ai][bj][m][1][j] * rs) * p8[4 + j]; }
                    *(f32x4*)(P.out + (long)row * DM + col) = o0; *(f32x4*)(P.out + (long)row * DM + col + 4) = o1;
                }
            }
        }
}

__device__ __forceinline__ void epilogue_kv(const f32x4 (&acc)[2][2][4][2], const Params& P, int brow, int bcol) {
    int tid_ = threadIdx.x; asm volatile("" : "+v"(tid_));
    const int wid = tid_ >> 6, lane = tid_ & 63, wr = wid >> 2, wc = wid & 3, fr = lane & 15, fq = lane >> 4;
    const float* ss = WSP(float, OFF_SS);
    float* exch = (float*)((char*)shm + 32768);
    if (wc < 2) {
#pragma unroll
        for (int ai = 0; ai < 2; ++ai)
#pragma unroll
            for (int m = 0; m < 4; ++m) {
                const int rl = ai * HALF + wr * 64 + m * 16 + fr;
                const float rs = rsqrtf(ss[5 * M_TOK + brow + rl] * (1.f / 256.f) + EPS);
#pragma unroll
                for (int bj = 0; bj < 2; ++bj) {
                    float sq = 0.f;
#pragma unroll
                    for (int n = 0; n < 2; ++n) { const f32x4 v = acc[ai][bj][m][n] * rs; sq += v[0] * v[0] + v[1] * v[1] + v[2] * v[2] + v[3] * v[3]; }
                    sq += __shfl_xor(sq, 16); sq += __shfl_xor(sq, 32);
                    if (fq == 0) exch[(rl * 2 + bj) * 2 + wc] = sq;
                }
            }
    }
    __syncthreads();
#pragma unroll
    for (int ai = 0; ai < 2; ++ai)
#pragma unroll
        for (int m = 0; m < 4; ++m) {
            const int rl = ai * HALF + wr * 64 + m * 16 + fr, row = brow + rl, b = row >> 12, l = row & 4095;
            const float rs = rsqrtf(ss[5 * M_TOK + row] * (1.f / 256.f) + EPS), pe = ss[8 * M_TOK + row];
#pragma unroll
            for (int bj = 0; bj < 2; ++bj) {
                const int h = (bcol >> 7) + bj;
                const float rk = rsqrtf((exch[(rl * 2 + bj) * 2] + exch[(rl * 2 + bj) * 2 + 1] + pe) * (1.f / 96.f) + EPS);
                bf16_t* kf = WSP(bf16_t, OFF_HBUF) + ((long)(b * 8 + h) * SEQ + l) * 96;
                if (wc < 2) {
                    const f32x4 v0 = acc[ai][bj][m][0] * (rs * rk), v1 = acc[ai][bj][m][1] * (rs * rk);
                    u32x4 w; w.x = pk_bf16(v0[0], v0[1]); w.y = pk_bf16(v0[2], v0[3]); w.z = pk_bf16(v1[0], v1[1]); w.w = pk_bf16(v1[2], v1[3]);
                    *(u32x4*)(kf + wc * 32 + fq * 8) = w;
                } else {
                    const f32x4 v0 = acc[ai][bj][m][0] * rs, v1 = acc[ai][bj][m][1] * rs;
                    u32x4 w; w.x = pk_bf16(v0[0], v0[1]); w.y = pk_bf16(v0[2], v0[3]); w.z = pk_bf16(v1[0], v1[1]); w.w = pk_bf16(v1[2], v1[3]);
                    *(u32x4*)(WSP(bf16_t, OFF_KVRAW) + (long)row * 1024 + bcol + bj * HALF + wc * 32 + fq * 8) = w;
                    if (wc == 2 + bj) {
                        float kv[8]; ld8(WSP(bf16_t, OFF_KPE) + (long)row * 32 + fq * 8, kv);
#pragma unroll
                        for (int i = 0; i < 8; ++i) kv[i] *= rk;
                        st8(kf + 64 + fq * 8, kv);
                    }
                }
            }
        }
}

namespace pg8 {
#define PG8_LAS __attribute__((address_space(3)))
typedef unsigned short bf16_t;
typedef short bf16x8 __attribute__((ext_vector_type(8)));
typedef float f32x4 __attribute__((ext_vector_type(4)));
typedef unsigned u32x4 __attribute__((ext_vector_type(4)));
constexpr int BM = 256, BK = 64, HALF = 128, HTB = HALF * BK * 2  , STAGE_BYTES = 8 * HTB, NXCD = 8, WGM = 8;

__host__ __device__ __forceinline__ int lds_byte(int r, int c) { const int st = (r >> 4) * 2 + (c >> 5), rr = r & 15, cc = c & 31, ob = rr * 64 + cc * 2; return st * 1024 + (ob ^ (((ob >> 9) & 1) << 5)); }
__host__ __device__ __forceinline__ void stage_rc(int b, int& R, int& C) { const int st = b / 1024, sb = b % 1024, swz = sb ^ (((sb >> 9) & 1) << 5); R = (st >> 1) * 16 + swz / 64; C = (st & 1) * 32 + (swz % 64) / 2; }
__host__ __device__ __forceinline__ int perm32(int rho) { const int n = rho >> 4, i = rho & 15; return 8 * (i >> 2) + 4 * n + (i & 3); }

struct Unit { int pm, pn; };
struct Gemm { const bf16_t* A; const bf16_t* Bt; int M, N, K; };

struct StaticOrder {
    int nM, nN, nwg, G, c;
    __host__ __device__ void init(int M, int N, int G_, int c_) { nM = M / BM; nN = N / BM; nwg = nM * nN; G = G_; c = c_; }
    __host__ __device__ bool next(int i, Unit& u) const {
        const long L = (long)i * G + c; if (L >= nwg) return false;
        int wgid = (int)L; { const int q = nwg / NXCD, r = nwg % NXCD, xcd = wgid % NXCD, off = wgid / NXCD; wgid = (xcd < r ? xcd * (q + 1) : r * (q + 1) + (xcd - r) * q) + off; }
        const int nig = WGM * nN, gid = wgid / nig, fm = gid * WGM, gsz = (nM - fm) < WGM ? (nM - fm) : WGM;
        u.pm = fm + ((wgid % nig) % gsz); u.pn = (wgid % nig) / gsz; return true;
    }
    __device__ __forceinline__ void a_ready(const Unit&) const {}
    __device__ __forceinline__ void done(const Unit&) const {}
};
template <class Epi, class Sched, bool ALIGN_EPI = false, bool SP2 = false>
__device__ __forceinline__ void gemm_phase(PG8_LAS unsigned char* lds, const Gemm g, const Sched& S, const Epi& E) {
    int tid = threadIdx.x; asm volatile("" : "+v"(tid));
    const int wid = __builtin_amdgcn_readfirstlane(tid >> 6), lane = tid & 63, wr = wid >> 2, wc = wid & 3, fr = lane & 15, fq = lane >> 4;
    const int K = g.K, nt = K / BK;
    unsigned voffA[2], voffB[2];
#pragma unroll
    for (int i = 0; i < 2; ++i) { int R, C; stage_rc(tid * 16 + i * 8192, R, C); const int Rb = Epi::PERM ? ((R & ~31) + perm32(R & 31)) : R;
        voffA[i] = (unsigned)(R * K + C) * 2u; voffB[i] = (unsigned)(Rb * K + C) * 2u; }
    const size_t kstep = (size_t)(BK * 2);
    const size_t hstep = (size_t)HALF * K * 2;
    const size_t tstep = 2 * hstep;
    const unsigned ldsw = (unsigned)wid * 1024u;
    const int aoff = lds_byte(wr * 64 + fr, fq * 8), boff = lds_byte(wc * 32 + fr, fq * 8);
#define PG8_SA(b, h) (((b) * 2 + (h)) * HTB)
#define PG8_SB(b, h) ((4 + (b) * 2 + (h)) * HTB)
#define PG8_STAGE(bufoff, gbase, voff) do { _Pragma("unroll") for (int _i = 0; _i < 2; ++_i) \
        __builtin_amdgcn_global_load_lds((const unsigned*)((const char*)(gbase) + (voff)[_i]), (PG8_LAS unsigned*)(lds + (bufoff) + ldsw + _i * 8192), 16, 0, 0); } while (0)
#define PG8_LDA(dst, b, h) do { _Pragma("unroll") for (int m = 0; m < 4; ++m) _Pragma("unroll") for (int k = 0; k < 2; ++k) dst[m][k] = *(const PG8_LAS bf16x8*)(lds + PG8_SA(b, h) + aoff + m * 2048 + k * 1024); } while (0)
#define PG8_LDB(dst, b, h) do { _Pragma("unroll") for (int n = 0; n < 2; ++n) _Pragma("unroll") for (int k = 0; k < 2; ++k) dst[n][k] = *(const PG8_LAS bf16x8*)(lds + PG8_SB(b, h) + boff + n * 2048 + k * 1024); } while (0)
#define PG8_MMA(ai, bj, At, Bt) do { __builtin_amdgcn_s_setprio(1); _Pragma("unroll") for (int m = 0; m < 4; ++m) _Pragma("unroll") for (int n = 0; n < 2; ++n) _Pragma("unroll") for (int k = 0; k < 2; ++k) \
        acc[ai][bj][m][n] = __builtin_amdgcn_mfma_f32_16x16x32_bf16(Bt[n][k], At[m][k], acc[ai][bj][m][n], 0, 0, 0); __builtin_amdgcn_s_setprio(0); } while (0)
#define PG8_WAIT_V(n) asm volatile("s_waitcnt vmcnt(" #n ")" ::: "memory")
#define PG8_WAIT_L(n) asm volatile("s_waitcnt lgkmcnt(" #n ")" ::: "memory")
#define PG8_BAR __builtin_amdgcn_s_barrier()
#define PG8_SCHED __builtin_amdgcn_sched_barrier(0)
    Unit cur, nxt; int ui = 0;
    if (!S.next(0, cur)) return;
    f32x4 acc[2][2][4][2];
#pragma unroll
    for (int a = 0; a < 2; ++a)
#pragma unroll
        for (int b = 0; b < 2; ++b)
#pragma unroll
            for (int m = 0; m < 4; ++m)
#pragma unroll
                for (int n = 0; n < 2; ++n) acc[a][b][m][n] = (f32x4){0.f, 0.f, 0.f, 0.f};
    bf16x8 At[4][2], B0[2][2], B1[2][2];
    const char* cA = (const char*)g.A + (size_t)cur.pm * tstep; const char* cB = (const char*)g.Bt + (size_t)cur.pn * tstep;
    S.a_ready(cur);
    if constexpr (SP2) {
        PG8_STAGE(PG8_SB(0, 0), cB, voffB); PG8_STAGE(PG8_SB(0, 1), cB + hstep, voffB); PG8_STAGE(PG8_SA(0, 0), cA, voffA); PG8_STAGE(PG8_SA(0, 1), cA + hstep, voffA);
        if (wr == 1) PG8_BAR;
        PG8_WAIT_V(2); PG8_BAR;
        PG8_STAGE(PG8_SB(1, 0), cB + kstep, voffB); PG8_STAGE(PG8_SA(1, 0), cA + kstep, voffA); PG8_STAGE(PG8_SB(1, 1), cB + hstep + kstep, voffB);
        PG8_WAIT_V(6); PG8_BAR;
    } else {
        PG8_STAGE(PG8_SB(0, 0), cB, voffB); PG8_STAGE(PG8_SA(0, 0), cA, voffA); PG8_STAGE(PG8_SB(0, 1), cB + hstep, voffB); PG8_STAGE(PG8_SA(0, 1), cA + hstep, voffA);
        if (wr == 1) PG8_BAR;
        PG8_WAIT_V(4); PG8_BAR;
        PG8_STAGE(PG8_SB(1, 0), cB + kstep, voffB); PG8_STAGE(PG8_SA(1, 0), cA + kstep, voffA); PG8_STAGE(PG8_SB(1, 1), cB + hstep + kstep, voffB);
        PG8_WAIT_V(6); PG8_BAR;
    }
    for (;;) {
        const bool has_next = S.next(ui + 1, nxt);
        const char* nA = has_next ? (const char*)g.A + (size_t)nxt.pm * tstep : cA; const char* nB = has_next ? (const char*)g.Bt + (size_t)nxt.pn * tstep : cB;
        for (int t = 0; t < nt; t += 2) {
            const bool last = (t == nt - 2);
            const char* a1 = cA + (size_t)(t + 1) * kstep;
            const char* a2 = last ? nA : cA + (size_t)(t + 2) * kstep; const char* b2 = last ? nB : cB + (size_t)(t + 2) * kstep;
            const char* a3 = a2 + kstep; const char* b3 = b2 + kstep;
            if (last && has_next) S.a_ready(nxt);
            if constexpr (SP2) {
            PG8_LDB(B0, 0, 0); PG8_LDB(B1, 0, 1); PG8_SCHED; PG8_LDA(At, 0, 0); PG8_STAGE(PG8_SA(1, 1), a1 + hstep, voffA);
            PG8_WAIT_V(8); PG8_WAIT_L(0); PG8_BAR; PG8_MMA(0, 0, At, B0); PG8_MMA(0, 1, At, B1); PG8_BAR; PG8_SCHED;
            PG8_LDA(At, 0, 1); PG8_STAGE(PG8_SB(0, 0), b2, voffB); PG8_STAGE(PG8_SB(0, 1), b2 + hstep, voffB); PG8_STAGE(PG8_SA(0, 0), a2, voffA);
            PG8_WAIT_V(8); PG8_WAIT_L(0); PG8_BAR; PG8_MMA(1, 0, At, B0); PG8_MMA(1, 1, At, B1); PG8_BAR; PG8_SCHED;
            PG8_LDB(B0, 1, 0); PG8_LDB(B1, 1, 1); PG8_SCHED; PG8_LDA(At, 1, 0); PG8_STAGE(PG8_SA(0, 1), a2 + hstep, voffA);
            PG8_WAIT_V(8); PG8_WAIT_L(0); PG8_BAR; PG8_MMA(0, 0, At, B0); PG8_MMA(0, 1, At, B1); PG8_BAR; PG8_SCHED;
            PG8_LDA(At, 1, 1); PG8_STAGE(PG8_SB(1, 0), b3, voffB); PG8_STAGE(PG8_SB(1, 1), b3 + hstep, voffB); PG8_STAGE(PG8_SA(1, 0), a3, voffA);
            PG8_WAIT_V(8); PG8_WAIT_L(0); PG8_BAR; PG8_MMA(1, 0, At, B0); PG8_MMA(1, 1, At, B1); PG8_BAR; PG8_SCHED;
            } else {
            PG8_LDB(B0, 0, 0); PG8_SCHED; PG8_LDA(At, 0, 0); PG8_STAGE(PG8_SA(1, 1), a1 + hstep, voffA);
            PG8_WAIT_L(8); PG8_BAR; PG8_WAIT_L(0); PG8_MMA(0, 0, At, B0); PG8_BAR; PG8_SCHED;
            PG8_LDB(B1, 0, 1); PG8_STAGE(PG8_SB(0, 0), b2, voffB);
            PG8_BAR; PG8_WAIT_L(0); PG8_MMA(0, 1, At, B1); PG8_BAR;
            PG8_LDA(At, 0, 1); PG8_STAGE(PG8_SA(0, 0), a2, voffA);
            PG8_BAR; PG8_WAIT_L(0); PG8_MMA(1, 0, At, B0); PG8_BAR; PG8_SCHED;
            PG8_STAGE(PG8_SB(0, 1), b2 + hstep, voffB);
            PG8_WAIT_V(6); PG8_BAR; PG8_MMA(1, 1, At, B1); PG8_BAR;
            PG8_LDB(B0, 1, 0); PG8_SCHED; PG8_LDA(At, 1, 0); PG8_STAGE(PG8_SA(0, 1), a2 + hstep, voffA);
            PG8_WAIT_L(8); PG8_BAR; PG8_WAIT_L(0); PG8_MMA(0, 0, At, B0); PG8_BAR; PG8_SCHED;
            PG8_LDB(B1, 1, 1); PG8_STAGE(PG8_SB(1, 0), b3, voffB);
            PG8_BAR; PG8_WAIT_L(0); PG8_MMA(0, 1, At, B1); PG8_BAR;
            PG8_LDA(At, 1, 1); PG8_STAGE(PG8_SA(1, 0), a3, voffA);
            PG8_BAR; PG8_WAIT_L(0); PG8_MMA(1, 0, At, B0); PG8_BAR; PG8_SCHED;
            PG8_STAGE(PG8_SB(1, 1), b3 + hstep, voffB);
            PG8_WAIT_V(6); PG8_BAR; PG8_MMA(1, 1, At, B1); PG8_BAR;
            }
        }
        if constexpr (ALIGN_EPI) { if (wr == 0) PG8_BAR; }
        if constexpr (!Epi::AFTER_DRAIN) { E(acc, cur, wr, wc, fr, fq); S.done(cur); }
        if (!has_next) break;
#pragma unroll
        for (int a = 0; a < 2; ++a)
#pragma unroll
            for (int b = 0; b < 2; ++b)
#pragma unroll
                for (int m = 0; m < 4; ++m)
#pragma unroll
                    for (int n = 0; n < 2; ++n) acc[a][b][m][n] = (f32x4){0.f, 0.f, 0.f, 0.f};
        cur = nxt; cA = nA; cB = nB; ++ui;
        if constexpr (ALIGN_EPI) { if (wr == 1) PG8_BAR; }
    }
    PG8_WAIT_V(0);
    if constexpr (!ALIGN_EPI) { if (wr == 0) PG8_BAR; }
    PG8_BAR;
    if constexpr (Epi::AFTER_DRAIN) { E.fused(acc, cur, wr, wc, fr, fq, lds, wid, lane); S.done(cur); }
#undef PG8_SA
#undef PG8_SB
#undef PG8_STAGE
#undef PG8_LDA
#undef PG8_LDB
#undef PG8_MMA
#undef PG8_WAIT_V
#undef PG8_WAIT_L
#undef PG8_BAR
#undef PG8_SCHED
}
}

template <int MODE> struct EpiAd {
    static constexpr bool PERM = true, AFTER_DRAIN = false;
    const Params& P; int aux;
    __device__ __forceinline__ void operator()(const f32x4 (&acc)[2][2][4][2], const pg8::Unit& u, int, int, int, int) const { epilogue<MODE>(acc, P, u.pm * 256, u.pn * 256, aux); }
};
template <int MODE> __device__ __forceinline__ void stream_gemm(const Params& P, const bf16_t* A, const bf16_t* Bt, int N, int K, int aux) {
    pg8::Gemm g; g.A = A; g.Bt = Bt; g.M = M_TOK; g.N = N; g.K = K;
    pg8::StaticOrder S; S.init(M_TOK, N, (int)gridDim.x, (int)blockIdx.x);
    const EpiAd<MODE> E{P, aux};
    pg8::gemm_phase<EpiAd<MODE>, pg8::StaticOrder, true, true>((PG8_LAS unsigned char*)shm, g, S, E);
}

struct WtDesc { const float* W; const float* g1; const float* g2; bf16_t* out; int N, ksplit, ldo, mode, k0, n0; };
__device__ __forceinline__ WtDesc wt_desc(const Params& P, int task) {
    WtDesc d; int tile;
    if (task < 2112) { const int wsel = task / 352; tile = task % 352; const int f2 = wsel >= 3, k = wsel % 3;
        const float* nf = f2 ? P.norm_ffn2 : P.norm_ffn1;
        if (k == 2) { d.W = f2 ? P.w2d : P.w1d; d.N = 1024; d.g1 = nullptr; d.g2 = nullptr; d.ksplit = 0; d.out = WSP(bf16_t, f2 ? OFF_WD2 : OFF_WD1); d.ldo = 2816; d.mode = 0; }
        else { d.W = k == 0 ? (f2 ? P.w2g : P.w1g) : (f2 ? P.w2u : P.w1u); d.N = 2816; d.g1 = nf; d.g2 = nf; d.ksplit = 1024; d.out = WSP(bf16_t, f2 ? OFF_W2 : OFF_W1); d.ldo = 1024; d.mode = k == 0 ? 1 : 2; }
    } else if (task < 2272) { tile = task - 2112; d.W = P.w_in; d.N = 1184; d.g1 = P.norm_mix; d.g2 = P.norm_mix; d.ksplit = 1024; d.out = WSP(bf16_t, OFF_WIN); d.ldo = 1024; d.mode = 0; }
    else if (task < 2308) { tile = task - 2272; d.W = P.w_uq; d.N = 768; d.g1 = P.q_norm; d.g2 = P.q_norm; d.ksplit = 384; d.out = WSP(bf16_t, OFF_WUQ); d.ldo = 384; d.mode = 0; }
    else if (task < 2340) { tile = task - 2308; d.W = P.w_ukv; d.N = 1024; d.g1 = P.kv_norm; d.g2 = P.kv_norm; d.ksplit = 256; d.out = WSP(bf16_t, OFF_WUKV); d.ldo = 256; d.mode = 0; }
    else if (task < 2372) { tile = task - 2340; d.W = P.w_glu; d.N = 512; d.g1 = nullptr; d.g2 = nullptr; d.ksplit = 0; d.out = WSP(bf16_t, OFF_WGLU); d.ldo = 512; d.mode = 0; }
    else if (task < 2500) { tile = task - 2372; d.W = P.w_out; d.N = 1024; d.g1 = P.on_ssm; d.g2 = P.on_att; d.ksplit = 512; d.out = WSP(bf16_t, OFF_WOUT); d.ldo = 1024; d.mode = 0; }
    else if (task < 2628) { tile = task - 2500; d.W = P.w_pg; d.N = 1024; d.g1 = P.norm_ple; d.g2 = P.norm_ple; d.ksplit = 1024; d.out = WSP(bf16_t, OFF_WPG); d.ldo = 1024; d.mode = 0; }
    else { tile = task - 2628; d.W = P.w_pp; d.N = 1024; d.g1 = nullptr; d.g2 = nullptr; d.ksplit = 0; d.out = WSP(bf16_t, OFF_WPP); d.ldo = 256; d.mode = 0; }
    const int ntn = (d.N + 127) >> 7, tk = tile / ntn, tn = tile - tk * ntn; d.k0 = tk * 64; d.n0 = tn * 128;
    return d;
}
constexpr int NWT = 2660;
__device__ __forceinline__ void wt_load(const WtDesc& d, f32x4 (&r)[4]) {
    int t = threadIdx.x; asm volatile("" : "+v"(t));
    const int n = d.n0 + (t & 31) * 4;
#pragma unroll
    for (int i = 0; i < 4; ++i) {
        const int kk = d.k0 + (t >> 5) + 16 * i;
        f32x4 v = {0.f, 0.f, 0.f, 0.f};
        if (n < d.N) { v = __builtin_nontemporal_load((const f32x4*)(d.W + (long)kk * d.N + n)); if (d.g1) v *= (kk < d.ksplit ? d.g1[kk] : d.g2[kk - d.ksplit]); }
        r[i] = v;
    }
}
__device__ __forceinline__ void wt_store(const WtDesc& d, const f32x4 (&r)[4]) {
    float* tl = (float*)shm;
    int t = threadIdx.x; asm volatile("" : "+v"(t));
#pragma unroll
    for (int i = 0; i < 4; ++i) { float* q = tl + ((t >> 5) + 16 * i) * 129 + (t & 31) * 4; q[0] = r[i][0]; q[1] = r[i][1]; q[2] = r[i][2]; q[3] = r[i][3]; }
    __syncthreads();
#pragma unroll
    for (int i = 0; i < 2; ++i) {
        const int n = (t >> 3) + 64 * i, kc = (t & 7) * 8, nn = d.n0 + n;
        if (nn < d.N) {
            const int orow = d.mode == 0 ? nn : ((nn >> 7) * 256 + (d.mode == 2 ? 128 : 0) + (nn & 127));
            u32x4 w;
            w.x = pk_bf16(tl[(kc + 0) * 129 + n], tl[(kc + 1) * 129 + n]); w.y = pk_bf16(tl[(kc + 2) * 129 + n], tl[(kc + 3) * 129 + n]);
            w.z = pk_bf16(tl[(kc + 4) * 129 + n], tl[(kc + 5) * 129 + n]); w.w = pk_bf16(tl[(kc + 6) * 129 + n], tl[(kc + 7) * 129 + n]);
            *(u32x4*)(d.out + (long)orow * d.ldo + d.k0 + kc) = w;
        }
    }
    __syncthreads();
}

struct S5Mode { float lr, li, dt, cr, ci; };
__device__ __forceinline__ S5Mode s5_mode(const Params& P, int g, int p) {
    S5Mode m; m.lr = P.lam_re[g * 64 + p]; m.li = P.lam_im[g * 64 + p]; m.dt = __expf(P.log_dt[g]);
    float c, s; cisf(m.li * m.dt, c, s); const float e = __expf(m.lr * m.dt);
    const float nr = e * c - 1.f, ni = e * s, den = 1.f / (m.lr * m.lr + m.li * m.li);
    m.cr = (nr * m.lr + ni * m.li) * den; m.ci = (ni * m.lr - nr * m.li) * den;
    return m;
}
__device__ __forceinline__ void s5_pow(const S5Mode& m, float tau, float& zr, float& zi) {
    float c, s; cisf(m.li * m.dt * tau, c, s); const float e = __expf(m.lr * m.dt * tau); zr = e * c; zi = e * s;
}

__constant__ float c_inv_freq[16] = {1.0f, 0.5623413251903491f, 0.31622776601683794f, 0.1778279410038923f, 0.1f, 0.05623413251903491f, 0.03162277660168379f, 0.01778279410038923f,
    0.01f, 0.005623413251903491f, 0.0031622776601683794f, 0.0017782794100389228f, 0.001f, 0.0005623413251903491f, 0.00031622776601683794f, 0.00017782794100389227f};

typedef short s16x4 __attribute__((ext_vector_type(4)));
__device__ __forceinline__ u32x4 scale8(u32x4 w, float s) { u32x4 o;
    o.x = pk_bf16(bf_lo(w.x) * s, bf_hi(w.x) * s); o.y = pk_bf16(bf_lo(w.y) * s, bf_hi(w.y) * s); o.z = pk_bf16(bf_lo(w.z) * s, bf_hi(w.z) * s); o.w = pk_bf16(bf_lo(w.w) * s, bf_hi(w.w) * s); return o; }
__device__ __forceinline__ void attn_item(const Params& P, int bh, int qb) {
    int tid = threadIdx.x; asm volatile("" : "+v"(tid));
    const int w = tid >> 6, lane = tid & 63, l32 = lane & 31, hi = lane >> 5;
    const int b = bh >> 3, h = bh & 7;
    const bf16_t* kvraw = WSP(bf16_t, OFF_KVRAW) + (long)b * SEQ * 1024 + h * 128;
    const bf16_t* kfp = WSP(bf16_t, OFF_HBUF) + (long)bh * SEQ * 96;
    LAS unsigned char* lds = (LAS unsigned char*)shm;
    const int wq = __builtin_amdgcn_readfirstlane(w);
    const int q0 = qb * 256, qrow = q0 + w * 32 + l32, wmin = q0 + wq * 32;
    bf16x8 qf[6];
    {
        const long tokq = (long)b * SEQ + qrow;
        const bf16_t* qr = WSP(bf16_t, OFF_QRAW) + tokq * 768 + h * 96 + hi * 8;
        float qv[6][8]; float sq = 0.f;
#pragma unroll
        for (int ks = 0; ks < 6; ++ks) { ld8(qr + ks * 16, qv[ks]); sq += sq8(qv[ks]); }
        sq += __shfl_xor(sq, 32);
        const float rs = rsqrtf(sq * (1.f / 96.f) + EPS), qs = 0.10206207261596575f * 1.4426950408889634f;
        float cs[8], sn[8];
        ld8f(WSP(float, OFF_TAB) + tokq * 32 + hi * 8, cs); ld8f(WSP(float, OFF_TAB) + tokq * 32 + 16 + hi * 8, sn);
#pragma unroll
        for (int ks = 0; ks < 4; ++ks) { float g[8], gk[8]; ld8f(P.qkn_q + ks * 16 + hi * 8, g); ld8f(P.qkn_k + ks * 16 + hi * 8, gk);
#pragma unroll
            for (int i = 0; i < 8; ++i) qv[ks][i] *= rs * g[i] * gk[i] * qs; }
        { float g1[8], g2[8]; ld8f(P.qkn_q + 64 + hi * 8, g1); ld8f(P.qkn_q + 80 + hi * 8, g2);
#pragma unroll
            for (int i = 0; i < 8; ++i) { const float x1 = qv[4][i] * rs * g1[i] * qs, x2 = qv[5][i] * rs * g2[i] * qs; qv[4][i] = x1 * cs[i] - x2 * sn[i]; qv[5][i] = x1 * sn[i] + x2 * cs[i]; } }
#pragma unroll
        for (int ks = 0; ks < 6; ++ks) { union { bf16x8 v; unsigned u[4]; } t;
#pragma unroll
            for (int i = 0; i < 4; ++i) t.u[i] = pk_bf16(qv[ks][2 * i], qv[ks][2 * i + 1]);
            qf[ks] = t.v; }
    }
    f32x16 o0, o1;
#pragma unroll
    for (int r = 0; r < 16; ++r) { o0[r] = 0.f; o1[r] = 0.f; }
    f32x16 lacc;
#pragma unroll
    for (int r = 0; r < 16; ++r) lacc[r] = 0.f;
    bf16x8 ones8;
#pragma unroll
    for (int i = 0; i < 8; ++i) ones8[i] = (short)0x3F80;
    const int nkt = 4 * (qb + 1);
    constexpr int KSLOT = 12288, VSLOT = 8192, VRING = 3 * KSLOT;
    int kga0, kga1, vga;
    { const int p0 = 64 * wq + lane, k0_ = p0 / 12, c0_ = p0 - 12 * k0_; const int cc0 = (c0_ - ((k0_ >> 2) & 3) + 12) % 12; kga0 = k0_ * 96 + cc0 * 8;
      const int p1 = 64 * ((wq & 3) + 8) + lane, k1_ = p1 / 12, c1_ = p1 - 12 * k1_; const int cc1 = (c1_ - ((k1_ >> 2) & 3) + 12) % 12; kga1 = k1_ * 96 + cc1 * 8;
      const int vkey = 8 * wq + (lane >> 3), vc = (lane & 7) ^ (((vkey >> 1) & 1) << 1); vga = vkey * 1024 + 64 + vc * 8; }
#define ATT_DMA_K(kt_, slot_) do { const bf16_t* g_ = kfp + (long)(kt_) * 64 * 96; \
        __builtin_amdgcn_global_load_lds((const unsigned*)(g_ + kga0), (LAS unsigned*)(lds + (slot_) * KSLOT + wq * 1024), 16, 0, 0); \
        if (wq < 4) __builtin_amdgcn_global_load_lds((const unsigned*)(g_ + kga1), (LAS unsigned*)(lds + (slot_) * KSLOT + (wq + 8) * 1024), 16, 0, 0); } while (0)
#define ATT_DMA_V(kt_, slot_) do { const bf16_t* g_ = kvraw + (long)(kt_) * 64 * 1024; \
        __builtin_amdgcn_global_load_lds((const unsigned*)(g_ + vga), (LAS unsigned*)(lds + VRING + (slot_) * VSLOT + wq * 1024), 16, 0, 0); } while (0)
    int koff[6];
#pragma unroll
    for (int ks = 0; ks < 6; ++ks) koff[ks] = (l32 * 12 + ((2 * ks + hi + ((l32 >> 2) & 3)) % 12)) * 16;
    const int g16 = lane >> 4, dhalf = g16 & 1, tr_r = (lane & 15) >> 2, tr_c = lane & 3;
    const int vtr_off = (4 * hi + tr_r) * 128 + (((dhalf ^ ((tr_r >> 1) & 1)) * 2 + (tr_c >> 1)) * 16) + (tr_c & 1) * 8;
    const unsigned lds_base = (unsigned)(unsigned long long)lds;
#define TR_RD(dst, addr, off) asm volatile("ds_read_b64_tr_b16 %0, %1 offset:" #off : "=v"(dst) : "v"(addr))
#define QK_TILE(S0, S1, kslot_) do { bf16x8 kf[12]; const LAS unsigned char* kb_ = lds + (kslot_) * KSLOT; \
        _Pragma("unroll") for (int ks = 0; ks < 6; ++ks) { kf[2 * ks] = *(const LAS bf16x8*)(kb_ + koff[ks]); kf[2 * ks + 1] = *(const LAS bf16x8*)(kb_ + koff[ks] + 6144); } \
        __builtin_amdgcn_sched_barrier(0); \
        _Pragma("unroll") for (int r = 0; r < 16; ++r) { S0[r] = 0.f; S1[r] = 0.f; } \
        __builtin_amdgcn_s_setprio(1); \
        _Pragma("unroll") for (int ks = 0; ks < 6; ++ks) { \
            S0 = __builtin_amdgcn_mfma_f32_32x32x16_bf16(kf[2 * ks], qf[ks], S0, 0, 0, 0); \
            S1 = __builtin_amdgcn_mfma_f32_32x32x16_bf16(kf[2 * ks + 1], qf[ks], S1, 0, 0, 0); } \
        __builtin_amdgcn_s_setprio(0); \
        __builtin_amdgcn_sched_barrier(0); } while (0)
#define ATT_BODY(KT, GEN) do { const int kt = (KT); \
        { const int ktn = kt + 2 < nkt ? kt + 2 : nkt - 1; ATT_DMA_K(ktn, s2_); ATT_DMA_V(ktn, s2_); } \
        if (!(GEN) || kt * 64 <= wmin + 31) { \
            f32x16 S0, S1; \
            QK_TILE(S0, S1, s0_); \
            const unsigned vb = lds_base + VRING + s0_ * VSLOT + vtr_off; \
            s16x4 vf[16]; \
            TR_RD(vf[0], vb, 0); TR_RD(vf[1], vb, 1024); TR_RD(vf[2], vb, 64); TR_RD(vf[3], vb, 1088); \
            TR_RD(vf[4], vb, 2048); TR_RD(vf[5], vb, 3072); TR_RD(vf[6], vb, 2112); TR_RD(vf[7], vb, 3136); \
            TR_RD(vf[8], vb, 4096); TR_RD(vf[9], vb, 5120); TR_RD(vf[10], vb, 4160); TR_RD(vf[11], vb, 5184); \
            TR_RD(vf[12], vb, 6144); TR_RD(vf[13], vb, 7168); TR_RD(vf[14], vb, 6208); TR_RD(vf[15], vb, 7232); \
            __builtin_amdgcn_sched_barrier(0); \
            if ((GEN) && kt * 64 + 63 > wmin) { \
                _Pragma("unroll") for (int r = 0; r < 16; ++r) { \
                    const int key = kt * 64 + 8 * (r >> 2) + 4 * hi + (r & 3); \
                    if (key > qrow) S0[r] = -1e30f; \
                    if (key + 32 > qrow) S1[r] = -1e30f; } } \
              \
              \
            _Pragma("unroll") for (int r = 0; r < 16; ++r) { S0[r] = __builtin_amdgcn_exp2f(S0[r]); S1[r] = __builtin_amdgcn_exp2f(S1[r]); } \
            asm volatile("s_waitcnt lgkmcnt(0)" : "+v"(vf[0]), "+v"(vf[1]), "+v"(vf[2]), "+v"(vf[3]), "+v"(vf[4]), "+v"(vf[5]), "+v"(vf[6]), "+v"(vf[7]), \
                         "+v"(vf[8]), "+v"(vf[9]), "+v"(vf[10]), "+v"(vf[11]), "+v"(vf[12]), "+v"(vf[13]), "+v"(vf[14]), "+v"(vf[15]) :: "memory"); \
            _Pragma("unroll") for (int q = 0; q < 4; ++q) { \
                union { bf16x8 v; unsigned u[4]; } pf; \
                _Pragma("unroll") for (int i = 0; i < 4; ++i) pf.u[i] = (q >> 1) == 0 ? pk_bf16(S0[8 * (q & 1) + 2 * i], S0[8 * (q & 1) + 2 * i + 1]) : pk_bf16(S1[8 * (q & 1) + 2 * i], S1[8 * (q & 1) + 2 * i + 1]); \
                union { bf16x8 v; s16x4 h[2]; } va, vb2; \
                va.h[0] = vf[4 * q + 0]; va.h[1] = vf[4 * q + 1]; vb2.h[0] = vf[4 * q + 2]; vb2.h[1] = vf[4 * q + 3]; \
                o0 = __builtin_amdgcn_mfma_f32_32x32x16_bf16(va.v, pf.v, o0, 0, 0, 0); \
                o1 = __builtin_amdgcn_mfma_f32_32x32x16_bf16(vb2.v, pf.v, o1, 0, 0, 0); \
                lacc = __builtin_amdgcn_mfma_f32_32x32x16_bf16(ones8, pf.v, lacc, 0, 0, 0); } \
        } \
          \
        if (wq < 4) asm volatile("s_waitcnt vmcnt(3)" ::: "memory"); else asm volatile("s_waitcnt vmcnt(2)" ::: "memory"); \
        __builtin_amdgcn_s_barrier(); \
        { const int t_ = s0_; s0_ = s1_; s1_ = s2_; s2_ = t_; } } while (0)
    __syncthreads();
    ATT_DMA_K(0, 0); ATT_DMA_K(1, 1); ATT_DMA_V(0, 0); ATT_DMA_V(1, 1);
    asm volatile("s_waitcnt vmcnt(0)" ::: "memory");
    __builtin_amdgcn_s_barrier();
    int s0_ = 0, s1_ = 1, s2_ = 2;
    int kfull = (wmin + 1) >> 6; kfull = kfull < nkt ? kfull : nkt;
    int kti = 0;
    for (; kti < kfull; ++kti) ATT_BODY(kti, 0);
    for (; kti < nkt; ++kti) ATT_BODY(kti, 1);
    asm volatile("s_waitcnt vmcnt(0)" ::: "memory");
    __builtin_amdgcn_s_barrier();
#undef QK_TILE
#undef TR_RD
#undef ATT_BODY
#undef ATT_DMA_K
#undef ATT_DMA_V
    const float inv = 1.f / lacc[0];
    const long tok = (long)b * SEQ + qrow;
    bf16_t* ymix = ((bf16_t*)P.out) + tok * 1024 + 512 + h * 64;
    float sq = 0.f;
#pragma unroll
    for (int g4 = 0; g4 < 4; ++g4) {
        f32x4 a, c;
#pragma unroll
        for (int j = 0; j < 4; ++j) { a[j] = o0[g4 * 4 + j] * inv; c[j] = o1[g4 * 4 + j] * inv; sq += a[j] * a[j] + c[j] * c[j]; }
        store_bf4(ymix + 8 * g4 + 4 * hi, a);
        store_bf4(ymix + 32 + 8 * g4 + 4 * hi, c);
    }
    sq += __shfl_xor(sq, 32);
    if (hi == 0) unsafeAtomicAdd(WSP(float, OFF_SS) + ATOM_OFF + 7 * M_TOK + tok, sq);
}

__device__ __forceinline__ void s5_scan_task(const Params& P, int g, int b, float* T) {
    int tid = threadIdx.x; asm volatile("" : "+v"(tid));
    const int p = tid & 63, part = tid >> 6;
    const S5Mode md = s5_mode(P, g, p); float ar, ai, a16r, a16i; s5_pow(md, 32.f, ar, ai); s5_pow(md, 512.f, a16r, a16i);
    const float* E = WSP(float, OFF_E) + ((long)g * 1024 + b * 128 + part * 16) * 128;
    bf16_t* A2 = WSP(bf16_t, OFF_A2) + ((long)g * 1024 + b * 128 + part * 16) * 640 + 512;
    float er[16], ei[16], lr[16], li[16];
#pragma unroll
    for (int j = 0; j < 16; ++j) { er[j] = E[(long)j * 128 + p]; ei[j] = E[(long)j * 128 + 64 + p]; }
    float sr = 0.f, si = 0.f;
#pragma unroll
    for (int j = 0; j < 16; ++j) { lr[j] = sr; li[j] = si; const float nr = ar * sr - ai * si + er[j], ni = ar * si + ai * sr + ei[j]; sr = nr; si = ni; }
    __syncthreads();
    T[(part * 2 + 0) * 64 + p] = sr; T[(part * 2 + 1) * 64 + p] = si;
    __syncthreads();
    float wr_ = 0.f, wi_ = 0.f;
    for (int k = 0; k < part; ++k) { const float tr = T[(k * 2 + 0) * 64 + p], ti = T[(k * 2 + 1) * 64 + p]; const float nr = a16r * wr_ - a16i * wi_ + tr, ni = a16r * wi_ + a16i * wr_ + ti; wr_ = nr; wi_ = ni; }
#pragma unroll
    for (int j = 0; j < 16; ++j) {
        A2[(long)j * 640 + p] = (bf16_t)(pk_bf16(lr[j] + wr_, 0.f) & 0xffff); A2[(long)j * 640 + 64 + p] = (bf16_t)(pk_bf16(li[j] + wi_, 0.f) & 0xffff);
        const float nr = ar * wr_ - ai * wi_, ni = ar * wi_ + ai * wr_; wr_ = nr; wi_ = ni;
    }
    __syncthreads();
}

#define XB_TMO      128
#define XB_XCNT(j)  (256  + 64 * (j))
#define XB_XSUB(j)  (1280 + 64 * (j))
#define XB_XGEN(j)  (2304 + 64 * (j))
#define XB_TOP      3328
#define XB_TOPGEN   3392
#define XCD_BAR_WORDS 3456
#define XB_SPIN_CAP (1u << 18)

__device__ __forceinline__ unsigned xb_ld(unsigned* p)              { return __hip_atomic_load(p, __ATOMIC_RELAXED, __HIP_MEMORY_SCOPE_AGENT); }
__device__ __forceinline__ unsigned xb_add(unsigned* p, unsigned v) { return __hip_atomic_fetch_add(p, v, __ATOMIC_RELAXED, __HIP_MEMORY_SCOPE_AGENT); }
__device__ __forceinline__ unsigned xb_xcc_id() { return (unsigned)__builtin_amdgcn_s_getreg((3 << 11) | 20) & 0xFu; }
#define XB_SPIN(cond, bar) do { unsigned _sp = 0; while (cond) { __builtin_amdgcn_s_sleep(1); \
    if ((++_sp & 255u) == 0u) { if (xb_ld(&(bar)[XB_TMO])) break; if (_sp > XB_SPIN_CAP) { atomicAdd(&(bar)[XB_TMO], 1u); break; } } } } while (0)

struct XcdBarrier {
    unsigned* bar; unsigned x;
    volatile LAS unsigned* st;
};

__device__ __forceinline__ XcdBarrier xcd_barrier_post(unsigned* bar, volatile LAS unsigned* st) {
    XcdBarrier b; b.bar = bar; b.x = xb_xcc_id(); b.st = st;
    if (threadIdx.x == 0) (void)xb_add(&bar[XB_XCNT(b.x)], 1u);
    return b;
}
__device__ __forceinline__ void xcd_barrier_complete(unsigned* bar, unsigned x, unsigned& nloc, unsigned& nx) {
    const unsigned G = gridDim.x * gridDim.y * gridDim.z;
    unsigned sum, cnt, mine, sp = 0u;
    for (;;) {
        sum = 0u; cnt = 0u; mine = 0u;
#pragma unroll
        for (unsigned j = 0; j < 16; ++j) { const unsigned c = xb_ld(&bar[XB_XCNT(j)]); sum += c; cnt += (c > 0u) ? 1u : 0u; mine = (j == x) ? c : mine; }
        if (sum == G) break;
        __builtin_amdgcn_s_sleep(1);
        if ((++sp & 255u) == 0u) { if (xb_ld(&bar[XB_TMO])) break; if (sp > XB_SPIN_CAP) { atomicAdd(&bar[XB_TMO], 1u); break; } }
    }
    nloc = mine > 0u ? mine : 1u; nx = cnt > 0u ? cnt : 1u;
}

__device__ __forceinline__ void xcd_barrier(const XcdBarrier& b) {
    asm volatile("s_waitcnt vmcnt(0)" ::: "memory");
    __syncthreads();
    if (threadIdx.x == 0) {
        unsigned* bar = b.bar;
        __builtin_amdgcn_s_waitcnt(0);
        unsigned nloc = b.st[0], nx = b.st[1];
        if (nloc == 0u) { xcd_barrier_complete(bar, b.x, nloc, nx); b.st[0] = nloc; b.st[1] = nx; }
        const unsigned old = xb_add(&bar[XB_XSUB(b.x)], 1u);
        const unsigned gen = old / nloc;
        if (old + 1u == (gen + 1u) * nloc) {
            __builtin_amdgcn_fence(__ATOMIC_RELEASE, "agent");
            asm volatile("s_waitcnt vmcnt(0)" ::: "memory");
            const unsigned og = xb_add(&bar[XB_TOP], 1u);
            const unsigned tg = og / nx;
            if (og + 1u == (tg + 1u) * nx) xb_add(&bar[XB_TOPGEN], 1u);
            else XB_SPIN(xb_ld(&bar[XB_TOPGEN]) == tg, bar);
            __builtin_amdgcn_fence(__ATOMIC_ACQUIRE, "agent");
            xb_add(&bar[XB_XGEN(b.x)], 1u);
            asm volatile("s_waitcnt vmcnt(0)" ::: "memory");
        } else {
            XB_SPIN(xb_ld(&bar[XB_XGEN(b.x)]) == gen, bar);
            __builtin_amdgcn_fence(__ATOMIC_ACQUIRE, "agent");
            asm volatile("s_waitcnt vmcnt(0)" ::: "memory");
        }
    }
    __syncthreads();
}


__global__ void __launch_bounds__(512, 2) mega(Params P) {
    const int G = gridDim.x, cb = blockIdx.x;
    __shared__ uint4 xb_words;
    if (threadIdx.x == 0) xb_words = make_uint4(0u, 0u, 0u, 0u);
    __syncthreads();
    const XcdBarrier xbar = xcd_barrier_post((unsigned*)(P.ws + OFF_BAR), (volatile LAS unsigned*)&xb_words);
    for (int phr = P.ph_lo * 2; phr < P.ph_hi * 2; ++phr) {
        const int ph = phr >> 1;
        if ((phr & 1) && ph != PROBE_PH) continue;
        if (ph == 5) continue;
#if PROBE_PH >= 0
        __syncthreads(); if (threadIdx.x == 0) s_aoff = (phr & 1) ? (long)24 * M_TOK : 0; __syncthreads();
#endif
        if (phr > P.ph_lo * 2) { if (P.ph_lo < 0) cg::this_grid().sync(); else xcd_barrier(xbar); }
        int tid = threadIdx.x; asm volatile("" : "+v"(tid));
        if (ph == 0) {
            for (int task = cb; task < NWT; task += 2 * G) {
                const WtDesc d0 = wt_desc(P, task); f32x4 r0[4]; wt_load(d0, r0);
                const int t1 = task + G;
                if (t1 < NWT) { const WtDesc d1 = wt_desc(P, t1); f32x4 r1[4]; wt_load(d1, r1); wt_store(d0, r0); wt_store(d1, r1); }
                else wt_store(d0, r0);
            }
            constexpr int R8 = 0, R9 = R8 + 1024  , R10 = R9 + 512  , R11 = R10 + 120  , R12 = R11 + 1024  , R13 = R12 + 512  ,
                          R14 = R13 + 256  , R15 = R14 + 128  , R16 = R15 + 1  ;
            for (int task = cb; task < R16; task += G) {
                if (task < R9) {
                    const int lane = tid & 63, row0 = (task - R8) * 32 + (tid >> 6) * 4;
                    f32x4 v[4][4];
#pragma unroll
                    for (int rr = 0; rr < 4; ++rr)
#pragma unroll
                        for (int i = 0; i < 4; ++i) v[rr][i] = __builtin_nontemporal_load((const f32x4*)(P.x + (long)(row0 + rr) * DM + i * 256 + lane * 4));
#pragma unroll
                    for (int rr = 0; rr < 4; ++rr) {
                        bf16_t* xb = WSP(bf16_t, OFF_HB) + (long)(row0 + rr) * DM; float sq = 0.f;
#pragma unroll
                        for (int i = 0; i < 4; ++i) { const f32x4 a = v[rr][i]; sq += a[0] * a[0] + a[1] * a[1] + a[2] * a[2] + a[3] * a[3]; store_bf4(xb + i * 256 + lane * 4, a); }
#pragma unroll
                        for (int o = 32; o > 0; o >>= 1) sq += __shfl_xor(sq, o);
                        if (lane == 0) WSP(float, OFF_SS)[row0 + rr] = sq;
                    }
                } else if (task < R10) {
                    f32x4 a[4], b[4];
#pragma unroll
                    for (int i = 0; i < 4; ++i) { const long e = ((long)(task - R9) * 2048 + i * 512 + tid) * 8; a[i] = __builtin_nontemporal_load((const f32x4*)(P.p + e)); b[i] = __builtin_nontemporal_load((const f32x4*)(P.p + e + 4)); }
#pragma unroll
                    for (int i = 0; i < 4; ++i) { const long e = ((long)(task - R9) * 2048 + i * 512 + tid) * 8;
                        u32x4 w; w.x = pk_bf16(a[i][0], a[i][1]); w.y = pk_bf16(a[i][2], a[i][3]); w.z = pk_bf16(b[i][0], b[i][1]); w.w = pk_bf16(b[i][2], b[i][3]);
                        *(u32x4*)(WSP(bf16_t, OFF_PB) + e) = w; }
                } else if (task < R11) {
                    const int zt = task - R10;
                    const long e = (zt < 56 ? (long)M_TOK : (long)16 * M_TOK - (long)56 * 4096) + ((long)zt * 512 + tid) * 8;
                    const f32x4 z = {0.f, 0.f, 0.f, 0.f};
                    *(f32x4*)(WSP(float, OFF_SS) + e) = z; *(f32x4*)(WSP(float, OFF_SS) + e + 4) = z;
                } else if (task < R12) {
                    const int id = (task - R11) * 512 + tid, m = id >> 4, i = id & 15;
                    const double ang = (double)P.pos[m] * (double)c_inv_freq[i];
                    double r = ang * 0.15915494309189535; r -= floor(r);
                    float* tab = WSP(float, OFF_TAB) + (long)m * 32;
                    tab[i] = __builtin_amdgcn_cosf((float)r); tab[16 + i] = __builtin_amdgcn_sinf((float)r);
                } else if (task < R13) {
                    const int g = (task - R12) >> 4, tau0 = ((task - R12) & 15) * 2;
                    float* wre = (float*)shm; float* wim = wre + 2048; float* cre = wim + 2048; float* cim = cre + 1024;
                    __syncthreads();
#pragma unroll
                    for (int i = 0; i < 4; ++i) { const int idx = i * 512 + tid, hi_ = idx & 15, p = (idx >> 4) & 63, tl_ = idx >> 10;
                        const S5Mode md = s5_mode(P, g, p); float zr, zi; s5_pow(md, (float)(tau0 + tl_), zr, zi);
                        const float br = P.b_re[(g * 64 + p) * 16 + hi_], bi = P.b_im[(g * 64 + p) * 16 + hi_];
                        const float bbr = md.cr * br - md.ci * bi, bbi = md.cr * bi + md.ci * br;
                        wre[idx] = zr * bbr - zi * bbi; wim[idx] = zr * bbi + zi * bbr; }
#pragma unroll
                    for (int i = 0; i < 2; ++i) { const int idx = i * 512 + tid; cre[idx] = P.c_re[g * 1024 + idx]; cim[idx] = P.c_im[g * 1024 + idx]; }
                    __syncthreads();
                    const int hi_ = tid & 15, ho = (tid >> 4) & 15, tl_ = tid >> 8;
                    float a = 0.f;
#pragma unroll 8
                    for (int p = 0; p < 64; ++p) a += cre[ho * 64 + p] * wre[(tl_ * 64 + p) * 16 + hi_] - cim[ho * 64 + p] * wim[(tl_ * 64 + p) * 16 + hi_];
                    if (tau0 + tl_ == 0 && ho == hi_) a += P.ssm_d[g * 16 + ho];
                    WSP(float, OFF_KTAB)[((g * 32 + tau0 + tl_) * 16 + ho) * 16 + hi_] = a;
                    __syncthreads();
                } else if (task < R14) {
                    const int id = (task - R13) * 512 + tid, s = id & 31, j = (id >> 5) & 127, g = id >> 12, p = j & 63;
                    const S5Mode md = s5_mode(P, g, p); float zr, zi; s5_pow(md, (float)(31 - s), zr, zi);
                    float br[16], bi[16];
#pragma unroll
                    for (int q = 0; q < 4; ++q) { const f32x4 a = *(const f32x4*)(P.b_re + (g * 64 + p) * 16 + q * 4), b = *(const f32x4*)(P.b_im + (g * 64 + p) * 16 + q * 4);
#pragma unroll
                        for (int e = 0; e < 4; ++e) { br[q * 4 + e] = a[e]; bi[q * 4 + e] = b[e]; } }
                    float o[16];
#pragma unroll
                    for (int h = 0; h < 16; ++h) { const float bbr = md.cr * br[h] - md.ci * bi[h], bbi = md.cr * bi[h] + md.ci * br[h]; o[h] = j < 64 ? (zr * bbr - zi * bbi) : (zr * bbi + zi * bbr); }
                    bf16_t* dst = WSP(bf16_t, OFF_PM) + ((long)g * 128 + j) * 512 + s * 16;
                    u32x4 w0, w1; w0.x = pk_bf16(o[0], o[1]); w0.y = pk_bf16(o[2], o[3]); w0.z = pk_bf16(o[4], o[5]); w0.w = pk_bf16(o[6], o[7]);
                    w1.x = pk_bf16(o[8], o[9]); w1.y = pk_bf16(o[10], o[11]); w1.z = pk_bf16(o[12], o[13]); w1.w = pk_bf16(o[14], o[15]);
                    *(u32x4*)dst = w0; *(u32x4*)(dst + 8) = w1;
                } else if (task < R15) {
                    const int id = (task - R14) * 512 + tid, p = id & 63, t = (id >> 6) & 31, g = id >> 11;
                    const S5Mode md = s5_mode(P, g, p); float zr, zi; s5_pow(md, (float)(t + 1), zr, zi);
                    bf16_t* dst = WSP(bf16_t, OFF_MQ) + ((long)g * 512 + t * 16) * 640 + 512 + p;
#pragma unroll
                    for (int ho = 0; ho < 16; ++ho) { const float cr = P.c_re[(g * 16 + ho) * 64 + p], ci = P.c_im[(g * 16 + ho) * 64 + p];
                        dst[(long)ho * 640] = (bf16_t)(pk_bf16(cr * zr - ci * zi, 0.f) & 0xffff); dst[(long)ho * 640 + 64] = (bf16_t)(pk_bf16(-(cr * zi + ci * zr), 0.f) & 0xffff); }
                } else {
                    for (int e = tid; e < 96 * 1024 / 8; e += 512) { const u32x4 z = {0u, 0u, 0u, 0u}; *(u32x4*)(WSP(bf16_t, OFF_WIN) + (long)1184 * 1024 + (long)e * 8) = z; }
                }
            }
        } else if (ph == 4) {
            for (int task = cb; task < 2048; task += G) {
                const int id = task * 512 + tid, c8 = id & 63, rowq = (id >> 6) & 511, g = id >> 15;
                const int t = rowq >> 4, ho = rowq & 15, s = c8 >> 1, hi0 = (c8 & 1) * 8;
                u32x4 w = {0u, 0u, 0u, 0u};
                if (s <= t) { const float* kt = WSP(float, OFF_KTAB) + (((long)g * 32 + (t - s)) * 16 + ho) * 16 + hi0;
                    const f32x4 a = *(const f32x4*)kt, b = *(const f32x4*)(kt + 4);
                    w.x = pk_bf16(a[0], a[1]); w.y = pk_bf16(a[2], a[3]); w.z = pk_bf16(b[0], b[1]); w.w = pk_bf16(b[2], b[3]); }
                *(u32x4*)(WSP(bf16_t, OFF_MQ) + ((long)g * 512 + rowq) * 640 + c8 * 8) = w;
            }
        } else if (ph == 6) {
            for (int it = cb; it < 1024; it += G) {
                const int r = (it >> 6) & 3, j = it >> 8, bh = it & 63;
                const int qb = (j & 1) ? (15 - 4 * j - (3 - r)) : (15 - 4 * j - r);
                attn_item(P, bh, qb);
            }
        }
        switch (ph) {
            case 1: stream_gemm<E_SWIGLU>(P, WSP(bf16_t, OFF_HB), WSP(bf16_t, OFF_W1), 5632, 1024, 0); break;
            case 9: stream_gemm<E_SWIGLU>(P, WSP(bf16_t, OFF_HB), WSP(bf16_t, OFF_W2), 5632, 1024, 1); break;
            case 2: stream_gemm<E_DOWN>(P, WSP(bf16_t, OFF_ACT), WSP(bf16_t, OFF_WD1), 1024, 2816, 0); break;
            case 10: stream_gemm<E_DOWN>(P, WSP(bf16_t, OFF_ACT), WSP(bf16_t, OFF_WD2), 1024, 2816, 1); break;
            case 3: stream_gemm<E_WIN>(P, WSP(bf16_t, OFF_HB), WSP(bf16_t, OFF_WIN), 1280, 1024, 0); break;
            case 7: stream_gemm<E_GLU>(P, (const bf16_t*)P.out + (long)M_TOK * 1024, WSP(bf16_t, OFF_WGLU), 512, 512, 0); break;
            case 11: stream_gemm<E_PLE>(P, WSP(bf16_t, OFF_HB), WSP(bf16_t, OFF_WPG), 1024, 1024, 0); break;
            default: break;
        }
        int ntiles = 0;
        switch (ph) {
            case 4: ntiles = 128 * 3 + 128 * 4 + 128; break;
            case 6: ntiles = 256; break;
            case 8: ntiles = 128 * 4; break;
            case 3: ntiles = 128 * 4; break;
            default: break;
        }
        struct TD { const char *Ap, *Bp, *Ap2, *Bp2; int lda, ldb, nt, nt2, mode, aux, brow, bcol; };
        auto make_td = [&](int L) -> TD {
            const bf16_t *A = nullptr, *Bt = nullptr, *A2p = nullptr, *B2p = nullptr; int lda = 0, ldb = 0, nt = 0, mode = 0, aux = 0, pm = 0, pn = 0, nt2 = 0;
            switch (ph) {
                case 4:
                    if (L < 384) { tile_map(L, 128, 3, pm, pn); A = WSP(bf16_t, OFF_CQB); lda = 384; Bt = WSP(bf16_t, OFF_WUQ); ldb = 384; nt = 6; mode = E_QRAW; }
                    else if (L < 896) { tile_map(L - 384, 128, 4, pm, pn); A = WSP(bf16_t, OFF_CKVB); lda = 256; Bt = WSP(bf16_t, OFF_WUKV); ldb = 256; nt = 4; mode = E_KVRAW; }
                    else { const int tl = L - 896; aux = tl >> 2; pm = tl & 3; pn = 0; A = WSP(bf16_t, OFF_A2) + (long)aux * 1024 * 640; lda = 640; Bt = WSP(bf16_t, OFF_PM) + (long)aux * 128 * 512; ldb = 512; nt = 8; mode = E_S5E; }
                    break;
                case 6: { aux = L >> 3; pm = (L & 7) >> 1; pn = L & 1; A = WSP(bf16_t, OFF_A2) + (long)aux * 1024 * 640; lda = 640; Bt = WSP(bf16_t, OFF_MQ) + (long)aux * 512 * 640; ldb = 640; nt = 10; mode = E_S5Y; } break;
                case 8: tile_map(L, 128, 4, pm, pn); A = (const bf16_t*)P.out; lda = 1024; Bt = WSP(bf16_t, OFF_WOUT); ldb = 1024; nt = 8; nt2 = 8; A2p = A + 512; B2p = Bt + 512; mode = E_WOUT; break;
                case 3: { tile_map(L, 128, 4, pm, pn); A = WSP(bf16_t, OFF_PB); lda = 256; Bt = WSP(bf16_t, OFF_WPP); ldb = 256; nt = 4; mode = E_PP; } break;
                default: break;
            }
            TD d; d.lda = lda; d.ldb = ldb; d.nt = nt; d.nt2 = nt2; d.mode = mode; d.aux = aux; d.brow = pm * BM; d.bcol = pn * BM;
            d.Ap = (const char*)(A + (long)d.brow * lda); d.Bp = (const char*)(Bt + (long)d.bcol * ldb);
            d.Ap2 = nt2 ? (const char*)(A2p + (long)d.brow * lda) : d.Ap; d.Bp2 = nt2 ? (const char*)(B2p + (long)d.bcol * ldb) : d.Bp;
            return d;
        };
        TD cur{}; bool pre = false;
        int L0 = cb, Lstep = G;
        if (ph == 3) { Lstep = G / 2; if (cb >= G / 2) { L0 = cb - G / 2; ntiles = 3 * (G / 2) < ntiles ? 3 * (G / 2) : ntiles; } else L0 = 3 * (G / 2) + cb; }
        if (L0 < ntiles) cur = make_td(L0);
        for (int L = L0; L < ntiles; L += Lstep) {
            const int lda = cur.lda, ldb = cur.ldb, nt = cur.nt, nt2 = cur.nt2, mode = cur.mode, aux = cur.aux;
            const int brow = cur.brow, bcol = cur.bcol;
            f32x4 acc[2][2][4][2];
#pragma unroll
            for (int a = 0; a < 2; ++a)
#pragma unroll
                for (int b = 0; b < 2; ++b)
#pragma unroll
                    for (int m = 0; m < 4; ++m)
#pragma unroll
                        for (int n = 0; n < 2; ++n) acc[a][b][m][n] = (f32x4){0.f, 0.f, 0.f, 0.f};
            const char* Ap = cur.Ap; const char* Bp = cur.Bp; int ntc = nt;
            for (int part = 0; part < (nt2 ? 2 : 1); ++part) {
                gemm_loop(acc, Ap, lda, Bp, ldb, ntc, pre && part == 0);
                if (nt2 && part == 0) {
                    int tid_ = threadIdx.x; asm volatile("" : "+v"(tid_));
                    const int wid = tid_ >> 6, lane = tid_ & 63, wr = wid >> 2, fr = lane & 15;
                    const float* ss = WSP(float, OFF_SS);
#pragma unroll
                    for (int a = 0; a < 2; ++a)
#pragma unroll
                        for (int m = 0; m < 4; ++m) {
                            const int row = brow + a * HALF + wr * 64 + m * 16 + fr;
                            const float ratio = rsqrtf(ss[6 * M_TOK + row] * (1.f / 512.f) + EPS) / rsqrtf(ss[7 * M_TOK + row] * (1.f / 512.f) + EPS);
#pragma unroll
                            for (int b = 0; b < 2; ++b)
#pragma unroll
                                for (int n = 0; n < 2; ++n) acc[a][b][m][n] *= ratio;
                        }
                    Ap = cur.Ap2; Bp = cur.Bp2; ntc = nt2;
                }
            }
            TD nxt = cur; pre = false;
            if (L + Lstep < ntiles) { nxt = make_td(L + Lstep); gemm_pre(nxt.Ap, nxt.lda, nxt.Bp, nxt.ldb); pre = true; }
            switch (mode) {
                case E_SWIGLU: epilogue<E_SWIGLU>(acc, P, brow, bcol, aux); break;
                case E_DOWN: epilogue<E_DOWN>(acc, P, brow, bcol, aux); break;
                case E_WIN: epilogue<E_WIN>(acc, P, brow, bcol, aux); break;
                case E_QRAW: epilogue<E_QRAW>(acc, P, brow, bcol, aux); break;
                case E_KVRAW: epilogue_kv(acc, P, brow, bcol); break;
                case E_S5E: epilogue<E_S5E>(acc, P, brow, bcol, aux);
                    __syncthreads();
                    s5_scan_task(P, aux, 2 * (brow >> 8), (float*)((char*)shm + 32768)); s5_scan_task(P, aux, 2 * (brow >> 8) + 1, (float*)((char*)shm + 32768));
                    break;
                case E_S5Y: epilogue<E_S5Y>(acc, P, brow, bcol, aux); break;
                case E_GLU: epilogue<E_GLU>(acc, P, brow, bcol, aux); break;
                case E_WOUT: epilogue<E_WOUT>(acc, P, brow, bcol, aux); break;
                case E_PP: epilogue<E_PP>(acc, P, brow, bcol, aux); break;
                default: epilogue<E_PLE>(acc, P, brow, bcol, aux); break;
            }
            cur = nxt;
        }
    }
}

extern "C" void kernel_launch(void* const* d_in, const int* in_sizes, int n_in, void* d_out, int out_size, void* d_ws, size_t ws_size, hipStream_t stream) {
    static int grid = 0;
    if (grid == 0) {
        if (n_in != 35 || ws_size < OFF_BAR + 16384 || out_size != M_TOK * DM) { fprintf(stderr, "kernel_launch: unexpected problem (n_in %d, ws %zu need %zu, out %d)\n", n_in, ws_size, (size_t)WS_END, out_size); grid = -1; return; }
        int dev = 0, cus = 0, per_cu = 0;
        hipGetDevice(&dev); hipDeviceGetAttribute(&cus, hipDeviceAttributeMultiprocessorCount, dev);
        if (hipFuncSetAttribute((const void*)mega, hipFuncAttributeMaxDynamicSharedMemorySize, SHM_B) != hipSuccess) { fprintf(stderr, "kernel_launch: hipFuncSetAttribute failed\n"); grid = -1; return; }
        if (hipOccupancyMaxActiveBlocksPerMultiprocessor(&per_cu, (const void*)mega, 512, SHM_B) != hipSuccess || per_cu < 1) { fprintf(stderr, "kernel_launch: occupancy query failed (%d)\n", per_cu); (void)hipGetLastError(); per_cu = 1; }
        grid = cus * per_cu;
        if (grid > 256) grid = 256;
        grid &= ~7;
    }
    if (grid <= 0) return;
    Params P{};
    const float** fp = (const float**)&P.norm_ffn1;
    P.x = (const float*)d_in[0]; P.p = (const float*)d_in[1]; P.pos = (const int*)d_in[2];
    for (int i = 3; i < 35; ++i) fp[i - 3] = (const float*)d_in[i];
    P.out = (float*)d_out; P.ws = (char*)d_ws;
#if MK_MULTI
    for (int ph = 0; ph < 12; ++ph) { P.ph_lo = ph; P.ph_hi = ph + 1; hipLaunchKernelGGL(mega, dim3(grid), dim3(512), SHM_B, stream, P); }
#else
    P.ph_lo = 0; P.ph_hi = 12;
    (void)hipMemsetAsync((char*)d_ws + OFF_BAR, 0, 16384, stream);
    void* args[] = {&P};
    hipError_t e = hipLaunchCooperativeKernel((void*)mega, dim3(grid), dim3(512), args, SHM_B, stream);
    if (e != hipSuccess) fprintf(stderr, "cooperative launch failed: %s (grid %d)\n", hipGetErrorString(e), grid);
#endif
}
```

```cpp
#include <hip/hip_runtime.h>
#include <hip/hip_cooperative_groups.h>
#include <cstdint>
#include <cstdio>
namespace cg = cooperative_groups;

typedef unsigned short bf16_t;
typedef short bf16x8 __attribute__((ext_vector_type(8)));
typedef float f32x4 __attribute__((ext_vector_type(4)));
typedef float f32x16 __attribute__((ext_vector_type(16)));
typedef unsigned u32x2 __attribute__((ext_vector_type(2)));
typedef unsigned u32x4 __attribute__((ext_vector_type(4)));

#ifndef MK_MULTI
#define MK_MULTI 0
#endif
#ifndef PROBE_MASK
#define PROBE_MASK 0
#endif
#ifndef PROBE_SEL
#define PROBE_SEL 0
#endif

constexpr int M_TOK = 32768, DM = 1024, DFF = 2816, SEQ = 4096;
constexpr int BM = 256, BK = 64, HALF = 128, HT = HALF * BK, SHM_B = 8 * HT * 2;
constexpr float EPS = 1e-6f;

constexpr size_t SZ_SS = (size_t)48 * M_TOK * 4;
constexpr size_t OFF_SS = 0;
constexpr size_t OFF_W1 = OFF_SS + SZ_SS;
constexpr size_t OFF_WD1 = OFF_W1 + (size_t)5632 * 1024 * 2;
constexpr size_t OFF_W2 = OFF_WD1 + (size_t)1024 * 2816 * 2;
constexpr size_t OFF_WD2 = OFF_W2 + (size_t)5632 * 1024 * 2;
constexpr size_t OFF_WIN = OFF_WD2 + (size_t)1024 * 2816 * 2;
constexpr size_t OFF_WUQ = OFF_WIN + (size_t)1280 * 1024 * 2;
constexpr size_t OFF_WUKV = OFF_WUQ + (size_t)768 * 384 * 2;
constexpr size_t OFF_WGLU = OFF_WUKV + (size_t)1024 * 256 * 2;
constexpr size_t OFF_WOUT = OFF_WGLU + (size_t)512 * 512 * 2;
constexpr size_t OFF_WPG = OFF_WOUT + (size_t)1024 * 1024 * 2;
constexpr size_t OFF_WPP = OFF_WPG + (size_t)1024 * 1024 * 2;
constexpr size_t OFF_TAB = OFF_WPP + (size_t)1024 * 256 * 2;
constexpr size_t OFF_KTAB = OFF_TAB + (size_t)M_TOK * 32 * 4;
constexpr size_t OFF_PB = OFF_KTAB + (size_t)32 * 32 * 256 * 4;
constexpr size_t OFF_HB = OFF_PB + (size_t)M_TOK * 256 * 2;
constexpr size_t OFF_HBUF = OFF_HB + (size_t)M_TOK * 1024 * 2;
constexpr size_t OFF_S5 = OFF_HBUF + (size_t)M_TOK * 1024 * 4;
constexpr size_t OFF_MQ = OFF_S5;
constexpr size_t OFF_PM = OFF_MQ + (size_t)32 * 512 * 640 * 2;
constexpr size_t OFF_A2 = OFF_PM + (size_t)32 * 256 * 512 * 2;
constexpr size_t OFF_PP = OFF_HBUF + (size_t)64 * 1024 * 1024;
constexpr size_t OFF_ACT = OFF_A2 + (size_t)32 * 1024 * 640 * 2;
constexpr size_t OFF_CQB = OFF_ACT;
constexpr size_t OFF_CKVB = OFF_CQB + (size_t)M_TOK * 384 * 2;
constexpr size_t OFF_KPE = OFF_CKVB + (size_t)M_TOK * 256 * 2;
constexpr size_t OFF_QRAW = OFF_KPE + (size_t)M_TOK * 32 * 4;
constexpr size_t OFF_KVRAW = OFF_QRAW + (size_t)M_TOK * 768 * 2;
constexpr size_t OFF_E = OFF_KVRAW + (size_t)M_TOK * 1024 * 2;
constexpr size_t OFF_ACT_END = OFF_E + (size_t)32 * 1024 * 128 * 4;
constexpr size_t WS_END = OFF_ACT + (size_t)M_TOK * 2816 * 2;
static_assert(OFF_ACT_END <= WS_END, "act region overflow");
static_assert(OFF_PP + (size_t)M_TOK * 1024 * 2 <= OFF_S5, "pp overflow");
constexpr size_t OFF_BAR = WS_END;
static_assert(OFF_BAR + 16384 <= (size_t)536870912, "workspace too large");

struct Params {
    const float *x, *p; const int* pos;
    const float *norm_ffn1, *w1g, *w1u, *w1d, *norm_mix, *w_in, *lam_re, *lam_im, *log_dt, *b_re, *b_im, *c_re, *c_im, *ssm_d, *w_glu, *b_glu,
        *q_norm, *w_uq, *kv_norm, *w_ukv, *qkn_q, *qkn_k, *on_ssm, *on_att, *w_out, *norm_ffn2, *w2g, *w2u, *w2d, *norm_ple, *w_pg, *w_pp;
    float* out; char* ws;
    int ph_lo, ph_hi; long atom_off;
};

extern __shared__ __attribute__((aligned(16))) bf16_t shm[];
#ifndef PROBE_PH
#define PROBE_PH -1
#endif
#if PROBE_PH >= 0
__shared__ long s_aoff;
#define ATOM_OFF s_aoff
#else
#define ATOM_OFF 0
#endif

__device__ __forceinline__ unsigned pk_bf16(float lo, float hi) { unsigned r; asm volatile("v_cvt_pk_bf16_f32 %0, %1, %2" : "=v"(r) : "v"(lo), "v"(hi)); return r; }
__device__ __forceinline__ float bf_lo(unsigned u) { return __uint_as_float(u << 16); }
__device__ __forceinline__ float bf_hi(unsigned u) { return __uint_as_float(u & 0xffff0000u); }
__device__ __forceinline__ float sigmoidf_(float v) { return __builtin_amdgcn_rcpf(1.f + __expf(-v)); }
__device__ __forceinline__ void cisf(float ang, float& c, float& s) { float r = ang * 0.15915494309189535f; r -= floorf(r); c = __builtin_amdgcn_cosf(r); s = __builtin_amdgcn_sinf(r); }

__device__ __forceinline__ int lds_byte(int r, int c) { int st = (r >> 4) * 2 + (c >> 5), rr = r & 15, cc = c & 31, ob = rr * 64 + cc * 2; return st * 1024 + (ob ^ (((ob >> 9) & 1) << 5)); }
__device__ __forceinline__ void stage_rc(int b, int& R, int& C) { int st = b / 1024, sb = b % 1024, swz = sb ^ (((sb >> 9) & 1) << 5); R = (st >> 1) * 16 + swz / 64; C = (st & 1) * 32 + (swz % 64) / 2; }

#define LAS __attribute__((address_space(3)))
constexpr int HTB = HT * 2;
#define SA(b, h) (((b) * 2 + (h)) * HTB)
#define SB(b, h) ((4 + (b) * 2 + (h)) * HTB)
#define STAGE(bufoff, gbase, voff) do { _Pragma("unroll") for (int _i = 0; _i < 2; ++_i) \
    __builtin_amdgcn_global_load_lds((const unsigned*)((const char*)(gbase) + (voff)[_i]), (LAS unsigned*)(lds + (bufoff) + ldsw + _i * 8192), 16, 0, 0); } while (0)
#define LDA(dst, b, h) do { _Pragma("unroll") for (int m = 0; m < 4; ++m) _Pragma("unroll") for (int k = 0; k < 2; ++k) dst[m][k] = *(const LAS bf16x8*)(lds + SA(b, h) + aoff + m * 2048 + k * 1024); } while (0)
#define LDB(dst, b, h) do { _Pragma("unroll") for (int n = 0; n < 2; ++n) _Pragma("unroll") for (int k = 0; k < 2; ++k) dst[n][k] = *(const LAS bf16x8*)(lds + SB(b, h) + boff + n * 2048 + k * 1024); } while (0)
#define MMA(ai, bj, At_, Bt_) do { __builtin_amdgcn_s_setprio(1); _Pragma("unroll") for (int m = 0; m < 4; ++m) _Pragma("unroll") for (int n = 0; n < 2; ++n) _Pragma("unroll") for (int k = 0; k < 2; ++k) \
      acc[ai][bj][m][n] = __builtin_amdgcn_mfma_f32_16x16x32_bf16(Bt_[n][k], At_[m][k], acc[ai][bj][m][n], 0, 0, 0); \
    __builtin_amdgcn_s_setprio(0); } while (0)
#define WAIT_V(n) asm volatile("s_waitcnt vmcnt(" #n ")" ::: "memory")
#define WAIT_L(n) asm volatile("s_waitcnt lgkmcnt(" #n ")" ::: "memory")
#define BAR __builtin_amdgcn_s_barrier()
#define SCHED __builtin_amdgcn_sched_barrier(0)

__device__ __forceinline__ void gemm_pre(const char* cA, int lda, const char* cB, int ldb) {
    LAS unsigned char* lds = (LAS unsigned char*)shm;
    int tid = threadIdx.x; asm volatile("" : "+v"(tid));
    const int wid = __builtin_amdgcn_readfirstlane(tid >> 6);
    unsigned voffA[2], voffB[2];
#pragma unroll
    for (int i = 0; i < 2; ++i) { int R, C; stage_rc(tid * 16 + i * 8192, R, C); const int rho = R & 31, Rb = (R & ~31) + 8 * ((rho & 15) >> 2) + 4 * (rho >> 4) + (rho & 3);
        voffA[i] = (unsigned)(R * lda + C) * 2u; voffB[i] = (unsigned)(Rb * ldb + C) * 2u; }
    const size_t hA = (size_t)HALF * lda * 2, hB = (size_t)HALF * ldb * 2;
    const unsigned ldsw = (unsigned)wid * 1024u;
    STAGE(SB(0, 0), cB, voffB); STAGE(SA(0, 0), cA, voffA); STAGE(SB(0, 1), cB + hB, voffB); STAGE(SA(0, 1), cA + hA, voffA);
}
__device__ __forceinline__ void gemm_loop(f32x4 (&acc)[2][2][4][2], const char* cA, int lda, const char* cB, int ldb, int nt, bool pre) {
    LAS unsigned char* lds = (LAS unsigned char*)shm;
    int tid = threadIdx.x; asm volatile("" : "+v"(tid));
    const int wid = __builtin_amdgcn_readfirstlane(tid >> 6), lane = tid & 63, wr = wid >> 2, wc = wid & 3, fr = lane & 15, fq = lane >> 4;
    unsigned voffA[2], voffB[2];
#pragma unroll
    for (int i = 0; i < 2; ++i) { int R, C; stage_rc(tid * 16 + i * 8192, R, C); const int rho = R & 31, Rb = (R & ~31) + 8 * ((rho & 15) >> 2) + 4 * (rho >> 4) + (rho & 3);
        voffA[i] = (unsigned)(R * lda + C) * 2u; voffB[i] = (unsigned)(Rb * ldb + C) * 2u; }
    const size_t hA = (size_t)HALF * lda * 2, hB = (size_t)HALF * ldb * 2, kstep = BK * 2;
    const unsigned ldsw = (unsigned)wid * 1024u;
    const int aoff = lds_byte(wr * 64 + fr, fq * 8), boff = lds_byte(wc * 32 + fr, fq * 8);
    bf16x8 At[4][2], B0[2][2], B1[2][2];
    if (!pre) { STAGE(SB(0, 0), cB, voffB); STAGE(SA(0, 0), cA, voffA); STAGE(SB(0, 1), cB + hB, voffB); STAGE(SA(0, 1), cA + hA, voffA); }
    if (wr == 1) BAR;
    WAIT_V(4); BAR;
    STAGE(SB(1, 0), cB + kstep, voffB); STAGE(SA(1, 0), cA + kstep, voffA); STAGE(SB(1, 1), cB + hB + kstep, voffB);
    WAIT_V(6); BAR;
    for (int t = 0; t < nt - 2; t += 2) {
        const char* a1 = cA + (size_t)(t + 1) * kstep; const char* a2 = a1 + kstep; const char* a3 = a2 + kstep;
        const char* b2 = cB + (size_t)(t + 2) * kstep; const char* b3 = b2 + kstep;
        LDB(B0, 0, 0); SCHED; LDA(At, 0, 0); STAGE(SA(1, 1), a1 + hA, voffA);
        WAIT_L(8); BAR; WAIT_L(0); MMA(0, 0, At, B0); BAR; SCHED;
        LDB(B1, 0, 1); STAGE(SB(0, 0), b2, voffB);
        BAR; WAIT_L(0); MMA(0, 1, At, B1); BAR;
        LDA(At, 0, 1); STAGE(SA(0, 0), a2, voffA);
        BAR; WAIT_L(0); MMA(1, 0, At, B0); BAR; SCHED;
        STAGE(SB(0, 1), b2 + hB, voffB);
        WAIT_V(6); BAR; MMA(1, 1, At, B1); BAR;
        LDB(B0, 1, 0); SCHED; LDA(At, 1, 0); STAGE(SA(0, 1), a2 + hA, voffA);
        WAIT_L(8); BAR; WAIT_L(0); MMA(0, 0, At, B0); BAR; SCHED;
        LDB(B1, 1, 1); STAGE(SB(1, 0), b3, voffB);
        BAR; WAIT_L(0); MMA(0, 1, At, B1); BAR;
        LDA(At, 1, 1); STAGE(SA(1, 0), a3, voffA);
        BAR; WAIT_L(0); MMA(1, 0, At, B0); BAR; SCHED;
        STAGE(SB(1, 1), b3 + hB, voffB);
        WAIT_V(6); BAR; MMA(1, 1, At, B1); BAR;
    }
    { const char* a1 = cA + (size_t)(nt - 1) * kstep;
      LDB(B0, 0, 0); LDA(At, 0, 0); STAGE(SA(1, 1), a1 + hA, voffA);
      BAR; WAIT_L(0); MMA(0, 0, At, B0); BAR;
      LDB(B1, 0, 1); BAR; WAIT_L(0); MMA(0, 1, At, B1); BAR;
      LDA(At, 0, 1); WAIT_V(4); BAR; WAIT_L(0); MMA(1, 0, At, B0); MMA(1, 1, At, B1); BAR; }
    { LDB(B0, 1, 0); LDA(At, 1, 0); WAIT_V(2); BAR; WAIT_L(0); MMA(0, 0, At, B0); BAR;
      LDB(B1, 1, 1); WAIT_V(0); BAR; WAIT_L(0); MMA(0, 1, At, B1); BAR;
      LDA(At, 1, 1); BAR; WAIT_L(0); MMA(1, 0, At, B0); MMA(1, 1, At, B1); BAR; }
    if (wr == 0) BAR;
}

__device__ __forceinline__ void tile_map(int L, int nM, int nN, int& pm, int& pn) {
    const int nwg = nM * nN, q = nwg / 8, r = nwg % 8, xcd = L % 8, off = L / 8;
    const int wgid = (xcd < r ? xcd * (q + 1) : r * (q + 1) + (xcd - r) * q) + off;
    const int nig = 8 * nN, gid = wgid / nig, fm = gid * 8, gsz = (nM - fm) < 8 ? (nM - fm) : 8;
    pm = fm + ((wgid % nig) % gsz); pn = (wgid % nig) / gsz;
}

__device__ __forceinline__ void ld8(const bf16_t* p, float (&v)[8]) { const u32x4 w = *(const u32x4*)p;
    v[0] = bf_lo(w.x); v[1] = bf_hi(w.x); v[2] = bf_lo(w.y); v[3] = bf_hi(w.y); v[4] = bf_lo(w.z); v[5] = bf_hi(w.z); v[6] = bf_lo(w.w); v[7] = bf_hi(w.w); }
__device__ __forceinline__ void ld8f(const float* p, float (&v)[8]) { const f32x4 a = *(const f32x4*)p, b = *(const f32x4*)(p + 4);
    v[0] = a[0]; v[1] = a[1]; v[2] = a[2]; v[3] = a[3]; v[4] = b[0]; v[5] = b[1]; v[6] = b[2]; v[7] = b[3]; }
__device__ __forceinline__ void st8(bf16_t* p, const float (&v)[8]) { u32x4 w; w.x = pk_bf16(v[0], v[1]); w.y = pk_bf16(v[2], v[3]); w.z = pk_bf16(v[4], v[5]); w.w = pk_bf16(v[6], v[7]); *(u32x4*)p = w; }
__device__ __forceinline__ float sq8(const float (&v)[8]) { float s = 0.f;
#pragma unroll
    for (int i = 0; i < 8; ++i) s += v[i] * v[i]; return s; }


enum { E_SWIGLU = 0, E_DOWN, E_WIN, E_QRAW, E_KVRAW, E_S5E, E_S5Y, E_GLU, E_WOUT, E_PP, E_PLE };

#define WSP(T, off) ((T*)(P.ws + (off)))

__device__ __forceinline__ void store_bf4(bf16_t* p, f32x4 v) { u32x2 w; w.x = pk_bf16(v[0], v[1]); w.y = pk_bf16(v[2], v[3]); *(u32x2*)p = w; }

template <int MODE> __device__ __forceinline__ void epilogue(const f32x4 (&acc)[2][2][4][2], const Params& P, int brow, int bcol, int aux) {
    int tid_ = threadIdx.x; asm volatile("" : "+v"(tid_));
    const int wid = tid_ >> 6, lane = tid_ & 63, wr = wid >> 2, wc = wid & 3, fr = lane & 15, fq = lane >> 4;
    float* ss = WSP(float, OFF_SS);
#pragma unroll
    for (int ai = 0; ai < 2; ++ai)
#pragma unroll
        for (int m = 0; m < 4; ++m) {
            const int row = brow + ai * HALF + wr * 64 + m * 16 + fr;
            if constexpr (MODE == E_SWIGLU) {
                const float rs = rsqrtf(ss[(aux ? 2 : 0) * M_TOK + row] * (1.f / 1024.f) + EPS);
                bf16_t* act = WSP(bf16_t, OFF_ACT);
                float o[8];
#pragma unroll
                for (int n = 0; n < 2; ++n) {
                    const f32x4 g = acc[ai][0][m][n] * rs, u = acc[ai][1][m][n] * rs;
#pragma unroll
                    for (int j = 0; j < 4; ++j) o[n * 4 + j] = g[j] * sigmoidf_(g[j]) * u[j];
                }
                { u32x4 w_; w_.x = pk_bf16(o[0], o[1]); w_.y = pk_bf16(o[2], o[3]); w_.z = pk_bf16(o[4], o[5]); w_.w = pk_bf16(o[6], o[7]);
                  __builtin_nontemporal_store(w_, (u32x4*)(act + (long)row * DFF + (bcol >> 1) + wc * 32 + fq * 8)); }
            } else if constexpr (MODE == E_DOWN || MODE == E_WOUT) {
                bf16_t* hb = WSP(bf16_t, OFF_HB);
                float sc = 0.5f; int ssi = aux ? 3 : 1;
                if constexpr (MODE == E_WOUT) { sc = rsqrtf(ss[7 * M_TOK + row] * (1.f / 512.f) + EPS); ssi = 2; }
                float sq = 0.f;
                if constexpr (MODE == E_DOWN || MODE == E_WOUT) {
                    u32x4 rr8[2];
#pragma unroll
                    for (int bj = 0; bj < 2; ++bj) rr8[bj] = *(const u32x4*)(hb + (long)row * DM + bcol + bj * HALF + wc * 32 + fq * 8);
#pragma unroll
                    for (int bj = 0; bj < 2; ++bj) {
                        const f32x4 r0 = {bf_lo(rr8[bj].x), bf_hi(rr8[bj].x), bf_lo(rr8[bj].y), bf_hi(rr8[bj].y)}, r1 = {bf_lo(rr8[bj].z), bf_hi(rr8[bj].z), bf_lo(rr8[bj].w), bf_hi(rr8[bj].w)};
                        const f32x4 v0 = r0 + acc[ai][bj][m][0] * sc, v1 = r1 + acc[ai][bj][m][1] * sc;
                        u32x4 w; w.x = pk_bf16(v0[0], v0[1]); w.y = pk_bf16(v0[2], v0[3]); w.z = pk_bf16(v1[0], v1[1]); w.w = pk_bf16(v1[2], v1[3]);
                        *(u32x4*)(hb + (long)row * DM + bcol + bj * HALF + wc * 32 + fq * 8) = w;
                        sq += v0[0] * v0[0] + v0[1] * v0[1] + v0[2] * v0[2] + v0[3] * v0[3] + v1[0] * v1[0] + v1[1] * v1[1] + v1[2] * v1[2] + v1[3] * v1[3];
                    }
                } else {
                u32x2 rr[2][2];
#pragma unroll
                for (int bj = 0; bj < 2; ++bj)
#pragma unroll
                    for (int n = 0; n < 2; ++n) rr[bj][n] = *(const u32x2*)(hb + (long)row * DM + bcol + bj * HALF + wc * 32 + n * 16 + fq * 4);
#pragma unroll
                for (int bj = 0; bj < 2; ++bj)
#pragma unroll
                    for (int n = 0; n < 2; ++n) {
                        const int col = bcol + bj * HALF + wc * 32 + n * 16 + fq * 4;
                        const f32x4 r = {bf_lo(rr[bj][n].x), bf_hi(rr[bj][n].x), bf_lo(rr[bj][n].y), bf_hi(rr[bj][n].y)};
                        const f32x4 v = r + acc[ai][bj][m][n] * sc;
                        store_bf4(hb + (long)row * DM + col, v);
                        sq += v[0] * v[0] + v[1] * v[1] + v[2] * v[2] + v[3] * v[3];
                    }
                }
                sq += __shfl_xor(sq, 16); sq += __shfl_xor(sq, 32);
                if (fq == 0) unsafeAtomicAdd(ss + ATOM_OFF + ssi * M_TOK + row, sq);
            } else if constexpr (MODE == E_WIN) {
                const float rs = rsqrtf(ss[1 * M_TOK + row] * (1.f / 1024.f) + EPS);
#pragma unroll
                for (int bj = 0; bj < 2; ++bj) {
                    const int seg = (bcol >> 7) + bj;
                    const int col0 = bcol + bj * HALF + wc * 32 + fq * 8;
                    const f32x4 v0 = acc[ai][bj][m][0] * rs, v1 = acc[ai][bj][m][1] * rs;
                    u32x4 w; w.x = pk_bf16(v0[0], v0[1]); w.y = pk_bf16(v0[2], v0[3]); w.z = pk_bf16(v1[0], v1[1]); w.w = pk_bf16(v1[2], v1[3]);
                    float sq = v0[0] * v0[0] + v0[1] * v0[1] + v0[2] * v0[2] + v0[3] * v0[3] + v1[0] * v1[0] + v1[1] * v1[1] + v1[2] * v1[2] + v1[3] * v1[3];
                    if (seg < 4) {
                        const int g = col0 >> 4, hi = col0 & 15;
                        *(u32x4*)(WSP(bf16_t, OFF_A2) + ((long)g * 1024 + (row >> 5)) * 640 + (row & 31) * 16 + hi) = w;
                    } else if (seg < 7) {
                        *(u32x4*)(WSP(bf16_t, OFF_CQB) + (long)row * 384 + (col0 - 512)) = w;
                    } else if (seg < 9) {
                        *(u32x4*)(WSP(bf16_t, OFF_CKVB) + (long)row * 256 + (col0 - 896)) = w;
                    } else if (wc == 0) {
                        float mine[8] = {v0[0], v0[1], v0[2], v0[3], v1[0], v1[1], v1[2], v1[3]}, oth[8];
#pragma unroll
                        for (int i = 0; i < 8; ++i) oth[i] = __shfl_xor(mine[i], 32);
                        float q2 = sq; q2 += __shfl_xor(q2, 16); q2 += __shfl_xor(q2, 32);
                        if (fq == 0) ss[8 * M_TOK + row] = q2;
                        const int ib = (fq & 1) * 8;
                        float cs[8], sn[8], g1[8], g2[8], o[8];
                        ld8f(WSP(float, OFF_TAB) + (long)row * 32 + ib, cs); ld8f(WSP(float, OFF_TAB) + (long)row * 32 + 16 + ib, sn);
                        ld8f(P.qkn_k + 64 + ib, g1); ld8f(P.qkn_k + 80 + ib, g2);
#pragma unroll
                        for (int i = 0; i < 8; ++i) { const float x1 = (fq < 2 ? mine[i] : oth[i]) * g1[i], x2 = (fq < 2 ? oth[i] : mine[i]) * g2[i];
                            o[i] = fq < 2 ? (x1 * cs[i] - x2 * sn[i]) : (x1 * sn[i] + x2 * cs[i]); }
                        st8(WSP(bf16_t, OFF_KPE) + (long)row * 32 + (fq < 2 ? 0 : 16) + ib, o);
                    }
                    if (seg >= 4 && seg < 9) {
                        sq += __shfl_xor(sq, 16); sq += __shfl_xor(sq, 32);
                        if (fq == 0) unsafeAtomicAdd(ss + ATOM_OFF + (seg < 7 ? 4 : 5) * M_TOK + row, sq);
                    }
                }
            } else if constexpr (MODE == E_QRAW || MODE == E_KVRAW) {
                const float rs = (MODE == E_QRAW) ? rsqrtf(ss[4 * M_TOK + row] * (1.f / 384.f) + EPS) : rsqrtf(ss[5 * M_TOK + row] * (1.f / 256.f) + EPS);
                bf16_t* o = (MODE == E_QRAW) ? WSP(bf16_t, OFF_QRAW) : WSP(bf16_t, OFF_KVRAW);
                const int ld = (MODE == E_QRAW) ? 768 : 1024;
#pragma unroll
                for (int bj = 0; bj < 2; ++bj) {
                    const f32x4 v0 = acc[ai][bj][m][0] * rs, v1 = acc[ai][bj][m][1] * rs;
                    u32x4 w; w.x = pk_bf16(v0[0], v0[1]); w.y = pk_bf16(v0[2], v0[3]); w.z = pk_bf16(v1[0], v1[1]); w.w = pk_bf16(v1[2], v1[3]);
                    *(u32x4*)(o + (long)row * ld + bcol + bj * HALF + wc * 32 + fq * 8) = w;
                }
            } else if constexpr (MODE == E_S5E) {
                float* E = WSP(float, OFF_E) + (long)aux * 1024 * 128 + (long)row * 128 + wc * 32 + fq * 8;
                *(f32x4*)E = acc[ai][0][m][0]; *(f32x4*)(E + 4) = acc[ai][0][m][1];
            } else if constexpr (MODE == E_S5Y) {
                bf16_t* yg = (bf16_t*)P.out + (long)M_TOK * 1024;
#pragma unroll
                for (int bj = 0; bj < 2; ++bj) {
                    const int col = bcol + bj * HALF + wc * 32 + fq * 8, t = col >> 4, ho = col & 15;
                    float o[8];
#pragma unroll
                    for (int j = 0; j < 4; ++j) { const float a = acc[ai][bj][m][0][j], b = acc[ai][bj][m][1][j];
                        o[j] = a * sigmoidf_(1.5957691216f * (a + 0.044715f * a * a * a)); o[4 + j] = b * sigmoidf_(1.5957691216f * (b + 0.044715f * b * b * b)); }
                    st8(yg + ((long)row * 32 + t) * 512 + aux * 16 + ho, o);
                }
            } else if constexpr (MODE == E_GLU) {
                const bf16_t* yg = (const bf16_t*)P.out + (long)M_TOK * 1024; bf16_t* ymix = (bf16_t*)P.out;
                float sq = 0.f;
#pragma unroll
                for (int bj = 0; bj < 2; ++bj) {
                    const int col = bcol + bj * HALF + wc * 32 + fq * 8;
                    float bb[8], yy[8], o[8];
                    ld8f(P.b_glu + col, bb); ld8(yg + (long)row * 512 + col, yy);
#pragma unroll
                    for (int j = 0; j < 4; ++j) { o[j] = yy[j] * sigmoidf_(acc[ai][bj][m][0][j] + bb[j]); o[4 + j] = yy[4 + j] * sigmoidf_(acc[ai][bj][m][1][j] + bb[4 + j]); }
                    st8(ymix + (long)row * 1024 + col, o);
                    sq += sq8(o);
                }
                sq += __shfl_xor(sq, 16); sq += __shfl_xor(sq, 32);
                if (fq == 0) unsafeAtomicAdd(ss + ATOM_OFF + 6 * M_TOK + row, sq);
            } else if constexpr (MODE == E_PP) {
                bf16_t* pp = WSP(bf16_t, OFF_PP);
#pragma unroll
                for (int bj = 0; bj < 2; ++bj) {
                    const f32x4 v0 = acc[ai][bj][m][0], v1 = acc[ai][bj][m][1];
                    u32x4 w; w.x = pk_bf16(v0[0], v0[1]); w.y = pk_bf16(v0[2], v0[3]); w.z = pk_bf16(v1[0], v1[1]); w.w = pk_bf16(v1[2], v1[3]);
                    *(u32x4*)(pp + (long)row * 1024 + bcol + bj * HALF + wc * 32 + fq * 8) = w;
                }
            } else if constexpr (MODE == E_PLE) {
                const float rs = rsqrtf(ss[3 * M_TOK + row] * (1.f / 1024.f) + EPS);
                const bf16_t* pp = WSP(bf16_t, OFF_PP); const bf16_t* hb = WSP(bf16_t, OFF_HB);
#pragma unroll
                for (int bj = 0; bj < 2; ++bj) {
                    const int col = bcol + bj * HALF + wc * 32 + fq * 8;
                    float h8[8], p8[8];
                    ld8(hb + (long)row * DM + col, h8); ld8(pp + (long)row * 1024 + col, p8);
                    f32x4 o0, o1;
#pragma unroll
                    for (int j = 0; j < 4; ++j) { o0[j] = h8[j] + sigmoidf_(acc[ai][bj][m][0][j] * rs) * p8[j]; o1[j] = h8[4 + j] + sigmoidf_(acc[ai][bj][m][1][j] * rs) * p8[4 + j]; }
                    *(f32x4*)(P.out + (long)row * DM + col) = o0; *(f32x4*)(P.out + (long)row * DM + col + 4) = o1;
                }
            }
        }
}

__device__ __forceinline__ void epilogue_kv(const f32x4 (&acc)[2][2][4][2], const Params& P, int brow, int bcol) {
    int tid_ = threadIdx.x; asm volatile("" : "+v"(tid_));
    const int wid = tid_ >> 6, lane = tid_ & 63, wr = wid >> 2, wc = wid & 3, fr = lane & 15, fq = lane >> 4;
    const float* ss = WSP(float, OFF_SS);
    float* exch = (float*)((char*)shm + 32768);
    if (wc < 2) {
#pragma unroll
        for (int ai = 0; ai < 2; ++ai)
#pragma unroll
            for (int m = 0; m < 4; ++m) {
                const int rl = ai * HALF + wr * 64 + m * 16 + fr;
                const float rs = rsqrtf(ss[5 * M_TOK + brow + rl] * (1.f / 256.f) + EPS);
#pragma unroll
                for (int bj = 0; bj < 2; ++bj) {
                    float sq = 0.f;
#pragma unroll
                    for (int n = 0; n < 2; ++n) { const f32x4 v = acc[ai][bj][m][n] * rs; sq += v[0] * v[0] + v[1] * v[1] + v[2] * v[2] + v[3] * v[3]; }
                    sq += __shfl_xor(sq, 16); sq += __shfl_xor(sq, 32);
                    if (fq == 0) exch[(rl * 2 + bj) * 2 + wc] = sq;
                }
            }
    }
    __syncthreads();
#pragma unroll
    for (int ai = 0; ai < 2; ++ai)
#pragma unroll
        for (int m = 0; m < 4; ++m) {
            const int rl = ai * HALF + wr * 64 + m * 16 + fr, row = brow + rl, b = row >> 12, l = row & 4095;
            const float rs = rsqrtf(ss[5 * M_TOK + row] * (1.f / 256.f) + EPS), pe = ss[8 * M_TOK + row];
#pragma unroll
            for (int bj = 0; bj < 2; ++bj) {
                const int h = (bcol >> 7) + bj;
                const float rk = rsqrtf((exch[(rl * 2 + bj) * 2] + exch[(rl * 2 + bj) * 2 + 1] + pe) * (1.f / 96.f) + EPS);
                bf16_t* kf = WSP(bf16_t, OFF_HBUF) + ((long)(b * 8 + h) * SEQ + l) * 96;
                if (wc < 2) {
                    const f32x4 v0 = acc[ai][bj][m][0] * (rs * rk), v1 = acc[ai][bj][m][1] * (rs * rk);
                    u32x4 w; w.x = pk_bf16(v0[0], v0[1]); w.y = pk_bf16(v0[2], v0[3]); w.z = pk_bf16(v1[0], v1[1]); w.w = pk_bf16(v1[2], v1[3]);
                    *(u32x4*)(kf + wc * 32 + fq * 8) = w;
                } else {
                    const f32x4 v0 = acc[ai][bj][m][0] * rs, v1 = acc[ai][bj][m][1] * rs;
                    u32x4 w; w.x = pk_bf16(v0[0], v0[1]); w.y = pk_bf16(v0[2], v0[3]); w.z = pk_bf16(v1[0], v1[1]); w.w = pk_bf16(v1[2], v1[3]);
                    *(u32x4*)(WSP(bf16_t, OFF_KVRAW) + (long)row * 1024 + bcol + bj * HALF + wc * 32 + fq * 8) = w;
                    if (wc == 2 + bj) {
                        float kv[8]; ld8(WSP(bf16_t, OFF_KPE) + (long)row * 32 + fq * 8, kv);
#pragma unroll
                        for (int i = 0; i < 8; ++i) kv[i] *= rk;
                        st8(kf + 64 + fq * 8, kv);
                    }
                }
            }
        }
}

namespace pg8 {
#define PG8_LAS __attribute__((address_space(3)))
typedef unsigned short bf16_t;
typedef short bf16x8 __attribute__((ext_vector_type(8)));
typedef float f32x4 __attribute__((ext_vector_type(4)));
typedef unsigned u32x4 __attribute__((ext_vector_type(4)));
constexpr int BM = 256, BK = 64, HALF = 128, HTB = HALF * BK * 2  , STAGE_BYTES = 8 * HTB, NXCD = 8, WGM = 8;

__host__ __device__ __forceinline__ int lds_byte(int r, int c) { const int st = (r >> 4) * 2 + (c >> 5), rr = r & 15, cc = c & 31, ob = rr * 64 + cc * 2; return st * 1024 + (ob ^ (((ob >> 9) & 1) << 5)); }
__host__ __device__ __forceinline__ void stage_rc(int b, int& R, int& C) { const int st = b / 1024, sb = b % 1024, swz = sb ^ (((sb >> 9) & 1) << 5); R = (st >> 1) * 16 + swz / 64; C = (st & 1) * 32 + (swz % 64) / 2; }
__host__ __device__ __forceinline__ int perm32(int rho) { const int n = rho >> 4, i = rho & 15; return 8 * (i >> 2) + 4 * n + (i & 3); }

struct Unit { int pm, pn; };
struct Gemm { const bf16_t* A; const bf16_t* Bt; int M, N, K; };

struct StaticOrder {
    int nM, nN, nwg, G, c;
    __host__ __device__ void init(int M, int N, int G_, int c_) { nM = M / BM; nN = N / BM; nwg = nM * nN; G = G_; c = c_; }
    __host__ __device__ bool next(int i, Unit& u) const {
        const long L = (long)i * G + c; if (L >= nwg) return false;
        int wgid = (int)L; { const int q = nwg / NXCD, r = nwg % NXCD, xcd = wgid % NXCD, off = wgid / NXCD; wgid = (xcd < r ? xcd * (q + 1) : r * (q + 1) + (xcd - r) * q) + off; }
        const int nig = WGM * nN, gid = wgid / nig, fm = gid * WGM, gsz = (nM - fm) < WGM ? (nM - fm) : WGM;
        u.pm = fm + ((wgid % nig) % gsz); u.pn = (wgid % nig) / gsz; return true;
    }
    __device__ __forceinline__ void a_ready(const Unit&) const {}
    __device__ __forceinline__ void done(const Unit&) const {}
};
template <class Epi, class Sched, bool ALIGN_EPI = false, bool SP2 = false>
__device__ __forceinline__ void gemm_phase(PG8_LAS unsigned char* lds, const Gemm g, const Sched& S, const Epi& E) {
    int tid = threadIdx.x; asm volatile("" : "+v"(tid));
    const int wid = __builtin_amdgcn_readfirstlane(tid >> 6), lane = tid & 63, wr = wid >> 2, wc = wid & 3, fr = lane & 15, fq = lane >> 4;
    const int K = g.K, nt = K / BK;
    unsigned voffA[2], voffB[2];
#pragma unroll
    for (int i = 0; i < 2; ++i) { int R, C; stage_rc(tid * 16 + i * 8192, R, C); const int Rb = Epi::PERM ? ((R & ~31) + perm32(R & 31)) : R;
        voffA[i] = (unsigned)(R * K + C) * 2u; voffB[i] = (unsigned)(Rb * K + C) * 2u; }
    const size_t kstep = (size_t)(BK * 2);
    const size_t hstep = (size_t)HALF * K * 2;
    const size_t tstep = 2 * hstep;
    const unsigned ldsw = (unsigned)wid * 1024u;
    const int aoff = lds_byte(wr * 64 + fr, fq * 8), boff = lds_byte(wc * 32 + fr, fq * 8);
#define PG8_SA(b, h) (((b) * 2 + (h)) * HTB)
#define PG8_SB(b, h) ((4 + (b) * 2 + (h)) * HTB)
#define PG8_STAGE(bufoff, gbase, voff) do { _Pragma("unroll") for (int _i = 0; _i < 2; ++_i) \
        __builtin_amdgcn_global_load_lds((const unsigned*)((const char*)(gbase) + (voff)[_i]), (PG8_LAS unsigned*)(lds + (bufoff) + ldsw + _i * 8192), 16, 0, 0); } while (0)
#define PG8_LDA(dst, b, h) do { _Pragma("unroll") for (int m = 0; m < 4; ++m) _Pragma("unroll") for (int k = 0; k < 2; ++k) dst[m][k] = *(const PG8_LAS bf16x8*)(lds + PG8_SA(b, h) + aoff + m * 2048 + k * 1024); } while (0)
#define PG8_LDB(dst, b, h) do { _Pragma("unroll") for (int n = 0; n < 2; ++n) _Pragma("unroll") for (int k = 0; k < 2; ++k) dst[n][k] = *(const PG8_LAS bf16x8*)(lds + PG8_SB(b, h) + boff + n * 2048 + k * 1024); } while (0)
#define PG8_MMA(ai, bj, At, Bt) do { __builtin_amdgcn_s_setprio(1); _Pragma("unroll") for (int m = 0; m < 4; ++m) _Pragma("unroll") for (int n = 0; n < 2; ++n) _Pragma("unroll") for (int k = 0; k < 2; ++k) \
        acc[ai][bj][m][n] = __builtin_amdgcn_mfma_f32_16x16x32_bf16(Bt[n][k], At[m][k], acc[ai][bj][m][n], 0, 0, 0); __builtin_amdgcn_s_setprio(0); } while (0)
#define PG8_WAIT_V(n) asm volatile("s_waitcnt vmcnt(" #n ")" ::: "memory")
#define PG8_WAIT_L(n) asm volatile("s_waitcnt lgkmcnt(" #n ")" ::: "memory")
#define PG8_BAR __builtin_amdgcn_s_barrier()
#define PG8_SCHED __builtin_amdgcn_sched_barrier(0)
    Unit cur, nxt; int ui = 0;
    if (!S.next(0, cur)) return;
    f32x4 acc[2][2][4][2];
#pragma unroll
    for (int a = 0; a < 2; ++a)
#pragma unroll
        for (int b = 0; b < 2; ++b)
#pragma unroll
            for (int m = 0; m < 4; ++m)
#pragma unroll
                for (int n = 0; n < 2; ++n) acc[a][b][m][n] = (f32x4){0.f, 0.f, 0.f, 0.f};
    bf16x8 At[4][2], B0[2][2], B1[2][2];
    const char* cA = (const char*)g.A + (size_t)cur.pm * tstep; const char* cB = (const char*)g.Bt + (size_t)cur.pn * tstep;
    S.a_ready(cur);
    if constexpr (SP2) {
        PG8_STAGE(PG8_SB(0, 0), cB, voffB); PG8_STAGE(PG8_SB(0, 1), cB + hstep, voffB); PG8_STAGE(PG8_SA(0, 0), cA, voffA); PG8_STAGE(PG8_SA(0, 1), cA + hstep, voffA);
        if (wr == 1) PG8_BAR;
        PG8_WAIT_V(2); PG8_BAR;
        PG8_STAGE(PG8_SB(1, 0), cB + kstep, voffB); PG8_STAGE(PG8_SA(1, 0), cA + kstep, voffA); PG8_STAGE(PG8_SB(1, 1), cB + hstep + kstep, voffB);
        PG8_WAIT_V(6); PG8_BAR;
    } else {
        PG8_STAGE(PG8_SB(0, 0), cB, voffB); PG8_STAGE(PG8_SA(0, 0), cA, voffA); PG8_STAGE(PG8_SB(0, 1), cB + hstep, voffB); PG8_STAGE(PG8_SA(0, 1), cA + hstep, voffA);
        if (wr == 1) PG8_BAR;
        PG8_WAIT_V(4); PG8_BAR;
        PG8_STAGE(PG8_SB(1, 0), cB + kstep, voffB); PG8_STAGE(PG8_SA(1, 0), cA + kstep, voffA); PG8_STAGE(PG8_SB(1, 1), cB + hstep + kstep, voffB);
        PG8_WAIT_V(6); PG8_BAR;
    }
    for (;;) {
        const bool has_next = S.next(ui + 1, nxt);
        const char* nA = has_next ? (const char*)g.A + (size_t)nxt.pm * tstep : cA; const char* nB = has_next ? (const char*)g.Bt + (size_t)nxt.pn * tstep : cB;
        for (int t = 0; t < nt; t += 2) {
            const bool last = (t == nt - 2);
            const char* a1 = cA + (size_t)(t + 1) * kstep;
            const char* a2 = last ? nA : cA + (size_t)(t + 2) * kstep; const char* b2 = last ? nB : cB + (size_t)(t + 2) * kstep;
            const char* a3 = a2 + kstep; const char* b3 = b2 + kstep;
            if (last && has_next) S.a_ready(nxt);
            if constexpr (SP2) {
            PG8_LDB(B0, 0, 0); PG8_LDB(B1, 0, 1); PG8_SCHED; PG8_LDA(At, 0, 0); PG8_STAGE(PG8_SA(1, 1), a1 + hstep, voffA);
            PG8_WAIT_V(8); PG8_WAIT_L(0); PG8_BAR; PG8_MMA(0, 0, At, B0); PG8_MMA(0, 1, At, B1); PG8_BAR; PG8_SCHED;
            PG8_LDA(At, 0, 1); PG8_STAGE(PG8_SB(0, 0), b2, voffB); PG8_STAGE(PG8_SB(0, 1), b2 + hstep, voffB); PG8_STAGE(PG8_SA(0, 0), a2, voffA);
            PG8_WAIT_V(8); PG8_WAIT_L(0); PG8_BAR; PG8_MMA(1, 0, At, B0); PG8_MMA(1, 1, At, B1); PG8_BAR; PG8_SCHED;
            PG8_LDB(B0, 1, 0); PG8_LDB(B1, 1, 1); PG8_SCHED; PG8_LDA(At, 1, 0); PG8_STAGE(PG8_SA(0, 1), a2 + hstep, voffA);
            PG8_WAIT_V(8); PG8_WAIT_L(0); PG8_BAR; PG8_MMA(0, 0, At, B0); PG8_MMA(0, 1, At, B1); PG8_BAR; PG8_SCHED;
            PG8_LDA(At, 1, 1); PG8_STAGE(PG8_SB(1, 0), b3, voffB); PG8_STAGE(PG8_SB(1, 1), b3 + hstep, voffB); PG8_STAGE(PG8_SA(1, 0), a3, voffA);
            PG8_WAIT_V(8); PG8_WAIT_L(0); PG8_BAR; PG8_MMA(1, 0, At, B0); PG8_MMA(1, 1, At, B1); PG8_BAR; PG8_SCHED;
            } else {
            PG8_LDB(B0, 0, 0); PG8_SCHED; PG8_LDA(At, 0, 0); PG8_STAGE(PG8_SA(1, 1), a1 + hstep, voffA);
            PG8_WAIT_L(8); PG8_BAR; PG8_WAIT_L(0); PG8_MMA(0, 0, At, B0); PG8_BAR; PG8_SCHED;
            PG8_LDB(B1, 0, 1); PG8_STAGE(PG8_SB(0, 0), b2, voffB);
            PG8_BAR; PG8_WAIT_L(0); PG8_MMA(0, 1, At, B1); PG8_BAR;
            PG8_LDA(At, 0, 1); PG8_STAGE(PG8_SA(0, 0), a2, voffA);
            PG8_BAR; PG8_WAIT_L(0); PG8_MMA(1, 0, At, B0); PG8_BAR; PG8_SCHED;
            PG8_STAGE(PG8_SB(0, 1), b2 + hstep, voffB);
            PG8_WAIT_V(6); PG8_BAR; PG8_MMA(1, 1, At, B1); PG8_BAR;
            PG8_LDB(B0, 1, 0); PG8_SCHED; PG8_LDA(At, 1, 0); PG8_STAGE(PG8_SA(0, 1), a2 + hstep, voffA);
            PG8_WAIT_L(8); PG8_BAR; PG8_WAIT_L(0); PG8_MMA(0, 0, At, B0); PG8_BAR; PG8_SCHED;
            PG8_LDB(B1, 1, 1); PG8_STAGE(PG8_SB(1, 0), b3, voffB);
            PG8_BAR; PG8_WAIT_L(0); PG8_MMA(0, 1, At, B1); PG8_BAR;
            PG8_LDA(At, 1, 1); PG8_STAGE(PG8_SA(1, 0), a3, voffA);
            PG8_BAR; PG8_WAIT_L(0); PG8_MMA(1, 0, At, B0); PG8_BAR; PG8_SCHED;
            PG8_STAGE(PG8_SB(1, 1), b3 + hstep, voffB);
            PG8_WAIT_V(6); PG8_BAR; PG8_MMA(1, 1, At, B1); PG8_BAR;
            }
        }
        if constexpr (ALIGN_EPI) { if (wr == 0) PG8_BAR; }
        if constexpr (!Epi::AFTER_DRAIN) { E(acc, cur, wr, wc, fr, fq); S.done(cur); }
        if (!has_next) break;
#pragma unroll
        for (int a = 0; a < 2; ++a)
#pragma unroll
            for (int b = 0; b < 2; ++b)
#pragma unroll
                for (int m = 0; m < 4; ++m)
#pragma unroll
                    for (int n = 0; n < 2; ++n) acc[a][b][m][n] = (f32x4){0.f, 0.f, 0.f, 0.f};
        cur = nxt; cA = nA; cB = nB; ++ui;
        if constexpr (ALIGN_EPI) { if (wr == 1) PG8_BAR; }
    }
    PG8_WAIT_V(0);
    if constexpr (!ALIGN_EPI) { if (wr == 0) PG8_BAR; }
    PG8_BAR;
    if constexpr (Epi::AFTER_DRAIN) { E.fused(acc, cur, wr, wc, fr, fq, lds, wid, lane); S.done(cur); }
#undef PG8_SA
#undef PG8_SB
#undef PG8_STAGE
#undef PG8_LDA
#undef PG8_LDB
#undef PG8_MMA
#undef PG8_WAIT_V
#undef PG8_WAIT_L
#undef PG8_BAR
#undef PG8_SCHED
}
}

template <int MODE> struct EpiAd {
    static constexpr bool PERM = true, AFTER_DRAIN = false;
    const Params& P; int aux;
    __device__ __forceinline__ void operator()(const f32x4 (&acc)[2][2][4][2], const pg8::Unit& u, int, int, int, int) const { epilogue<MODE>(acc, P, u.pm * 256, u.pn * 256, aux); }
};
template <int MODE> __device__ __forceinline__ void stream_gemm(const Params& P, const bf16_t* A, const bf16_t* Bt, int N, int K, int aux) {
    pg8::Gemm g; g.A = A; g.Bt = Bt; g.M = M_TOK; g.N = N; g.K = K;
    pg8::StaticOrder S; S.init(M_TOK, N, (int)gridDim.x, (int)blockIdx.x);
    const EpiAd<MODE> E{P, aux};
    pg8::gemm_phase<EpiAd<MODE>, pg8::StaticOrder, true, true>((PG8_LAS unsigned char*)shm, g, S, E);
}

struct WtDesc { const float* W; const float* g1; const float* g2; bf16_t* out; int N, ksplit, ldo, mode, k0, n0; };
__device__ __forceinline__ WtDesc wt_desc(const Params& P, int task) {
    WtDesc d; int tile;
    if (task < 2112) { const int wsel = task / 352; tile = task % 352; const int f2 = wsel >= 3, k = wsel % 3;
        const float* nf = f2 ? P.norm_ffn2 : P.norm_ffn1;
        if (k == 2) { d.W = f2 ? P.w2d : P.w1d; d.N = 1024; d.g1 = nullptr; d.g2 = nullptr; d.ksplit = 0; d.out = WSP(bf16_t, f2 ? OFF_WD2 : OFF_WD1); d.ldo = 2816; d.mode = 0; }
        else { d.W = k == 0 ? (f2 ? P.w2g : P.w1g) : (f2 ? P.w2u : P.w1u); d.N = 2816; d.g1 = nf; d.g2 = nf; d.ksplit = 1024; d.out = WSP(bf16_t, f2 ? OFF_W2 : OFF_W1); d.ldo = 1024; d.mode = k == 0 ? 1 : 2; }
    } else if (task < 2272) { tile = task - 2112; d.W = P.w_in; d.N = 1184; d.g1 = P.norm_mix; d.g2 = P.norm_mix; d.ksplit = 1024; d.out = WSP(bf16_t, OFF_WIN); d.ldo = 1024; d.mode = 0; }
    else if (task < 2308) { tile = task - 2272; d.W = P.w_uq; d.N = 768; d.g1 = P.q_norm; d.g2 = P.q_norm; d.ksplit = 384; d.out = WSP(bf16_t, OFF_WUQ); d.ldo = 384; d.mode = 0; }
    else if (task < 2340) { tile = task - 2308; d.W = P.w_ukv; d.N = 1024; d.g1 = P.kv_norm; d.g2 = P.kv_norm; d.ksplit = 256; d.out = WSP(bf16_t, OFF_WUKV); d.ldo = 256; d.mode = 0; }
    else if (task < 2372) { tile = task - 2340; d.W = P.w_glu; d.N = 512; d.g1 = nullptr; d.g2 = nullptr; d.ksplit = 0; d.out = WSP(bf16_t, OFF_WGLU); d.ldo = 512; d.mode = 0; }
    else if (task < 2500) { tile = task - 2372; d.W = P.w_out; d.N = 1024; d.g1 = P.on_ssm; d.g2 = P.on_att; d.ksplit = 512; d.out = WSP(bf16_t, OFF_WOUT); d.ldo = 1024; d.mode = 0; }
    else if (task < 2628) { tile = task - 2500; d.W = P.w_pg; d.N = 1024; d.g1 = P.norm_ple; d.g2 = P.norm_ple; d.ksplit = 1024; d.out = WSP(bf16_t, OFF_WPG); d.ldo = 1024; d.mode = 0; }
    else { tile = task - 2628; d.W = P.w_pp; d.N = 1024; d.g1 = nullptr; d.g2 = nullptr; d.ksplit = 0; d.out = WSP(bf16_t, OFF_WPP); d.ldo = 256; d.mode = 0; }
    const int ntn = (d.N + 127) >> 7, tk = tile / ntn, tn = tile - tk * ntn; d.k0 = tk * 64; d.n0 = tn * 128;
    return d;
}
constexpr int NWT = 2660;
__device__ __forceinline__ void wt_load(const WtDesc& d, f32x4 (&r)[4]) {
    int t = threadIdx.x; asm volatile("" : "+v"(t));
    const int n = d.n0 + (t & 31) * 4;
#pragma unroll
    for (int i = 0; i < 4; ++i) {
        const int kk = d.k0 + (t >> 5) + 16 * i;
        f32x4 v = {0.f, 0.f, 0.f, 0.f};
        if (n < d.N) { v = __builtin_nontemporal_load((const f32x4*)(d.W + (long)kk * d.N + n)); if (d.g1) v *= (kk < d.ksplit ? d.g1[kk] : d.g2[kk - d.ksplit]); }
        r[i] = v;
    }
}
__device__ __forceinline__ void wt_store(const WtDesc& d, const f32x4 (&r)[4]) {
    float* tl = (float*)shm;
    int t = threadIdx.x; asm volatile("" : "+v"(t));
#pragma unroll
    for (int i = 0; i < 4; ++i) { float* q = tl + ((t >> 5) + 16 * i) * 129 + (t & 31) * 4; q[0] = r[i][0]; q[1] = r[i][1]; q[2] = r[i][2]; q[3] = r[i][3]; }
    __syncthreads();
#pragma unroll
    for (int i = 0; i < 2; ++i) {
        const int n = (t >> 3) + 64 * i, kc = (t & 7) * 8, nn = d.n0 + n;
        if (nn < d.N) {
            const int orow = d.mode == 0 ? nn : ((nn >> 7) * 256 + (d.mode == 2 ? 128 : 0) + (nn & 127));
            u32x4 w;
            w.x = pk_bf16(tl[(kc + 0) * 129 + n], tl[(kc + 1) * 129 + n]); w.y = pk_bf16(tl[(kc + 2) * 129 + n], tl[(kc + 3) * 129 + n]);
            w.z = pk_bf16(tl[(kc + 4) * 129 + n], tl[(kc + 5) * 129 + n]); w.w = pk_bf16(tl[(kc + 6) * 129 + n], tl[(kc + 7) * 129 + n]);
            *(u32x4*)(d.out + (long)orow * d.ldo + d.k0 + kc) = w;
        }
    }
    __syncthreads();
}

struct S5Mode { float lr, li, dt, cr, ci; };
__device__ __forceinline__ S5Mode s5_mode(const Params& P, int g, int p) {
    S5Mode m; m.lr = P.lam_re[g * 64 + p]; m.li = P.lam_im[g * 64 + p]; m.dt = __expf(P.log_dt[g]);
    float c, s; cisf(m.li * m.dt, c, s); const float e = __expf(m.lr * m.dt);
    const float nr = e * c - 1.f, ni = e * s, den = 1.f / (m.lr * m.lr + m.li * m.li);
    m.cr = (nr * m.lr + ni * m.li) * den; m.ci = (ni * m.lr - nr * m.li) * den;
    return m;
}
__device__ __forceinline__ void s5_pow(const S5Mode& m, float tau, float& zr, float& zi) {
    float c, s; cisf(m.li * m.dt * tau, c, s); const float e = __expf(m.lr * m.dt * tau); zr = e * c; zi = e * s;
}

__constant__ float c_inv_freq[16] = {1.0f, 0.5623413251903491f, 0.31622776601683794f, 0.1778279410038923f, 0.1f, 0.05623413251903491f, 0.03162277660168379f, 0.01778279410038923f,
    0.01f, 0.005623413251903491f, 0.0031622776601683794f, 0.0017782794100389228f, 0.001f, 0.0005623413251903491f, 0.00031622776601683794f, 0.00017782794100389227f};

typedef short s16x4 __attribute__((ext_vector_type(4)));
__device__ __forceinline__ u32x4 scale8(u32x4 w, float s) { u32x4 o;
    o.x = pk_bf16(bf_lo(w.x) * s, bf_hi(w.x) * s); o.y = pk_bf16(bf_lo(w.y) * s, bf_hi(w.y) * s); o.z = pk_bf16(bf_lo(w.z) * s, bf_hi(w.z) * s); o.w = pk_bf16(bf_lo(w.w) * s, bf_hi(w.w) * s); return o; }
__device__ __forceinline__ void attn_item(const Params& P, int bh, int qb) {
    int tid = threadIdx.x; asm volatile("" : "+v"(tid));
    const int w = tid >> 6, lane = tid & 63, l32 = lane & 31, hi = lane >> 5;
    const int b = bh >> 3, h = bh & 7;
    const bf16_t* kvraw = WSP(bf16_t, OFF_KVRAW) + (long)b * SEQ * 1024 + h * 128;
    const bf16_t* kfp = WSP(bf16_t, OFF_HBUF) + (long)bh * SEQ * 96;
    LAS unsigned char* lds = (LAS unsigned char*)shm;
    const int wq = __builtin_amdgcn_readfirstlane(w);
    const int q0 = qb * 256, qrow = q0 + w * 32 + l32, wmin = q0 + wq * 32;
    bf16x8 qf[6];
    {
        const long tokq = (long)b * SEQ + qrow;
        const bf16_t* qr = WSP(bf16_t, OFF_QRAW) + tokq * 768 + h * 96 + hi * 8;
        float qv[6][8]; float sq = 0.f;
#pragma unroll
        for (int ks = 0; ks < 6; ++ks) { ld8(qr + ks * 16, qv[ks]); sq += sq8(qv[ks]); }
        sq += __shfl_xor(sq, 32);
        const float rs = rsqrtf(sq * (1.f / 96.f) + EPS), qs = 0.10206207261596575f * 1.4426950408889634f;
        float cs[8], sn[8];
        ld8f(WSP(float, OFF_TAB) + tokq * 32 + hi * 8, cs); ld8f(WSP(float, OFF_TAB) + tokq * 32 + 16 + hi * 8, sn);
#pragma unroll
        for (int ks = 0; ks < 4; ++ks) { float g[8], gk[8]; ld8f(P.qkn_q + ks * 16 + hi * 8, g); ld8f(P.qkn_k + ks * 16 + hi * 8, gk);
#pragma unroll
            for (int i = 0; i < 8; ++i) qv[ks][i] *= rs * g[i] * gk[i] * qs; }
        { float g1[8], g2[8]; ld8f(P.qkn_q + 64 + hi * 8, g1); ld8f(P.qkn_q + 80 + hi * 8, g2);
#pragma unroll
            for (int i = 0; i < 8; ++i) { const float x1 = qv[4][i] * rs * g1[i] * qs, x2 = qv[5][i] * rs * g2[i] * qs; qv[4][i] = x1 * cs[i] - x2 * sn[i]; qv[5][i] = x1 * sn[i] + x2 * cs[i]; } }
#pragma unroll
        for (int ks = 0; ks < 6; ++ks) { union { bf16x8 v; unsigned u[4]; } t;
#pragma unroll
            for (int i = 0; i < 4; ++i) t.u[i] = pk_bf16(qv[ks][2 * i], qv[ks][2 * i + 1]);
            qf[ks] = t.v; }
    }
    f32x16 o0, o1;
#pragma unroll
    for (int r = 0; r < 16; ++r) { o0[r] = 0.f; o1[r] = 0.f; }
    f32x16 lacc;
#pragma unroll
    for (int r = 0; r < 16; ++r) lacc[r] = 0.f;
    bf16x8 ones8;
#pragma unroll
    for (int i = 0; i < 8; ++i) ones8[i] = (short)0x3F80;
    const int nkt = 4 * (qb + 1);
    constexpr int KSLOT = 12288, VSLOT = 8192, VRING = 3 * KSLOT;
    int kga0, kga1, vga;
    { const int p0 = 64 * wq + lane, k0_ = p0 / 12, c0_ = p0 - 12 * k0_; const int cc0 = (c0_ - ((k0_ >> 2) & 3) + 12) % 12; kga0 = k0_ * 96 + cc0 * 8;
      const int p1 = 64 * ((wq & 3) + 8) + lane, k1_ = p1 / 12, c1_ = p1 - 12 * k1_; const int cc1 = (c1_ - ((k1_ >> 2) & 3) + 12) % 12; kga1 = k1_ * 96 + cc1 * 8;
      const int vkey = 8 * wq + (lane >> 3), vc = (lane & 7) ^ (((vkey >> 1) & 1) << 1); vga = vkey * 1024 + 64 + vc * 8; }
#define ATT_DMA_K(kt_, slot_) do { const bf16_t* g_ = kfp + (long)(kt_) * 64 * 96; \
        __builtin_amdgcn_global_load_lds((const unsigned*)(g_ + kga0), (LAS unsigned*)(lds + (slot_) * KSLOT + wq * 1024), 16, 0, 0); \
        if (wq < 4) __builtin_amdgcn_global_load_lds((const unsigned*)(g_ + kga1), (LAS unsigned*)(lds + (slot_) * KSLOT + (wq + 8) * 1024), 16, 0, 0); } while (0)
#define ATT_DMA_V(kt_, slot_) do { const bf16_t* g_ = kvraw + (long)(kt_) * 64 * 1024; \
        __builtin_amdgcn_global_load_lds((const unsigned*)(g_ + vga), (LAS unsigned*)(lds + VRING + (slot_) * VSLOT + wq * 1024), 16, 0, 0); } while (0)
    int koff[6];
#pragma unroll
    for (int ks = 0; ks < 6; ++ks) koff[ks] = (l32 * 12 + ((2 * ks + hi + ((l32 >> 2) & 3)) % 12)) * 16;
    const int g16 = lane >> 4, dhalf = g16 & 1, tr_r = (lane & 15) >> 2, tr_c = lane & 3;
    const int vtr_off = (4 * hi + tr_r) * 128 + (((dhalf ^ ((tr_r >> 1) & 1)) * 2 + (tr_c >> 1)) * 16) + (tr_c & 1) * 8;
    const unsigned lds_base = (unsigned)(unsigned long long)lds;
#define TR_RD(dst, addr, off) asm volatile("ds_read_b64_tr_b16 %0, %1 offset:" #off : "=v"(dst) : "v"(addr))
#define QK_TILE(S0, S1, kslot_) do { bf16x8 kf[12]; const LAS unsigned char* kb_ = lds + (kslot_) * KSLOT; \
        _Pragma("unroll") for (int ks = 0; ks < 6; ++ks) { kf[2 * ks] = *(const LAS bf16x8*)(kb_ + koff[ks]); kf[2 * ks + 1] = *(const LAS bf16x8*)(kb_ + koff[ks] + 6144); } \
        __builtin_amdgcn_sched_barrier(0); \
        _Pragma("unroll") for (int r = 0; r < 16; ++r) { S0[r] = 0.f; S1[r] = 0.f; } \
        __builtin_amdgcn_s_setprio(1); \
        _Pragma("unroll") for (int ks = 0; ks < 6; ++ks) { \
            S0 = __builtin_amdgcn_mfma_f32_32x32x16_bf16(kf[2 * ks], qf[ks], S0, 0, 0, 0); \
            S1 = __builtin_amdgcn_mfma_f32_32x32x16_bf16(kf[2 * ks + 1], qf[ks], S1, 0, 0, 0); } \
        __builtin_amdgcn_s_setprio(0); \
        __builtin_amdgcn_sched_barrier(0); } while (0)
#define ATT_BODY(KT, GEN) do { const int kt = (KT); \
        { const int ktn = kt + 2 < nkt ? kt + 2 : nkt - 1; ATT_DMA_K(ktn, s2_); ATT_DMA_V(ktn, s2_); } \
        if (!(GEN) || kt * 64 <= wmin + 31) { \
            f32x16 S0, S1; \
            QK_TILE(S0, S1, s0_); \
            const unsigned vb = lds_base + VRING + s0_ * VSLOT + vtr_off; \
            s16x4 vf[16]; \
            TR_RD(vf[0], vb, 0); TR_RD(vf[1], vb, 1024); TR_RD(vf[2], vb, 64); TR_RD(vf[3], vb, 1088); \
            TR_RD(vf[4], vb, 2048); TR_RD(vf[5], vb, 3072); TR_RD(vf[6], vb, 2112); TR_RD(vf[7], vb, 3136); \
            TR_RD(vf[8], vb, 4096); TR_RD(vf[9], vb, 5120); TR_RD(vf[10], vb, 4160); TR_RD(vf[11], vb, 5184); \
            TR_RD(vf[12], vb, 6144); TR_RD(vf[13], vb, 7168); TR_RD(vf[14], vb, 6208); TR_RD(vf[15], vb, 7232); \
            __builtin_amdgcn_sched_barrier(0); \
            if ((GEN) && kt * 64 + 63 > wmin) { \
                _Pragma("unroll") for (int r = 0; r < 16; ++r) { \
                    const int key = kt * 64 + 8 * (r >> 2) + 4 * hi + (r & 3); \
                    if (key > qrow) S0[r] = -1e30f; \
                    if (key + 32 > qrow) S1[r] = -1e30f; } } \
              \
              \
            _Pragma("unroll") for (int r = 0; r < 16; ++r) { S0[r] = __builtin_amdgcn_exp2f(S0[r]); S1[r] = __builtin_amdgcn_exp2f(S1[r]); } \
            asm volatile("s_waitcnt lgkmcnt(0)" : "+v"(vf[0]), "+v"(vf[1]), "+v"(vf[2]), "+v"(vf[3]), "+v"(vf[4]), "+v"(vf[5]), "+v"(vf[6]), "+v"(vf[7]), \
                         "+v"(vf[8]), "+v"(vf[9]), "+v"(vf[10]), "+v"(vf[11]), "+v"(vf[12]), "+v"(vf[13]), "+v"(vf[14]), "+v"(vf[15]) :: "memory"); \
            _Pragma("unroll") for (int q = 0; q < 4; ++q) { \
                union { bf16x8 v; unsigned u[4]; } pf; \
                _Pragma("unroll") for (int i = 0; i < 4; ++i) pf.u[i] = (q >> 1) == 0 ? pk_bf16(S0[8 * (q & 1) + 2 * i], S0[8 * (q & 1) + 2 * i + 1]) : pk_bf16(S1[8 * (q & 1) + 2 * i], S1[8 * (q & 1) + 2 * i + 1]); \
                union { bf16x8 v; s16x4 h[2]; } va, vb2; \
                va.h[0] = vf[4 * q + 0]; va.h[1] = vf[4 * q + 1]; vb2.h[0] = vf[4 * q + 2]; vb2.h[1] = vf[4 * q + 3]; \
                o0 = __builtin_amdgcn_mfma_f32_32x32x16_bf16(va.v, pf.v, o0, 0, 0, 0); \
                o1 = __builtin_amdgcn_mfma_f32_32x32x16_bf16(vb2.v, pf.v, o1, 0, 0, 0); \
                lacc = __builtin_amdgcn_mfma_f32_32x32x16_bf16(ones8, pf.v, lacc, 0, 0, 0); } \
        } \
          \
        if (wq < 4) asm volatile("s_waitcnt vmcnt(3)" ::: "memory"); else asm volatile("s_waitcnt vmcnt(2)" ::: "memory"); \
        __builtin_amdgcn_s_barrier(); \
        { const int t_ = s0_; s0_ = s1_; s1_ = s2_; s2_ = t_; } } while (0)
    __syncthreads();
    ATT_DMA_K(0, 0); ATT_DMA_K(1, 1); ATT_DMA_V(0, 0); ATT_DMA_V(1, 1);
    asm volatile("s_waitcnt vmcnt(0)" ::: "memory");
    __builtin_amdgcn_s_barrier();
    int s0_ = 0, s1_ = 1, s2_ = 2;
    int kfull = (wmin + 1) >> 6; kfull = kfull < nkt ? kfull : nkt;
    int kti = 0;
    for (; kti < kfull; ++kti) ATT_BODY(kti, 0);
    for (; kti < nkt; ++kti) ATT_BODY(kti, 1);
    asm volatile("s_waitcnt vmcnt(0)" ::: "memory");
    __builtin_amdgcn_s_barrier();
#undef QK_TILE
#undef TR_RD
#undef ATT_BODY
#undef ATT_DMA_K
#undef ATT_DMA_V
    const float inv = 1.f / lacc[0];
    const long tok = (long)b * SEQ + qrow;
    bf16_t* ymix = ((bf16_t*)P.out) + tok * 1024 + 512 + h * 64;
    float sq = 0.f;
#pragma unroll
    for (int g4 = 0; g4 < 4; ++g4) {
        f32x4 a, c;
#pragma unroll
        for (int j = 0; j < 4; ++j) { a[j] = o0[g4 * 4 + j] * inv; c[j] = o1[g4 * 4 + j] * inv; sq += a[j] * a[j] + c[j] * c[j]; }
        store_bf4(ymix + 8 * g4 + 4 * hi, a);
        store_bf4(ymix + 32 + 8 * g4 + 4 * hi, c);
    }
    sq += __shfl_xor(sq, 32);
    if (hi == 0) unsafeAtomicAdd(WSP(float, OFF_SS) + ATOM_OFF + 7 * M_TOK + tok, sq);
}

__device__ __forceinline__ void s5_scan_task(const Params& P, int g, int b, float* T) {
    int tid = threadIdx.x; asm volatile("" : "+v"(tid));
    const int p = tid & 63, part = tid >> 6;
    const S5Mode md = s5_mode(P, g, p); float ar, ai, a16r, a16i; s5_pow(md, 32.f, ar, ai); s5_pow(md, 512.f, a16r, a16i);
    const float* E = WSP(float, OFF_E) + ((long)g * 1024 + b * 128 + part * 16) * 128;
    bf16_t* A2 = WSP(bf16_t, OFF_A2) + ((long)g * 1024 + b * 128 + part * 16) * 640 + 512;
    float er[16], ei[16], lr[16], li[16];
#pragma unroll
    for (int j = 0; j < 16; ++j) { er[j] = E[(long)j * 128 + p]; ei[j] = E[(long)j * 128 + 64 + p]; }
    float sr = 0.f, si = 0.f;
#pragma unroll
    for (int j = 0; j < 16; ++j) { lr[j] = sr; li[j] = si; const float nr = ar * sr - ai * si + er[j], ni = ar * si + ai * sr + ei[j]; sr = nr; si = ni; }
    __syncthreads();
    T[(part * 2 + 0) * 64 + p] = sr; T[(part * 2 + 1) * 64 + p] = si;
    __syncthreads();
    float wr_ = 0.f, wi_ = 0.f;
    for (int k = 0; k < part; ++k) { const float tr = T[(k * 2 + 0) * 64 + p], ti = T[(k * 2 + 1) * 64 + p]; const float nr = a16r * wr_ - a16i * wi_ + tr, ni = a16r * wi_ + a16i * wr_ + ti; wr_ = nr; wi_ = ni; }
#pragma unroll
    for (int j = 0; j < 16; ++j) {
        A2[(long)j * 640 + p] = (bf16_t)(pk_bf16(lr[j] + wr_, 0.f) & 0xffff); A2[(long)j * 640 + 64 + p] = (bf16_t)(pk_bf16(li[j] + wi_, 0.f) & 0xffff);
        const float nr = ar * wr_ - ai * wi_, ni = ar * wi_ + ai * wr_; wr_ = nr; wi_ = ni;
    }
    __syncthreads();
}

#define XB_TMO      128
#define XB_XCNT(j)  (256  + 64 * (j))
#define XB_XSUB(j)  (1280 + 64 * (j))
#define XB_XGEN(j)  (2304 + 64 * (j))
#define XB_TOP      3328
#define XB_TOPGEN   3392
#define XCD_BAR_WORDS 3456
#define XB_SPIN_CAP (1u << 18)

__device__ __forceinline__ unsigned xb_ld(unsigned* p)              { return __hip_atomic_load(p, __ATOMIC_RELAXED, __HIP_MEMORY_SCOPE_AGENT); }
__device__ __forceinline__ unsigned xb_add(unsigned* p, unsigned v) { return __hip_atomic_fetch_add(p, v, __ATOMIC_RELAXED, __HIP_MEMORY_SCOPE_AGENT); }
__device__ __forceinline__ unsigned xb_xcc_id() { return (unsigned)__builtin_amdgcn_s_getreg((3 << 11) | 20) & 0xFu; }
#define XB_SPIN(cond, bar) do { unsigned _sp = 0; while (cond) { __builtin_amdgcn_s_sleep(1); \
    if ((++_sp & 255u) == 0u) { if (xb_ld(&(bar)[XB_TMO])) break; if (_sp > XB_SPIN_CAP) { atomicAdd(&(bar)[XB_TMO], 1u); break; } } } } while (0)

struct XcdBarrier {
    unsigned* bar; unsigned x;
    volatile LAS unsigned* st;
};

__device__ __forceinline__ XcdBarrier xcd_barrier_post(unsigned* bar, volatile LAS unsigned* st) {
    XcdBarrier b; b.bar = bar; b.x = xb_xcc_id(); b.st = st;
    if (threadIdx.x == 0) (void)xb_add(&bar[XB_XCNT(b.x)], 1u);
    return b;
}
__device__ __forceinline__ void xcd_barrier_complete(unsigned* bar, unsigned x, unsigned& nloc, unsigned& nx) {
    const unsigned G = gridDim.x * gridDim.y * gridDim.z;
    unsigned sum, cnt, mine, sp = 0u;
    for (;;) {
        sum = 0u; cnt = 0u; mine = 0u;
#pragma unroll
        for (unsigned j = 0; j < 16; ++j) { const unsigned c = xb_ld(&bar[XB_XCNT(j)]); sum += c; cnt += (c > 0u) ? 1u : 0u; mine = (j == x) ? c : mine; }
        if (sum == G) break;
        __builtin_amdgcn_s_sleep(1);
        if ((++sp & 255u) == 0u) { if (xb_ld(&bar[XB_TMO])) break; if (sp > XB_SPIN_CAP) { atomicAdd(&bar[XB_TMO], 1u); break; } }
    }
    nloc = mine > 0u ? mine : 1u; nx = cnt > 0u ? cnt : 1u;
}

__device__ __forceinline__ void xcd_barrier(const XcdBarrier& b) {
    asm volatile("s_waitcnt vmcnt(0)" ::: "memory");
    __syncthreads();
    if (threadIdx.x == 0) {
        unsigned* bar = b.bar;
        __builtin_amdgcn_s_waitcnt(0);
        unsigned nloc = b.st[0], nx = b.st[1];
        if (nloc == 0u) { xcd_barrier_complete(bar, b.x, nloc, nx); b.st[0] = nloc; b.st[1] = nx; }
        const unsigned old = xb_add(&bar[XB_XSUB(b.x)], 1u);
        const unsigned gen = old / nloc;
        if (old + 1u == (gen + 1u) * nloc) {
            __builtin_amdgcn_fence(__ATOMIC_RELEASE, "agent");
            asm volatile("s_waitcnt vmcnt(0)" ::: "memory");
            const unsigned og = xb_add(&bar[XB_TOP], 1u);
            const unsigned tg = og / nx;
            if (og + 1u == (tg + 1u) * nx) xb_add(&bar[XB_TOPGEN], 1u);
            else XB_SPIN(xb_ld(&bar[XB_TOPGEN]) == tg, bar);
            __builtin_amdgcn_fence(__ATOMIC_ACQUIRE, "agent");
            xb_add(&bar[XB_XGEN(b.x)], 1u);
            asm volatile("s_waitcnt vmcnt(0)" ::: "memory");
        } else {
            XB_SPIN(xb_ld(&bar[XB_XGEN(b.x)]) == gen, bar);
            __builtin_amdgcn_fence(__ATOMIC_ACQUIRE, "agent");
            asm volatile("s_waitcnt vmcnt(0)" ::: "memory");
        }
    }
    __syncthreads();
}


__global__ void __launch_bounds__(512, 2) mega(Params P) {
    const int G = gridDim.x, cb = blockIdx.x;
    __shared__ uint4 xb_words;
    if (threadIdx.x == 0) xb_words = make_uint4(0u, 0u, 0u, 0u);
    __syncthreads();
    const XcdBarrier xbar = xcd_barrier_post((unsigned*)(P.ws + OFF_BAR), (volatile LAS unsigned*)&xb_words);
    for (int phr = P.ph_lo * 2; phr < P.ph_hi * 2; ++phr) {
        const int ph = phr >> 1;
        if ((phr & 1) && ph != PROBE_PH) continue;
        if (ph == 5) continue;
#if PROBE_PH >= 0
        __syncthreads(); if (threadIdx.x == 0) s_aoff = (phr & 1) ? (long)24 * M_TOK : 0; __syncthreads();
#endif
        if (phr > P.ph_lo * 2) { if (P.ph_lo < 0) cg::this_grid().sync(); else xcd_barrier(xbar); }
        int tid = threadIdx.x; asm volatile("" : "+v"(tid));
        if (ph == 0) {
            for (int task = cb; task < NWT; task += 2 * G) {
                const WtDesc d0 = wt_desc(P, task); f32x4 r0[4]; wt_load(d0, r0);
                const int t1 = task + G;
                if (t1 < NWT) { const WtDesc d1 = wt_desc(P, t1); f32x4 r1[4]; wt_load(d1, r1); wt_store(d0, r0); wt_store(d1, r1); }
                else wt_store(d0, r0);
            }
            constexpr int R8 = 0, R9 = R8 + 1024  , R10 = R9 + 512  , R11 = R10 + 120  , R12 = R11 + 1024  , R13 = R12 + 512  ,
                          R14 = R13 + 256  , R15 = R14 + 128  , R16 = R15 + 1  ;
            for (int task = cb; task < R16; task += G) {
                if (task < R9) {
                    const int lane = tid & 63, row0 = (task - R8) * 32 + (tid >> 6) * 4;
                    f32x4 v[4][4];
#pragma unroll
                    for (int rr = 0; rr < 4; ++rr)
#pragma unroll
                        for (int i = 0; i < 4; ++i) v[rr][i] = __builtin_nontemporal_load((const f32x4*)(P.x + (long)(row0 + rr) * DM + i * 256 + lane * 4));
#pragma unroll
                    for (int rr = 0; rr < 4; ++rr) {
                        bf16_t* xb = WSP(bf16_t, OFF_HB) + (long)(row0 + rr) * DM; float sq = 0.f;
#pragma unroll
                        for (int i = 0; i < 4; ++i) { const f32x4 a = v[rr][i]; sq += a[0] * a[0] + a[1] * a[1] + a[2] * a[2] + a[3] * a[3]; store_bf4(xb + i * 256 + lane * 4, a); }
#pragma unroll
                        for (int o = 32; o > 0; o >>= 1) sq += __shfl_xor(sq, o);
                        if (lane == 0) WSP(float, OFF_SS)[row0 + rr] = sq;
                    }
                } else if (task < R10) {
                    f32x4 a[4], b[4];
#pragma unroll
                    for (int i = 0; i < 4; ++i) { const long e = ((long)(task - R9) * 2048 + i * 512 + tid) * 8; a[i] = __builtin_nontemporal_load((const f32x4*)(P.p + e)); b[i] = __builtin_nontemporal_load((const f32x4*)(P.p + e + 4)); }
#pragma unroll
                    for (int i = 0; i < 4; ++i) { const long e = ((long)(task - R9) * 2048 + i * 512 + tid) * 8;
                        u32x4 w; w.x = pk_bf16(a[i][0], a[i][1]); w.y = pk_bf16(a[i][2], a[i][3]); w.z = pk_bf16(b[i][0], b[i][1]); w.w = pk_bf16(b[i][2], b[i][3]);
                        *(u32x4*)(WSP(bf16_t, OFF_PB) + e) = w; }
                } else if (task < R11) {
                    const int zt = task - R10;
                    const long e = (zt < 56 ? (long)M_TOK : (long)16 * M_TOK - (long)56 * 4096) + ((long)zt * 512 + tid) * 8;
                    const f32x4 z = {0.f, 0.f, 0.f, 0.f};
                    *(f32x4*)(WSP(float, OFF_SS) + e) = z; *(f32x4*)(WSP(float, OFF_SS) + e + 4) = z;
                } else if (task < R12) {
                    const int id = (task - R11) * 512 + tid, m = id >> 4, i = id & 15;
                    const double ang = (double)P.pos[m] * (double)c_inv_freq[i];
                    double r = ang * 0.15915494309189535; r -= floor(r);
                    float* tab = WSP(float, OFF_TAB) + (long)m * 32;
                    tab[i] = __builtin_amdgcn_cosf((float)r); tab[16 + i] = __builtin_amdgcn_sinf((float)r);
                } else if (task < R13) {
                    const int g = (task - R12) >> 4, tau0 = ((task - R12) & 15) * 2;
                    float* wre = (float*)shm; float* wim = wre + 2048; float* cre = wim + 2048; float* cim = cre + 1024;
                    __syncthreads();
#pragma unroll
                    for (int i = 0; i < 4; ++i) { const int idx = i * 512 + tid, hi_ = idx & 15, p = (idx >> 4) & 63, tl_ = idx >> 10;
                        const S5Mode md = s5_mode(P, g, p); float zr, zi; s5_pow(md, (float)(tau0 + tl_), zr, zi);
                        const float br = P.b_re[(g * 64 + p) * 16 + hi_], bi = P.b_im[(g * 64 + p) * 16 + hi_];
                        const float bbr = md.cr * br - md.ci * bi, bbi = md.cr * bi + md.ci * br;
                        wre[idx] = zr * bbr - zi * bbi; wim[idx] = zr * bbi + zi * bbr; }
#pragma unroll
                    for (int i = 0; i < 2; ++i) { const int idx = i * 512 + tid; cre[idx] = P.c_re[g * 1024 + idx]; cim[idx] = P.c_im[g * 1024 + idx]; }
                    __syncthreads();
                    const int hi_ = tid & 15, ho = (tid >> 4) & 15, tl_ = tid >> 8;
                    float a = 0.f;
#pragma unroll 8
                    for (int p = 0; p < 64; ++p) a += cre[ho * 64 + p] * wre[(tl_ * 64 + p) * 16 + hi_] - cim[ho * 64 + p] * wim[(tl_ * 64 + p) * 16 + hi_];
                    if (tau0 + tl_ == 0 && ho == hi_) a += P.ssm_d[g * 16 + ho];
                    WSP(float, OFF_KTAB)[((g * 32 + tau0 + tl_) * 16 + ho) * 16 + hi_] = a;
                    __syncthreads();
                } else if (task < R14) {
                    const int id = (task - R13) * 512 + tid, s = id & 31, j = (id >> 5) & 127, g = id >> 12, p = j & 63;
                    const S5Mode md = s5_mode(P, g, p); float zr, zi; s5_pow(md, (float)(31 - s), zr, zi);
                    float br[16], bi[16];
#pragma unroll
                    for (int q = 0; q < 4; ++q) { const f32x4 a = *(const f32x4*)(P.b_re + (g * 64 + p) * 16 + q * 4), b = *(const f32x4*)(P.b_im + (g * 64 + p) * 16 + q * 4);
#pragma unroll
                        for (int e = 0; e < 4; ++e) { br[q * 4 + e] = a[e]; bi[q * 4 + e] = b[e]; } }
                    float o[16];
#pragma unroll
                    for (int h = 0; h < 16; ++h) { const float bbr = md.cr * br[h] - md.ci * bi[h], bbi = md.cr * bi[h] + md.ci * br[h]; o[h] = j < 64 ? (zr * bbr - zi * bbi) : (zr * bbi + zi * bbr); }
                    bf16_t* dst = WSP(bf16_t, OFF_PM) + ((long)g * 128 + j) * 512 + s * 16;
                    u32x4 w0, w1; w0.x = pk_bf16(o[0], o[1]); w0.y = pk_bf16(o[2], o[3]); w0.z = pk_bf16(o[4], o[5]); w0.w = pk_bf16(o[6], o[7]);
                    w1.x = pk_bf16(o[8], o[9]); w1.y = pk_bf16(o[10], o[11]); w1.z = pk_bf16(o[12], o[13]); w1.w = pk_bf16(o[14], o[15]);
                    *(u32x4*)dst = w0; *(u32x4*)(dst + 8) = w1;
                } else if (task < R15) {
                    const int id = (task - R14) * 512 + tid, p = id & 63, t = (id >> 6) & 31, g = id >> 11;
                    const S5Mode md = s5_mode(P, g, p); float zr, zi; s5_pow(md, (float)(t + 1), zr, zi);
                    bf16_t* dst = WSP(bf16_t, OFF_MQ) + ((long)g * 512 + t * 16) * 640 + 512 + p;
#pragma unroll
                    for (int ho = 0; ho < 16; ++ho) { const float cr = P.c_re[(g * 16 + ho) * 64 + p], ci = P.c_im[(g * 16 + ho) * 64 + p];
                        dst[(long)ho * 640] = (bf16_t)(pk_bf16(cr * zr - ci * zi, 0.f) & 0xffff); dst[(long)ho * 640 + 64] = (bf16_t)(pk_bf16(-(cr * zi + ci * zr), 0.f) & 0xffff); }
                } else {
                    for (int e = tid; e < 96 * 1024 / 8; e += 512) { const u32x4 z = {0u, 0u, 0u, 0u}; *(u32x4*)(WSP(bf16_t, OFF_WIN) + (long)1184 * 1024 + (long)e * 8) = z; }
                }
            }
        } else if (ph == 4) {
            for (int task = cb; task < 2048; task += G) {
                const int id = task * 512 + tid, c8 = id & 63, rowq = (id >> 6) & 511, g = id >> 15;
                const int t = rowq >> 4, ho = rowq & 15, s = c8 >> 1, hi0 = (c8 & 1) * 8;
                u32x4 w = {0u, 0u, 0u, 0u};
                if (s <= t) { const float* kt = WSP(float, OFF_KTAB) + (((long)g * 32 + (t - s)) * 16 + ho) * 16 + hi0;
                    const f32x4 a = *(const f32x4*)kt, b = *(const f32x4*)(kt + 4);
                    w.x = pk_bf16(a[0], a[1]); w.y = pk_bf16(a[2], a[3]); w.z = pk_bf16(b[0], b[1]); w.w = pk_bf16(b[2], b[3]); }
                *(u32x4*)(WSP(bf16_t, OFF_MQ) + ((long)g * 512 + rowq) * 640 + c8 * 8) = w;
            }
        } else if (ph == 6) {
            for (int it = cb; it < 1024; it += G) {
                const int r = (it >> 6) & 3, j = it >> 8, bh = it & 63;
                const int qb = (j & 1) ? (15 - 4 * j - (3 - r)) : (15 - 4 * j - r);
                attn_item(P, bh, qb);
            }
        }
        switch (ph) {
            case 1: stream_gemm<E_SWIGLU>(P, WSP(bf16_t, OFF_HB), WSP(bf16_t, OFF_W1), 5632, 1024, 0); break;
            case 9: stream_gemm<E_SWIGLU>(P, WSP(bf16_t, OFF_HB), WSP(bf16_t, OFF_W2), 5632, 1024, 1); break;
            case 2: stream_gemm<E_DOWN>(P, WSP(bf16_t, OFF_ACT), WSP(bf16_t, OFF_WD1), 1024, 2816, 0); break;
            case 10: stream_gemm<E_DOWN>(P, WSP(bf16_t, OFF_ACT), WSP(bf16_t, OFF_WD2), 1024, 2816, 1); break;
            case 3: stream_gemm<E_WIN>(P, WSP(bf16_t, OFF_HB), WSP(bf16_t, OFF_WIN), 1280, 1024, 0); break;
            case 7: stream_gemm<E_GLU>(P, (const bf16_t*)P.out + (long)M_TOK * 1024, WSP(bf16_t, OFF_WGLU), 512, 512, 0); break;
            case 11: stream_gemm<E_PLE>(P, WSP(bf16_t, OFF_HB), WSP(bf16_t, OFF_WPG), 1024, 1024, 0); break;
            default: break;
        }
        int ntiles = 0;
        switch (ph) {
            case 4: ntiles = 128 * 3 + 128 * 4 + 128; break;
            case 6: ntiles = 256; break;
            case 8: ntiles = 128 * 4; break;
            case 3: ntiles = 128 * 4; break;
            default: break;
        }
        struct TD { const char *Ap, *Bp, *Ap2, *Bp2; int lda, ldb, nt, nt2, mode, aux, brow, bcol; };
        auto make_td = [&](int L) -> TD {
            const bf16_t *A = nullptr, *Bt = nullptr, *A2p = nullptr, *B2p = nullptr; int lda = 0, ldb = 0, nt = 0, mode = 0, aux = 0, pm = 0, pn = 0, nt2 = 0;
            switch (ph) {
                case 4:
                    if (L < 384) { tile_map(L, 128, 3, pm, pn); A = WSP(bf16_t, OFF_CQB); lda = 384; Bt = WSP(bf16_t, OFF_WUQ); ldb = 384; nt = 6; mode = E_QRAW; }
                    else if (L < 896) { tile_map(L - 384, 128, 4, pm, pn); A = WSP(bf16_t, OFF_CKVB); lda = 256; Bt = WSP(bf16_t, OFF_WUKV); ldb = 256; nt = 4; mode = E_KVRAW; }
                    else { const int tl = L - 896; aux = tl >> 2; pm = tl & 3; pn = 0; A = WSP(bf16_t, OFF_A2) + (long)aux * 1024 * 640; lda = 640; Bt = WSP(bf16_t, OFF_PM) + (long)aux * 128 * 512; ldb = 512; nt = 8; mode = E_S5E; }
                    break;
                case 6: { aux = L >> 3; pm = (L & 7) >> 1; pn = L & 1; A = WSP(bf16_t, OFF_A2) + (long)aux * 1024 * 640; lda = 640; Bt = WSP(bf16_t, OFF_MQ) + (long)aux * 512 * 640; ldb = 640; nt = 10; mode = E_S5Y; } break;
                case 8: tile_map(L, 128, 4, pm, pn); A = (const bf16_t*)P.out; lda = 1024; Bt = WSP(bf16_t, OFF_WOUT); ldb = 1024; nt = 8; nt2 = 8; A2p = A + 512; B2p = Bt + 512; mode = E_WOUT; break;
                case 3: { tile_map(L, 128, 4, pm, pn); A = WSP(bf16_t, OFF_PB); lda = 256; Bt = WSP(bf16_t, OFF_WPP); ldb = 256; nt = 4; mode = E_PP; } break;
                default: break;
            }
            TD d; d.lda = lda; d.ldb = ldb; d.nt = nt; d.nt2 = nt2; d.mode = mode; d.aux = aux; d.brow = pm * BM; d.bcol = pn * BM;
            d.Ap = (const char*)(A + (long)d.brow * lda); d.Bp = (const char*)(Bt + (long)d.bcol * ldb);
            d.Ap2 = nt2 ? (const char*)(A2p + (long)d.brow * lda) : d.Ap; d.Bp2 = nt2 ? (const char*)(B2p + (long)d.bcol * ldb) : d.Bp;
            return d;
        };
        TD cur{}; bool pre = false;
        int L0 = cb, Lstep = G;
        if (ph == 3) { Lstep = G / 2; if (cb >= G / 2) { L0 = cb - G / 2; ntiles = 3 * (G / 2) < ntiles ? 3 * (G / 2) : ntiles; } else L0 = 3 * (G / 2) + cb; }
        if (L0 < ntiles) cur = make_td(L0);
        for (int L = L0; L < ntiles; L += Lstep) {
            const int lda = cur.lda, ldb = cur.ldb, nt = cur.nt, nt2 = cur.nt2, mode = cur.mode, aux = cur.aux;
            const int brow = cur.brow, bcol = cur.bcol;
            f32x4 acc[2][2][4][2];
#pragma unroll
            for (int a = 0; a < 2; ++a)
#pragma unroll
                for (int b = 0; b < 2; ++b)
#pragma unroll
                    for (int m = 0; m < 4; ++m)
#pragma unroll
                        for (int n = 0; n < 2; ++n) acc[a][b][m][n] = (f32x4){0.f, 0.f, 0.f, 0.f};
            const char* Ap = cur.Ap; const char* Bp = cur.Bp; int ntc = nt;
            for (int part = 0; part < (nt2 ? 2 : 1); ++part) {
                gemm_loop(acc, Ap, lda, Bp, ldb, ntc, pre && part == 0);
                if (nt2 && part == 0) {
                    int tid_ = threadIdx.x; asm volatile("" : "+v"(tid_));
                    const int wid = tid_ >> 6, lane = tid_ & 63, wr = wid >> 2, fr = lane & 15;
                    const float* ss = WSP(float, OFF_SS);
#pragma unroll
                    for (int a = 0; a < 2; ++a)
#pragma unroll
                        for (int m = 0; m < 4; ++m) {
                            const int row = brow + a * HALF + wr * 64 + m * 16 + fr;
                            const float ratio = rsqrtf(ss[6 * M_TOK + row] * (1.f / 512.f) + EPS) / rsqrtf(ss[7 * M_TOK + row] * (1.f / 512.f) + EPS);
#pragma unroll
                            for (int b = 0; b < 2; ++b)
#pragma unroll
                                for (int n = 0; n < 2; ++n) acc[a][b][m][n] *= ratio;
                        }
                    Ap = cur.Ap2; Bp = cur.Bp2; ntc = nt2;
                }
            }
            TD nxt = cur; pre = false;
            if (L + Lstep < ntiles) { nxt = make_td(L + Lstep); gemm_pre(nxt.Ap, nxt.lda, nxt.Bp, nxt.ldb); pre = true; }
            switch (mode) {
                case E_SWIGLU: epilogue<E_SWIGLU>(acc, P, brow, bcol, aux); break;
                case E_DOWN: epilogue<E_DOWN>(acc, P, brow, bcol, aux); break;
                case E_WIN: epilogue<E_WIN>(acc, P, brow, bcol, aux); break;
                case E_QRAW: epilogue<E_QRAW>(acc, P, brow, bcol, aux); break;
                case E_KVRAW: epilogue_kv(acc, P, brow, bcol); break;
                case E_S5E: epilogue<E_S5E>(acc, P, brow, bcol, aux);
                    __syncthreads();
                    s5_scan_task(P, aux, 2 * (brow >> 8), (float*)((char*)shm + 32768)); s5_scan_task(P, aux, 2 * (brow >> 8) + 1, (float*)((char*)shm + 32768));
                    break;
                case E_S5Y: epilogue<E_S5Y>(acc, P, brow, bcol, aux); break;
                case E_GLU: epilogue<E_GLU>(acc, P, brow, bcol, aux); break;
                case E_WOUT: epilogue<E_WOUT>(acc, P, brow, bcol, aux); break;
                case E_PP: epilogue<E_PP>(acc, P, brow, bcol, aux); break;
                default: epilogue<E_PLE>(acc, P, brow, bcol, aux); break;
            }
            cur = nxt;
        }
    }
}

extern "C" void kernel_launch(void* const* d_in, const int* in_sizes, int n_in, void* d_out, int out_size, void* d_ws, size_t ws_size, hipStream_t stream) {
    static int grid = 0;
    if (grid == 0) {
        if (n_in != 35 || ws_size < OFF_BAR + 16384 || out_size != M_TOK * DM) { fprintf(stderr, "kernel_launch: unexpected problem (n_in %d, ws %zu need %zu, out %d)\n", n_in, ws_size, (size_t)WS_END, out_size); grid = -1; return; }
        int dev = 0, cus = 0, per_cu = 0;
        hipGetDevice(&dev); hipDeviceGetAttribute(&cus, hipDeviceAttributeMultiprocessorCount, dev);
        if (hipFuncSetAttribute((const void*)mega, hipFuncAttributeMaxDynamicSharedMemorySize, SHM_B) != hipSuccess) { fprintf(stderr, "kernel_launch: hipFuncSetAttribute failed\n"); grid = -1; return; }
        if (hipOccupancyMaxActiveBlocksPerMultiprocessor(&per_cu, (const void*)mega, 512, SHM_B) != hipSuccess || per_cu < 1) { fprintf(stderr, "kernel_launch: occupancy query failed (%d)\n", per_cu); (void)hipGetLastError(); per_cu = 1; }
        grid = cus * per_cu;
        if (grid > 256) grid = 256;
        grid &= ~7;
    }
    if (grid <= 0) return;
    Params P{};
    const float** fp = (const float**)&P.norm_ffn1;
    P.x = (const float*)d_in[0]; P.p = (const float*)d_in[1]; P.pos = (const int*)d_in[2];
    for (int i = 3; i < 35; ++i) fp[i - 3] = (const float*)d_in[i];
    P.out = (float*)d_out; P.ws = (char*)d_ws;
#if MK_MULTI
    for (int ph = 0; ph < 12; ++ph) { P.ph_lo = ph; P.ph_hi = ph + 1; hipLaunchKernelGGL(mega, dim3(grid), dim3(512), SHM_B, stream, P); }
#else
    P.ph_lo = 0; P.ph_hi = 12;
    (void)hipMemsetAsync((char*)d_ws + OFF_BAR, 0, 16384, stream);
    void* args[] = {&P};
    hipError_t e = hipLaunchCooperativeKernel((void*)mega, dim3(grid), dim3(512), args, SHM_B, stream);
    if (e != hipSuccess) fprintf(stderr, "cooperative launch failed: %s (grid %d)\n", hipGetErrorString(e), grid);
#endif
}
```

```cpp
#include <hip/hip_runtime.h>
#include <hip/hip_cooperative_groups.h>
#include <cstdint>
#include <cstdio>
namespace cg = cooperative_groups;

typedef unsigned short bf16_t;
typedef short bf16x8 __attribute__((ext_vector_type(8)));
typedef float f32x4 __attribute__((ext_vector_type(4)));
typedef float f32x16 __attribute__((ext_vector_type(16)));
typedef unsigned u32x2 __attribute__((ext_vector_type(2)));
typedef unsigned u32x4 __attribute__((ext_vector_type(4)));

#ifndef MK_MULTI
#define MK_MULTI 0
#endif
#ifndef PROBE_MASK
#define PROBE_MASK 0
#endif
#ifndef PROBE_SEL
#define PROBE_SEL 0
#endif

constexpr int M_TOK = 32768, DM = 1024, DFF = 2816, SEQ = 4096;
constexpr int BM = 256, BK = 64, HALF = 128, HT = HALF * BK, SHM_B = 8 * HT * 2;
constexpr float EPS = 1e-6f;

constexpr size_t SZ_SS = (size_t)48 * M_TOK * 4;
constexpr size_t OFF_SS = 0;
constexpr size_t OFF_W1 = OFF_SS + SZ_SS;
constexpr size_t OFF_WD1 = OFF_W1 + (size_t)5632 * 1024 * 2;
constexpr size_t OFF_W2 = OFF_WD1 + (size_t)1024 * 2816 * 2;
constexpr size_t OFF_WD2 = OFF_W2 + (size_t)5632 * 1024 * 2;
constexpr size_t OFF_WIN = OFF_WD2 + (size_t)1024 * 2816 * 2;
constexpr size_t OFF_WUQ = OFF_WIN + (size_t)1280 * 1024 * 2;
constexpr size_t OFF_WUKV = OFF_WUQ + (size_t)768 * 384 * 2;
constexpr size_t OFF_WGLU = OFF_WUKV + (size_t)1024 * 256 * 2;
constexpr size_t OFF_WOUT = OFF_WGLU + (size_t)512 * 512 * 2;
constexpr size_t OFF_WPG = OFF_WOUT + (size_t)1024 * 1024 * 2;
constexpr size_t OFF_WPP = OFF_WPG + (size_t)1024 * 1024 * 2;
constexpr size_t OFF_TAB = OFF_WPP + (size_t)1024 * 256 * 2;
constexpr size_t OFF_KTAB = OFF_TAB + (size_t)M_TOK * 32 * 4;
constexpr size_t OFF_PB = OFF_KTAB + (size_t)32 * 32 * 256 * 4;
constexpr size_t OFF_HB = OFF_PB + (size_t)M_TOK * 256 * 2;
constexpr size_t OFF_HBUF = OFF_HB + (size_t)M_TOK * 1024 * 2;
constexpr size_t OFF_S5 = OFF_HBUF + (size_t)M_TOK * 1024 * 4;
constexpr size_t OFF_MQ = OFF_S5;
constexpr size_t OFF_PM = OFF_MQ + (size_t)32 * 512 * 640 * 2;
constexpr size_t OFF_A2 = OFF_PM + (size_t)32 * 256 * 512 * 2;
constexpr size_t OFF_PP = OFF_HBUF + (size_t)64 * 1024 * 1024;
constexpr size_t OFF_ACT = OFF_A2 + (size_t)32 * 1024 * 640 * 2;
constexpr size_t OFF_CQB = OFF_ACT;
constexpr size_t OFF_CKVB = OFF_CQB + (size_t)M_TOK * 384 * 2;
constexpr size_t OFF_KPE = OFF_CKVB + (size_t)M_TOK * 256 * 2;
constexpr size_t OFF_QRAW = OFF_KPE + (size_t)M_TOK * 32 * 4;
constexpr size_t OFF_KVRAW = OFF_QRAW + (size_t)M_TOK * 768 * 2;
constexpr size_t OFF_E = OFF_KVRAW + (size_t)M_TOK * 1024 * 2;
constexpr size_t OFF_ACT_END = OFF_E + (size_t)32 * 1024 * 128 * 4;
constexpr size_t WS_END = OFF_ACT + (size_t)M_TOK * 2816 * 2;
static_assert(OFF_ACT_END <= WS_END, "act region overflow");
static_assert(OFF_PP + (size_t)M_TOK * 1024 * 2 <= OFF_S5, "pp overflow");
constexpr size_t OFF_BAR = WS_END;
static_assert(OFF_BAR + 16384 <= (size_t)536870912, "workspace too large");

struct Params {
    const float *x, *p; const int* pos;
    const float *norm_ffn1, *w1g, *w1u, *w1d, *norm_mix, *w_in, *lam_re, *lam_im, *log_dt, *b_re, *b_im, *c_re, *c_im, *ssm_d, *w_glu, *b_glu,
        *q_norm, *w_uq, *kv_norm, *w_ukv, *qkn_q, *qkn_k, *on_ssm, *on_att, *w_out, *norm_ffn2, *w2g, *w2u, *w2d, *norm_ple, *w_pg, *w_pp;
    float* out; char* ws;
    int ph_lo, ph_hi; long atom_off;
};

extern __shared__ __attribute__((aligned(16))) bf16_t shm[];
#ifndef PROBE_PH
#define PROBE_PH -1
#endif
#if PROBE_PH >= 0
__shared__ long s_aoff;
#define ATOM_OFF s_aoff
#else
#define ATOM_OFF 0
#endif

__device__ __forceinline__ unsigned pk_bf16(float lo, float hi) { unsigned r; asm volatile("v_cvt_pk_bf16_f32 %0, %1, %2" : "=v"(r) : "v"(lo), "v"(hi)); return r; }
__device__ __forceinline__ float bf_lo(unsigned u) { return __uint_as_float(u << 16); }
__device__ __forceinline__ float bf_hi(unsigned u) { return __uint_as_float(u & 0xffff0000u); }
__device__ __forceinline__ float sigmoidf_(float v) { return __builtin_amdgcn_rcpf(1.f + __expf(-v)); }
__device__ __forceinline__ void cisf(float ang, float& c, float& s) { float r = ang * 0.15915494309189535f; r -= floorf(r); c = __builtin_amdgcn_cosf(r); s = __builtin_amdgcn_sinf(r); }

__device__ __forceinline__ int lds_byte(int r, int c) { int st = (r >> 4) * 2 + (c >> 5), rr = r & 15, cc = c & 31, ob = rr * 64 + cc * 2; return st * 1024 + (ob ^ (((ob >> 9) & 1) << 5)); }
__device__ __forceinline__ void stage_rc(int b, int& R, int& C) { int st = b / 1024, sb = b % 1024, swz = sb ^ (((sb >> 9) & 1) << 5); R = (st >> 1) * 16 + swz / 64; C = (st & 1) * 32 + (swz % 64) / 2; }

#define LAS __attribute__((address_space(3)))
constexpr int HTB = HT * 2;
#define SA(b, h) (((b) * 2 + (h)) * HTB)
#define SB(b, h) ((4 + (b) * 2 + (h)) * HTB)
#define STAGE(bufoff, gbase, voff) do { _Pragma("unroll") for (int _i = 0; _i < 2; ++_i) \
    __builtin_amdgcn_global_load_lds((const unsigned*)((const char*)(gbase) + (voff)[_i]), (LAS unsigned*)(lds + (bufoff) + ldsw + _i * 8192), 16, 0, 0); } while (0)
#define LDA(dst, b, h) do { _Pragma("unroll") for (int m = 0; m < 4; ++m) _Pragma("unroll") for (int k = 0; k < 2; ++k) dst[m][k] = *(const LAS bf16x8*)(lds + SA(b, h) + aoff + m * 2048 + k * 1024); } while (0)
#define LDB(dst, b, h) do { _Pragma("unroll") for (int n = 0; n < 2; ++n) _Pragma("unroll") for (int k = 0; k < 2; ++k) dst[n][k] = *(const LAS bf16x8*)(lds + SB(b, h) + boff + n * 2048 + k * 1024); } while (0)
#define MMA(ai, bj, At_, Bt_) do { __builtin_amdgcn_s_setprio(1); _Pragma("unroll") for (int m = 0; m < 4; ++m) _Pragma("unroll") for (int n = 0; n < 2; ++n) _Pragma("unroll") for (int k = 0; k < 2; ++k) \
      acc[ai][bj][m][n] = __builtin_amdgcn_mfma_f32_16x16x32_bf16(Bt_[n][k], At_[m][k], acc[ai][bj][m][n], 0, 0, 0); \
    __builtin_amdgcn_s_setprio(0); } while (0)
#define WAIT_V(n) asm volatile("s_waitcnt vmcnt(" #n ")" ::: "memory")
#define WAIT_L(n) asm volatile("s_waitcnt lgkmcnt(" #n ")" ::: "memory")
#define BAR __builtin_amdgcn_s_barrier()
#define SCHED __builtin_amdgcn_sched_barrier(0)

__device__ __forceinline__ void gemm_pre(const char* cA, int lda, const char* cB, int ldb) {
    LAS unsigned char* lds = (LAS unsigned char*)shm;
    int tid = threadIdx.x; asm volatile("" : "+v"(tid));
    const int wid = __builtin_amdgcn_readfirstlane(tid >> 6);
    unsigned voffA[2], voffB[2];
#pragma unroll
    for (int i = 0; i < 2; ++i) { int R, C; stage_rc(tid * 16 + i * 8192, R, C); const int rho = R & 31, Rb = (R & ~31) + 8 * ((rho & 15) >> 2) + 4 * (rho >> 4) + (rho & 3);
        voffA[i] = (unsigned)(R * lda + C) * 2u; voffB[i] = (unsigned)(Rb * ldb + C) * 2u; }
    const size_t hA = (size_t)HALF * lda * 2, hB = (size_t)HALF * ldb * 2;
    const unsigned ldsw = (unsigned)wid * 1024u;
    STAGE(SB(0, 0), cB, voffB); STAGE(SA(0, 0), cA, voffA); STAGE(SB(0, 1), cB + hB, voffB); STAGE(SA(0, 1), cA + hA, voffA);
}
__device__ __forceinline__ void gemm_loop(f32x4 (&acc)[2][2][4][2], const char* cA, int lda, const char* cB, int ldb, int nt, bool pre) {
    LAS unsigned char* lds = (LAS unsigned char*)shm;
    int tid = threadIdx.x; asm volatile("" : "+v"(tid));
    const int wid = __builtin_amdgcn_readfirstlane(tid >> 6), lane = tid & 63, wr = wid >> 2, wc = wid & 3, fr = lane & 15, fq = lane >> 4;
    unsigned voffA[2], voffB[2];
#pragma unroll
    for (int i = 0; i < 2; ++i) { int R, C; stage_rc(tid * 16 + i * 8192, R, C); const int rho = R & 31, Rb = (R & ~31) + 8 * ((rho & 15) >> 2) + 4 * (rho >> 4) + (rho & 3);
        voffA[i] = (unsigned)(R * lda + C) * 2u; voffB[i] = (unsigned)(Rb * ldb + C) * 2u; }
    const size_t hA = (size_t)HALF * lda * 2, hB = (size_t)HALF * ldb * 2, kstep = BK * 2;
    const unsigned ldsw = (unsigned)wid * 1024u;
    const int aoff = lds_byte(wr * 64 + fr, fq * 8), boff = lds_byte(wc * 32 + fr, fq * 8);
    bf16x8 At[4][2], B0[2][2], B1[2][2];
    if (!pre) { STAGE(SB(0, 0), cB, voffB); STAGE(SA(0, 0), cA, voffA); STAGE(SB(0, 1), cB + hB, voffB); STAGE(SA(0, 1), cA + hA, voffA); }
    if (wr == 1) BAR;
    WAIT_V(4); BAR;
    STAGE(SB(1, 0), cB + kstep, voffB); STAGE(SA(1, 0), cA + kstep, voffA); STAGE(SB(1, 1), cB + hB + kstep, voffB);
    WAIT_V(6); BAR;
    for (int t = 0; t < nt - 2; t += 2) {
        const char* a1 = cA + (size_t)(t + 1) * kstep; const char* a2 = a1 + kstep; const char* a3 = a2 + kstep;
        const char* b2 = cB + (size_t)(t + 2) * kstep; const char* b3 = b2 + kstep;
        LDB(B0, 0, 0); SCHED; LDA(At, 0, 0); STAGE(SA(1, 1), a1 + hA, voffA);
        WAIT_L(8); BAR; WAIT_L(0); MMA(0, 0, At, B0); BAR; SCHED;
        LDB(B1, 0, 1); STAGE(SB(0, 0), b2, voffB);
        BAR; WAIT_L(0); MMA(0, 1, At, B1); BAR;
        LDA(At, 0, 1); STAGE(SA(0, 0), a2, voffA);
        BAR; WAIT_L(0); MMA(1, 0, At, B0); BAR; SCHED;
        STAGE(SB(0, 1), b2 + hB, voffB);
        WAIT_V(6); BAR; MMA(1, 1, At, B1); BAR;
        LDB(B0, 1, 0); SCHED; LDA(At, 1, 0); STAGE(SA(0, 1), a2 + hA, voffA);
        WAIT_L(8); BAR; WAIT_L(0); MMA(0, 0, At, B0); BAR; SCHED;
        LDB(B1, 1, 1); STAGE(SB(1, 0), b3, voffB);
        BAR; WAIT_L(0); MMA(0, 1, At, B1); BAR;
        LDA(At, 1, 1); STAGE(SA(1, 0), a3, voffA);
        BAR; WAIT_L(0); MMA(1, 0, At, B0); BAR; SCHED;
        STAGE(SB(1, 1), b3 + hB, voffB);
        WAIT_V(6); BAR; MMA(1, 1, At, B1); BAR;
    }
    { const char* a1 = cA + (size_t)(nt - 1) * kstep;
      LDB(B0, 0, 0); LDA(At, 0, 0); STAGE(SA(1, 1), a1 + hA, voffA);
      BAR; WAIT_L(0); MMA(0, 0, At, B0); BAR;
      LDB(B1, 0, 1); BAR; WAIT_L(0); MMA(0, 1, At, B1); BAR;
      LDA(At, 0, 1); WAIT_V(4); BAR; WAIT_L(0); MMA(1, 0, At, B0); MMA(1, 1, At, B1); BAR; }
    { LDB(B0, 1, 0); LDA(At, 1, 0); WAIT_V(2); BAR; WAIT_L(0); MMA(0, 0, At, B0); BAR;
      LDB(B1, 1, 1); WAIT_V(0); BAR; WAIT_L(0); MMA(0, 1, At, B1); BAR;
      LDA(At, 1, 1); BAR; WAIT_L(0); MMA(1, 0, At, B0); MMA(1, 1, At, B1); BAR; }
    if (wr == 0) BAR;
}

__device__ __forceinline__ void tile_map(int L, int nM, int nN, int& pm, int& pn) {
    const int nwg = nM * nN, q = nwg / 8, r = nwg % 8, xcd = L % 8, off = L / 8;
    const int wgid = (xcd < r ? xcd * (q + 1) : r * (q + 1) + (xcd - r) * q) + off;
    const int nig = 8 * nN, gid = wgid / nig, fm = gid * 8, gsz = (nM - fm) < 8 ? (nM - fm) : 8;
    pm = fm + ((wgid % nig) % gsz); pn = (wgid % nig) / gsz;
}

__device__ __forceinline__ void ld8(const bf16_t* p, float (&v)[8]) { const u32x4 w = *(const u32x4*)p;
    v[0] = bf_lo(w.x); v[1] = bf_hi(w.x); v[2] = bf_lo(w.y); v[3] = bf_hi(w.y); v[4] = bf_lo(w.z); v[5] = bf_hi(w.z); v[6] = bf_lo(w.w); v[7] = bf_hi(w.w); }
__device__ __forceinline__ void ld8f(const float* p, float (&v)[8]) { const f32x4 a = *(const f32x4*)p, b = *(const f32x4*)(p + 4);
    v[0] = a[0]; v[1] = a[1]; v[2] = a[2]; v[3] = a[3]; v[4] = b[0]; v[5] = b[1]; v[6] = b[2]; v[7] = b[3]; }
__device__ __forceinline__ void st8(bf16_t* p, const float (&v)[8]) { u32x4 w; w.x = pk_bf16(v[0], v[1]); w.y = pk_bf16(v[2], v[3]); w.z = pk_bf16(v[4], v[5]); w.w = pk_bf16(v[6], v[7]); *(u32x4*)p = w; }
__device__ __forceinline__ float sq8(const float (&v)[8]) { float s = 0.f;
#pragma unroll
    for (int i = 0; i < 8; ++i) s += v[i] * v[i]; return s; }


enum { E_SWIGLU = 0, E_DOWN, E_WIN, E_QRAW, E_KVRAW, E_S5E, E_S5Y, E_GLU, E_WOUT, E_PP, E_PLE };

#define WSP(T, off) ((T*)(P.ws + (off)))

__device__ __forceinline__ void store_bf4(bf16_t* p, f32x4 v) { u32x2 w; w.x = pk_bf16(v[0], v[1]); w.y = pk_bf16(v[2], v[3]); *(u32x2*)p = w; }

template <int MODE> __device__ __forceinline__ void epilogue(const f32x4 (&acc)[2][2][4][2], const Params& P, int brow, int bcol, int aux) {
    int tid_ = threadIdx.x; asm volatile("" : "+v"(tid_));
    const int wid = tid_ >> 6, lane = tid_ & 63, wr = wid >> 2, wc = wid & 3, fr = lane & 15, fq = lane >> 4;
    float* ss = WSP(float, OFF_SS);
#pragma unroll
    for (int ai = 0; ai < 2; ++ai)
#pragma unroll
        for (int m = 0; m < 4; ++m) {
            const int row = brow + ai * HALF + wr * 64 + m * 16 + fr;
            if constexpr (MODE == E_SWIGLU) {
                const float rs = rsqrtf(ss[(aux ? 2 : 0) * M_TOK + row] * (1.f / 1024.f) + EPS);
                bf16_t* act = WSP(bf16_t, OFF_ACT);
                float o[8];
#pragma unroll
                for (int n = 0; n < 2; ++n) {
                    const f32x4 g = acc[ai][0][m][n] * rs, u = acc[ai][1][m][n] * rs;
#pragma unroll
                    for (int j = 0; j < 4; ++j) o[n * 4 + j] = g[j] * sigmoidf_(g[j]) * u[j];
                }
                { u32x4 w_; w_.x = pk_bf16(o[0], o[1]); w_.y = pk_bf16(o[2], o[3]); w_.z = pk_bf16(o[4], o[5]); w_.w = pk_bf16(o[6], o[7]);
                  __builtin_nontemporal_store(w_, (u32x4*)(act + (long)row * DFF + (bcol >> 1) + wc * 32 + fq * 8)); }
            } else if constexpr (MODE == E_DOWN || MODE == E_WOUT) {
                bf16_t* hb = WSP(bf16_t, OFF_HB);
                float sc = 0.5f; int ssi = aux ? 3 : 1;
                if constexpr (MODE == E_WOUT) { sc = rsqrtf(ss[7 * M_TOK + row] * (1.f / 512.f) + EPS); ssi = 2; }
                float sq = 0.f;
                if constexpr (MODE == E_DOWN || MODE == E_WOUT) {
                    u32x4 rr8[2];
#pragma unroll
                    for (int bj = 0; bj < 2; ++bj) rr8[bj] = *(const u32x4*)(hb + (long)row * DM + bcol + bj * HALF + wc * 32 + fq * 8);
#pragma unroll
                    for (int bj = 0; bj < 2; ++bj) {
                        const f32x4 r0 = {bf_lo(rr8[bj].x), bf_hi(rr8[bj].x), bf_lo(rr8[bj].y), bf_hi(rr8[bj].y)}, r1 = {bf_lo(rr8[bj].z), bf_hi(rr8[bj].z), bf_lo(rr8[bj].w), bf_hi(rr8[bj].w)};
                        const f32x4 v0 = r0 + acc[ai][bj][m][0] * sc, v1 = r1 + acc[ai][bj][m][1] * sc;
                        u32x4 w; w.x = pk_bf16(v0[0], v0[1]); w.y = pk_bf16(v0[2], v0[3]); w.z = pk_bf16(v1[0], v1[1]); w.w = pk_bf16(v1[2], v1[3]);
                        *(u32x4*)(hb + (long)row * DM + bcol + bj * HALF + wc * 32 + fq * 8) = w;
                        sq += v0[0] * v0[0] + v0[1] * v0[1] + v0[2] * v0[2] + v0[3] * v0[3] + v1[0] * v1[0] + v1[1] * v1[1] + v1[2] * v1[2] + v1[3] * v1[3];
                    }
                } else {
                u32x2 rr[2][2];
#pragma unroll
                for (int bj = 0; bj < 2; ++bj)
#pragma unroll
                    for (int n = 0; n < 2; ++n) rr[bj][n] = *(const u32x2*)(hb + (long)row * DM + bcol + bj * HALF + wc * 32 + n * 16 + fq * 4);
#pragma unroll
                for (int bj = 0; bj < 2; ++bj)
#pragma unroll
                    for (int n = 0; n < 2; ++n) {
                        const int col = bcol + bj * HALF + wc * 32 + n * 16 + fq * 4;
                        const f32x4 r = {bf_lo(rr[bj][n].x), bf_hi(rr[bj][n].x), bf_lo(rr[bj][n].y), bf_hi(rr[bj][n].y)};
                        const f32x4 v = r + acc[ai][bj][m][n] * sc;
                        store_bf4(hb + (long)row * DM + col, v);
                        sq += v[0] * v[0] + v[1] * v[1] + v[2] * v[2] + v[3] * v[3];
                    }
                }
                sq += __shfl_xor(sq, 16); sq += __shfl_xor(sq, 32);
                if (fq == 0) unsafeAtomicAdd(ss + ATOM_OFF + ssi * M_TOK + row, sq);
            } else if constexpr (MODE == E_WIN) {
                const float rs = rsqrtf(ss[1 * M_TOK + row] * (1.f / 1024.f) + EPS);
#pragma unroll
                for (int bj = 0; bj < 2; ++bj) {
                    const int seg = (bcol >> 7) + bj;
                    const int col0 = bcol + bj * HALF + wc * 32 + fq * 8;
                    const f32x4 v0 = acc[ai][bj][m][0] * rs, v1 = acc[ai][bj][m][1] * rs;
                    u32x4 w; w.x = pk_bf16(v0[0], v0[1]); w.y = pk_bf16(v0[2], v0[3]); w.z = pk_bf16(v1[0], v1[1]); w.w = pk_bf16(v1[2], v1[3]);
                    float sq = v0[0] * v0[0] + v0[1] * v0[1] + v0[2] * v0[2] + v0[3] * v0[3] + v1[0] * v1[0] + v1[1] * v1[1] + v1[2] * v1[2] + v1[3] * v1[3];
                    if (seg < 4) {
                        const int g = col0 >> 4, hi = col0 & 15;
                        __builtin_nontemporal_store(w, (u32x4*)(WSP(bf16_t, OFF_A2) + ((long)g * 1024 + (row >> 5)) * 640 + (row & 31) * 16 + hi));
                    } else if (seg < 7) {
                        __builtin_nontemporal_store(w, (u32x4*)(WSP(bf16_t, OFF_CQB) + (long)row * 384 + (col0 - 512)));
                    } else if (seg < 9) {
                        __builtin_nontemporal_store(w, (u32x4*)(WSP(bf16_t, OFF_CKVB) + (long)row * 256 + (col0 - 896)));
                    } else if (wc == 0) {
                        float mine[8] = {v0[0], v0[1], v0[2], v0[3], v1[0], v1[1], v1[2], v1[3]}, oth[8];
#pragma unroll
                        for (int i = 0; i < 8; ++i) oth[i] = __shfl_xor(mine[i], 32);
                        float q2 = sq; q2 += __shfl_xor(q2, 16); q2 += __shfl_xor(q2, 32);
                        if (fq == 0) ss[8 * M_TOK + row] = q2;
                        const int ib = (fq & 1) * 8;
                        float cs[8], sn[8], g1[8], g2[8], o[8];
                        ld8f(WSP(float, OFF_TAB) + (long)row * 32 + ib, cs); ld8f(WSP(float, OFF_TAB) + (long)row * 32 + 16 + ib, sn);
                        ld8f(P.qkn_k + 64 + ib, g1); ld8f(P.qkn_k + 80 + ib, g2);
#pragma unroll
                        for (int i = 0; i < 8; ++i) { const float x1 = (fq < 2 ? mine[i] : oth[i]) * g1[i], x2 = (fq < 2 ? oth[i] : mine[i]) * g2[i];
                            o[i] = fq < 2 ? (x1 * cs[i] - x2 * sn[i]) : (x1 * sn[i] + x2 * cs[i]); }
                        st8(WSP(bf16_t, OFF_KPE) + (long)row * 32 + (fq < 2 ? 0 : 16) + ib, o);
                    }
                    if (seg >= 4 && seg < 9) {
                        sq += __shfl_xor(sq, 16); sq += __shfl_xor(sq, 32);
                        if (fq == 0) unsafeAtomicAdd(ss + ATOM_OFF + (seg < 7 ? 4 : 5) * M_TOK + row, sq);
                    }
                }
            } else if constexpr (MODE == E_QRAW || MODE == E_KVRAW) {
                const float rs = (MODE == E_QRAW) ? rsqrtf(ss[4 * M_TOK + row] * (1.f / 384.f) + EPS) : rsqrtf(ss[5 * M_TOK + row] * (1.f / 256.f) + EPS);
                bf16_t* o = (MODE == E_QRAW) ? WSP(bf16_t, OFF_QRAW) : WSP(bf16_t, OFF_KVRAW);
                const int ld = (MODE == E_QRAW) ? 768 : 1024;
#pragma unroll
                for (int bj = 0; bj < 2; ++bj) {
                    const f32x4 v0 = acc[ai][bj][m][0] * rs, v1 = acc[ai][bj][m][1] * rs;
                    u32x4 w; w.x = pk_bf16(v0[0], v0[1]); w.y = pk_bf16(v0[2], v0[3]); w.z = pk_bf16(v1[0], v1[1]); w.w = pk_bf16(v1[2], v1[3]);
                    *(u32x4*)(o + (long)row * ld + bcol + bj * HALF + wc * 32 + fq * 8) = w;
                }
            } else if constexpr (MODE == E_S5E) {
                float* E = WSP(float, OFF_E) + (long)aux * 1024 * 128 + (long)row * 128 + wc * 32 + fq * 8;
                *(f32x4*)E = acc[ai][0][m][0]; *(f32x4*)(E + 4) = acc[ai][0][m][1];
            } else if constexpr (MODE == E_S5Y) {
                bf16_t* yg = (bf16_t*)P.out + (long)M_TOK * 1024;
#pragma unroll
                for (int bj = 0; bj < 2; ++bj) {
                    const int col = bcol + bj * HALF + wc * 32 + fq * 8, t = col >> 4, ho = col & 15;
                    float o[8];
#pragma unroll
                    for (int j = 0; j < 4; ++j) { const float a = acc[ai][bj][m][0][j], b = acc[ai][bj][m][1][j];
                        o[j] = a * sigmoidf_(1.5957691216f * (a + 0.044715f * a * a * a)); o[4 + j] = b * sigmoidf_(1.5957691216f * (b + 0.044715f * b * b * b)); }
                    st8(yg + ((long)row * 32 + t) * 512 + aux * 16 + ho, o);
                }
            } else if constexpr (MODE == E_GLU) {
                const bf16_t* yg = (const bf16_t*)P.out + (long)M_TOK * 1024; bf16_t* ymix = (bf16_t*)P.out;
                float sq = 0.f;
#pragma unroll
                for (int bj = 0; bj < 2; ++bj) {
                    const int col = bcol + bj * HALF + wc * 32 + fq * 8;
                    float bb[8], yy[8], o[8];
                    ld8f(P.b_glu + col, bb); ld8(yg + (long)row * 512 + col, yy);
#pragma unroll
                    for (int j = 0; j < 4; ++j) { o[j] = yy[j] * sigmoidf_(acc[ai][bj][m][0][j] + bb[j]); o[4 + j] = yy[4 + j] * sigmoidf_(acc[ai][bj][m][1][j] + bb[4 + j]); }
                    st8(ymix + (long)row * 1024 + col, o);
                    sq += sq8(o);
                }
                sq += __shfl_xor(sq, 16); sq += __shfl_xor(sq, 32);
                if (fq == 0) unsafeAtomicAdd(ss + ATOM_OFF + 6 * M_TOK + row, sq);
            } else if constexpr (MODE == E_PP) {
                bf16_t* pp = WSP(bf16_t, OFF_PP);
#pragma unroll
                for (int bj = 0; bj < 2; ++bj) {
                    const f32x4 v0 = acc[ai][bj][m][0], v1 = acc[ai][bj][m][1];
                    u32x4 w; w.x = pk_bf16(v0[0], v0[1]); w.y = pk_bf16(v0[2], v0[3]); w.z = pk_bf16(v1[0], v1[1]); w.w = pk_bf16(v1[2], v1[3]);
                    *(u32x4*)(pp + (long)row * 1024 + bcol + bj * HALF + wc * 32 + fq * 8) = w;
                }
            } else if constexpr (MODE == E_PLE) {
                const float rs = rsqrtf(ss[3 * M_TOK + row] * (1.f / 1024.f) + EPS);
                const bf16_t* pp = WSP(bf16_t, OFF_PP); const bf16_t* hb = WSP(bf16_t, OFF_HB);
#pragma unroll
                for (int bj = 0; bj < 2; ++bj) {
                    const int col = bcol + bj * HALF + wc * 32 + fq * 8;
                    float h8[8], p8[8];
                    ld8(hb + (long)row * DM + col, h8); ld8(pp + (long)row * 1024 + col, p8);
                    f32x4 o0, o1;
#pragma unroll
                    for (int j = 0; j < 4; ++j) { o0[j] = h8[j] + sigmoidf_(acc[ai][bj][m][0][j] * rs) * p8[j]; o1[j] = h8[4 + j] + sigmoidf_(acc[ai][bj][m][1][j] * rs) * p8[4 + j]; }
                    *(f32x4*)(P.out + (long)row * DM + col) = o0; *(f32x4*)(P.out + (long)row * DM + col + 4) = o1;
                }
            }
        }
}

__device__ __forceinline__ void epilogue_kv(const f32x4 (&acc)[2][2][4][2], const Params& P, int brow, int bcol) {
    int tid_ = threadIdx.x; asm volatile("" : "+v"(tid_));
    const int wid = tid_ >> 6, lane = tid_ & 63, wr = wid >> 2, wc = wid & 3, fr = lane & 15, fq = lane >> 4;
    const float* ss = WSP(float, OFF_SS);
    float* exch = (float*)((char*)shm + 32768);
    if (wc < 2) {
#pragma unroll
        for (int ai = 0; ai < 2; ++ai)
#pragma unroll
            for (int m = 0; m < 4; ++m) {
                const int rl = ai * HALF + wr * 64 + m * 16 + fr;
                const float rs = rsqrtf(ss[5 * M_TOK + brow + rl] * (1.f / 256.f) + EPS);
#pragma unroll
                for (int bj = 0; bj < 2; ++bj) {
                    float sq = 0.f;
#pragma unroll
                    for (int n = 0; n < 2; ++n) { const f32x4 v = acc[ai][bj][m][n] * rs; sq += v[0] * v[0] + v[1] * v[1] + v[2] * v[2] + v[3] * v[3]; }
                    sq += __shfl_xor(sq, 16); sq += __shfl_xor(sq, 32);
                    if (fq == 0) exch[(rl * 2 + bj) * 2 + wc] = sq;
                }
            }
    }
    __syncthreads();
#pragma unroll
    for (int ai = 0; ai < 2; ++ai)
#pragma unroll
        for (int m = 0; m < 4; ++m) {
            const int rl = ai * HALF + wr * 64 + m * 16 + fr, row = brow + rl, b = row >> 12, l = row & 4095;
            const float rs = rsqrtf(ss[5 * M_TOK + row] * (1.f / 256.f) + EPS), pe = ss[8 * M_TOK + row];
#pragma unroll
            for (int bj = 0; bj < 2; ++bj) {
                const int h = (bcol >> 7) + bj;
                const float rk = rsqrtf((exch[(rl * 2 + bj) * 2] + exch[(rl * 2 + bj) * 2 + 1] + pe) * (1.f / 96.f) + EPS);
                bf16_t* kf = WSP(bf16_t, OFF_HBUF) + ((long)(b * 8 + h) * SEQ + l) * 96;
                if (wc < 2) {
                    const f32x4 v0 = acc[ai][bj][m][0] * (rs * rk), v1 = acc[ai][bj][m][1] * (rs * rk);
                    u32x4 w; w.x = pk_bf16(v0[0], v0[1]); w.y = pk_bf16(v0[2], v0[3]); w.z = pk_bf16(v1[0], v1[1]); w.w = pk_bf16(v1[2], v1[3]);
                    *(u32x4*)(kf + wc * 32 + fq * 8) = w;
                } else {
                    const f32x4 v0 = acc[ai][bj][m][0] * rs, v1 = acc[ai][bj][m][1] * rs;
                    u32x4 w; w.x = pk_bf16(v0[0], v0[1]); w.y = pk_bf16(v0[2], v0[3]); w.z = pk_bf16(v1[0], v1[1]); w.w = pk_bf16(v1[2], v1[3]);
                    *(u32x4*)(WSP(bf16_t, OFF_KVRAW) + (long)row * 1024 + bcol + bj * HALF + wc * 32 + fq * 8) = w;
                    if (wc == 2 + bj) {
                        float kv[8]; ld8(WSP(bf16_t, OFF_KPE) + (long)row * 32 + fq * 8, kv);
#pragma unroll
                        for (int i = 0; i < 8; ++i) kv[i] *= rk;
                        st8(kf + 64 + fq * 8, kv);
                    }
                }
            }
        }
}

namespace pg8 {
#define PG8_LAS __attribute__((address_space(3)))
typedef unsigned short bf16_t;
typedef short bf16x8 __attribute__((ext_vector_type(8)));
typedef float f32x4 __attribute__((ext_vector_type(4)));
typedef unsigned u32x4 __attribute__((ext_vector_type(4)));
constexpr int BM = 256, BK = 64, HALF = 128, HTB = HALF * BK * 2  , STAGE_BYTES = 8 * HTB, NXCD = 8, WGM = 8;

__host__ __device__ __forceinline__ int lds_byte(int r, int c) { const int st = (r >> 4) * 2 + (c >> 5), rr = r & 15, cc = c & 31, ob = rr * 64 + cc * 2; return st * 1024 + (ob ^ (((ob >> 9) & 1) << 5)); }
__host__ __device__ __forceinline__ void stage_rc(int b, int& R, int& C) { const int st = b / 1024, sb = b % 1024, swz = sb ^ (((sb >> 9) & 1) << 5); R = (st >> 1) * 16 + swz / 64; C = (st & 1) * 32 + (swz % 64) / 2; }
__host__ __device__ __forceinline__ int perm32(int rho) { const int n = rho >> 4, i = rho & 15; return 8 * (i >> 2) + 4 * n + (i & 3); }

struct Unit { int pm, pn; };
struct Gemm { const bf16_t* A; const bf16_t* Bt; int M, N, K; };

struct StaticOrder {
    int nM, nN, nwg, G, c;
    __host__ __device__ void init(int M, int N, int G_, int c_) { nM = M / BM; nN = N / BM; nwg = nM * nN; G = G_; c = c_; }
    __host__ __device__ bool next(int i, Unit& u) const {
        const long L = (long)i * G + c; if (L >= nwg) return false;
        int wgid = (int)L; { const int q = nwg / NXCD, r = nwg % NXCD, xcd = wgid % NXCD, off = wgid / NXCD; wgid = (xcd < r ? xcd * (q + 1) : r * (q + 1) + (xcd - r) * q) + off; }
        const int nig = WGM * nN, gid = wgid / nig, fm = gid * WGM, gsz = (nM - fm) < WGM ? (nM - fm) : WGM;
        u.pm = fm + ((wgid % nig) % gsz); u.pn = (wgid % nig) / gsz; return true;
    }
    __device__ __forceinline__ void a_ready(const Unit&) const {}
    __device__ __forceinline__ void done(const Unit&) const {}
};
template <class Epi, class Sched, bool ALIGN_EPI = false, bool SP2 = false>
__device__ __forceinline__ void gemm_phase(PG8_LAS unsigned char* lds, const Gemm g, const Sched& S, const Epi& E) {
    int tid = threadIdx.x; asm volatile("" : "+v"(tid));
    const int wid = __builtin_amdgcn_readfirstlane(tid >> 6), lane = tid & 63, wr = wid >> 2, wc = wid & 3, fr = lane & 15, fq = lane >> 4;
    const int K = g.K, nt = K / BK;
    unsigned voffA[2], voffB[2];
#pragma unroll
    for (int i = 0; i < 2; ++i) { int R, C; stage_rc(tid * 16 + i * 8192, R, C); const int Rb = Epi::PERM ? ((R & ~31) + perm32(R & 31)) : R;
        voffA[i] = (unsigned)(R * K + C) * 2u; voffB[i] = (unsigned)(Rb * K + C) * 2u; }
    const size_t kstep = (size_t)(BK * 2);
    const size_t hstep = (size_t)HALF * K * 2;
    const size_t tstep = 2 * hstep;
    const unsigned ldsw = (unsigned)wid * 1024u;
    const int aoff = lds_byte(wr * 64 + fr, fq * 8), boff = lds_byte(wc * 32 + fr, fq * 8);
#define PG8_SA(b, h) (((b) * 2 + (h)) * HTB)
#define PG8_SB(b, h) ((4 + (b) * 2 + (h)) * HTB)
#define PG8_STAGE(bufoff, gbase, voff) do { _Pragma("unroll") for (int _i = 0; _i < 2; ++_i) \
        __builtin_amdgcn_global_load_lds((const unsigned*)((const char*)(gbase) + (voff)[_i]), (PG8_LAS unsigned*)(lds + (bufoff) + ldsw + _i * 8192), 16, 0, 0); } while (0)
#define PG8_LDA(dst, b, h) do { _Pragma("unroll") for (int m = 0; m < 4; ++m) _Pragma("unroll") for (int k = 0; k < 2; ++k) dst[m][k] = *(const PG8_LAS bf16x8*)(lds + PG8_SA(b, h) + aoff + m * 2048 + k * 1024); } while (0)
#define PG8_LDB(dst, b, h) do { _Pragma("unroll") for (int n = 0; n < 2; ++n) _Pragma("unroll") for (int k = 0; k < 2; ++k) dst[n][k] = *(const PG8_LAS bf16x8*)(lds + PG8_SB(b, h) + boff + n * 2048 + k * 1024); } while (0)
#define PG8_MMA(ai, bj, At, Bt) do { __builtin_amdgcn_s_setprio(1); _Pragma("unroll") for (int m = 0; m < 4; ++m) _Pragma("unroll") for (int n = 0; n < 2; ++n) _Pragma("unroll") for (int k = 0; k < 2; ++k) \
        acc[ai][bj][m][n] = __builtin_amdgcn_mfma_f32_16x16x32_bf16(Bt[n][k], At[m][k], acc[ai][bj][m][n], 0, 0, 0); __builtin_amdgcn_s_setprio(0); } while (0)
#define PG8_WAIT_V(n) asm volatile("s_waitcnt vmcnt(" #n ")" ::: "memory")
#define PG8_WAIT_L(n) asm volatile("s_waitcnt lgkmcnt(" #n ")" ::: "memory")
#define PG8_BAR __builtin_amdgcn_s_barrier()
#define PG8_SCHED __builtin_amdgcn_sched_barrier(0)
    Unit cur, nxt; int ui = 0;
    if (!S.next(0, cur)) return;
    f32x4 acc[2][2][4][2];
#pragma unroll
    for (int a = 0; a < 2; ++a)
#pragma unroll
        for (int b = 0; b < 2; ++b)
#pragma unroll
            for (int m = 0; m < 4; ++m)
#pragma unroll
                for (int n = 0; n < 2; ++n) acc[a][b][m][n] = (f32x4){0.f, 0.f, 0.f, 0.f};
    bf16x8 At[4][2], B0[2][2], B1[2][2];
    const char* cA = (const char*)g.A + (size_t)cur.pm * tstep; const char* cB = (const char*)g.Bt + (size_t)cur.pn * tstep;
    S.a_ready(cur);
    if constexpr (SP2) {
        PG8_STAGE(PG8_SB(0, 0), cB, voffB); PG8_STAGE(PG8_SB(0, 1), cB + hstep, voffB); PG8_STAGE(PG8_SA(0, 0), cA, voffA); PG8_STAGE(PG8_SA(0, 1), cA + hstep, voffA);
        if (wr == 1) PG8_BAR;
        PG8_WAIT_V(2); PG8_BAR;
        PG8_STAGE(PG8_SB(1, 0), cB + kstep, voffB); PG8_STAGE(PG8_SA(1, 0), cA + kstep, voffA); PG8_STAGE(PG8_SB(1, 1), cB + hstep + kstep, voffB);
        PG8_WAIT_V(6); PG8_BAR;
    } else {
        PG8_STAGE(PG8_SB(0, 0), cB, voffB); PG8_STAGE(PG8_SA(0, 0), cA, voffA); PG8_STAGE(PG8_SB(0, 1), cB + hstep, voffB); PG8_STAGE(PG8_SA(0, 1), cA + hstep, voffA);
        if (wr == 1) PG8_BAR;
        PG8_WAIT_V(4); PG8_BAR;
        PG8_STAGE(PG8_SB(1, 0), cB + kstep, voffB); PG8_STAGE(PG8_SA(1, 0), cA + kstep, voffA); PG8_STAGE(PG8_SB(1, 1), cB + hstep + kstep, voffB);
        PG8_WAIT_V(6); PG8_BAR;
    }
    for (;;) {
        const bool has_next = S.next(ui + 1, nxt);
        const char* nA = has_next ? (const char*)g.A + (size_t)nxt.pm * tstep : cA; const char* nB = has_next ? (const char*)g.Bt + (size_t)nxt.pn * tstep : cB;
        for (int t = 0; t < nt; t += 2) {
            const bool last = (t == nt - 2);
            const char* a1 = cA + (size_t)(t + 1) * kstep;
            const char* a2 = last ? nA : cA + (size_t)(t + 2) * kstep; const char* b2 = last ? nB : cB + (size_t)(t + 2) * kstep;
            const char* a3 = a2 + kstep; const char* b3 = b2 + kstep;
            if (last && has_next) S.a_ready(nxt);
            if constexpr (SP2) {
            PG8_LDB(B0, 0, 0); PG8_LDB(B1, 0, 1); PG8_SCHED; PG8_LDA(At, 0, 0); PG8_STAGE(PG8_SA(1, 1), a1 + hstep, voffA);
            PG8_WAIT_V(8); PG8_WAIT_L(0); PG8_BAR; PG8_MMA(0, 0, At, B0); PG8_MMA(0, 1, At, B1); PG8_BAR; PG8_SCHED;
            PG8_LDA(At, 0, 1); PG8_STAGE(PG8_SB(0, 0), b2, voffB); PG8_STAGE(PG8_SB(0, 1), b2 + hstep, voffB); PG8_STAGE(PG8_SA(0, 0), a2, voffA);
            PG8_WAIT_V(8); PG8_WAIT_L(0); PG8_BAR; PG8_MMA(1, 0, At, B0); PG8_MMA(1, 1, At, B1); PG8_BAR; PG8_SCHED;
            PG8_LDB(B0, 1, 0); PG8_LDB(B1, 1, 1); PG8_SCHED; PG8_LDA(At, 1, 0); PG8_STAGE(PG8_SA(0, 1), a2 + hstep, voffA);
            PG8_WAIT_V(8); PG8_WAIT_L(0); PG8_BAR; PG8_MMA(0, 0, At, B0); PG8_MMA(0, 1, At, B1); PG8_BAR; PG8_SCHED;
            PG8_LDA(At, 1, 1); PG8_STAGE(PG8_SB(1, 0), b3, voffB); PG8_STAGE(PG8_SB(1, 1), b3 + hstep, voffB); PG8_STAGE(PG8_SA(1, 0), a3, voffA);
            PG8_WAIT_V(8); PG8_WAIT_L(0); PG8_BAR; PG8_MMA(1, 0, At, B0); PG8_MMA(1, 1, At, B1); PG8_BAR; PG8_SCHED;
            } else {
            PG8_LDB(B0, 0, 0); PG8_SCHED; PG8_LDA(At, 0, 0); PG8_STAGE(PG8_SA(1, 1), a1 + hstep, voffA);
            PG8_WAIT_L(8); PG8_BAR; PG8_WAIT_L(0); PG8_MMA(0, 0, At, B0); PG8_BAR; PG8_SCHED;
            PG8_LDB(B1, 0, 1); PG8_STAGE(PG8_SB(0, 0), b2, voffB);
            PG8_BAR; PG8_WAIT_L(0); PG8_MMA(0, 1, At, B1); PG8_BAR;
            PG8_LDA(At, 0, 1); PG8_STAGE(PG8_SA(0, 0), a2, voffA);
            PG8_BAR; PG8_WAIT_L(0); PG8_MMA(1, 0, At, B0); PG8_BAR; PG8_SCHED;
            PG8_STAGE(PG8_SB(0, 1), b2 + hstep, voffB);
            PG8_WAIT_V(6); PG8_BAR; PG8_MMA(1, 1, At, B1); PG8_BAR;
            PG8_LDB(B0, 1, 0); PG8_SCHED; PG8_LDA(At, 1, 0); PG8_STAGE(PG8_SA(0, 1), a2 + hstep, voffA);
            PG8_WAIT_L(8); PG8_BAR; PG8_WAIT_L(0); PG8_MMA(0, 0, At, B0); PG8_BAR; PG8_SCHED;
            PG8_LDB(B1, 1, 1); PG8_STAGE(PG8_SB(1, 0), b3, voffB);
            PG8_BAR; PG8_WAIT_L(0); PG8_MMA(0, 1, At, B1); PG8_BAR;
            PG8_LDA(At, 1, 1); PG8_STAGE(PG8_SA(1, 0), a3, voffA);
            PG8_BAR; PG8_WAIT_L(0); PG8_MMA(1, 0, At, B0); PG8_BAR; PG8_SCHED;
            PG8_STAGE(PG8_SB(1, 1), b3 + hstep, voffB);
            PG8_WAIT_V(6); PG8_BAR; PG8_MMA(1, 1, At, B1); PG8_BAR;
            }
        }
        if constexpr (ALIGN_EPI) { if (wr == 0) PG8_BAR; }
        if constexpr (!Epi::AFTER_DRAIN) { E(acc, cur, wr, wc, fr, fq); S.done(cur); }
        if (!has_next) break;
#pragma unroll
        for (int a = 0; a < 2; ++a)
#pragma unroll
            for (int b = 0; b < 2; ++b)
#pragma unroll
                for (int m = 0; m < 4; ++m)
#pragma unroll
                    for (int n = 0; n < 2; ++n) acc[a][b][m][n] = (f32x4){0.f, 0.f, 0.f, 0.f};
        cur = nxt; cA = nA; cB = nB; ++ui;
        if constexpr (ALIGN_EPI) { if (wr == 1) PG8_BAR; }
    }
    PG8_WAIT_V(0);
    if constexpr (!ALIGN_EPI) { if (wr == 0) PG8_BAR; }
    PG8_BAR;
    if constexpr (Epi::AFTER_DRAIN) { E.fused(acc, cur, wr, wc, fr, fq, lds, wid, lane); S.done(cur); }
#undef PG8_SA
#undef PG8_SB
#undef PG8_STAGE
#undef PG8_LDA
#undef PG8_LDB
#undef PG8_MMA
#undef PG8_WAIT_V
#undef PG8_WAIT_L
#undef PG8_BAR
#undef PG8_SCHED
}
}

template <int MODE> struct EpiAd {
    static constexpr bool PERM = true, AFTER_DRAIN = false;
    const Params& P; int aux;
    __device__ __forceinline__ void operator()(const f32x4 (&acc)[2][2][4][2], const pg8::Unit& u, int, int, int, int) const { epilogue<MODE>(acc, P, u.pm * 256, u.pn * 256, aux); }
};
template <int MODE> __device__ __forceinline__ void stream_gemm(const Params& P, const bf16_t* A, const bf16_t* Bt, int N, int K, int aux) {
    pg8::Gemm g; g.A = A; g.Bt = Bt; g.M = M_TOK; g.N = N; g.K = K;
    pg8::StaticOrder S; S.init(M_TOK, N, (int)gridDim.x, (int)blockIdx.x);
    const EpiAd<MODE> E{P, aux};
    pg8::gemm_phase<EpiAd<MODE>, pg8::StaticOrder, true, true>((PG8_LAS unsigned char*)shm, g, S, E);
}

struct WtDesc { const float* W; const float* g1; const float* g2; bf16_t* out; int N, ksplit, ldo, mode, k0, n0; };
__device__ __forceinline__ WtDesc wt_desc(const Params& P, int task) {
    WtDesc d; int tile;
    if (task < 2112) { const int wsel = task / 352; tile = task % 352; const int f2 = wsel >= 3, k = wsel % 3;
        const float* nf = f2 ? P.norm_ffn2 : P.norm_ffn1;
        if (k == 2) { d.W = f2 ? P.w2d : P.w1d; d.N = 1024; d.g1 = nullptr; d.g2 = nullptr; d.ksplit = 0; d.out = WSP(bf16_t, f2 ? OFF_WD2 : OFF_WD1); d.ldo = 2816; d.mode = 0; }
        else { d.W = k == 0 ? (f2 ? P.w2g : P.w1g) : (f2 ? P.w2u : P.w1u); d.N = 2816; d.g1 = nf; d.g2 = nf; d.ksplit = 1024; d.out = WSP(bf16_t, f2 ? OFF_W2 : OFF_W1); d.ldo = 1024; d.mode = k == 0 ? 1 : 2; }
    } else if (task < 2272) { tile = task - 2112; d.W = P.w_in; d.N = 1184; d.g1 = P.norm_mix; d.g2 = P.norm_mix; d.ksplit = 1024; d.out = WSP(bf16_t, OFF_WIN); d.ldo = 1024; d.mode = 0; }
    else if (task < 2308) { tile = task - 2272; d.W = P.w_uq; d.N = 768; d.g1 = P.q_norm; d.g2 = P.q_norm; d.ksplit = 384; d.out = WSP(bf16_t, OFF_WUQ); d.ldo = 384; d.mode = 0; }
    else if (task < 2340) { tile = task - 2308; d.W = P.w_ukv; d.N = 1024; d.g1 = P.kv_norm; d.g2 = P.kv_norm; d.ksplit = 256; d.out = WSP(bf16_t, OFF_WUKV); d.ldo = 256; d.mode = 0; }
    else if (task < 2372) { tile = task - 2340; d.W = P.w_glu; d.N = 512; d.g1 = nullptr; d.g2 = nullptr; d.ksplit = 0; d.out = WSP(bf16_t, OFF_WGLU); d.ldo = 512; d.mode = 0; }
    else if (task < 2500) { tile = task - 2372; d.W = P.w_out; d.N = 1024; d.g1 = P.on_ssm; d.g2 = P.on_att; d.ksplit = 512; d.out = WSP(bf16_t, OFF_WOUT); d.ldo = 1024; d.mode = 0; }
    else if (task < 2628) { tile = task - 2500; d.W = P.w_pg; d.N = 1024; d.g1 = P.norm_ple; d.g2 = P.norm_ple; d.ksplit = 1024; d.out = WSP(bf16_t, OFF_WPG); d.ldo = 1024; d.mode = 0; }
    else { tile = task - 2628; d.W = P.w_pp; d.N = 1024; d.g1 = nullptr; d.g2 = nullptr; d.ksplit = 0; d.out = WSP(bf16_t, OFF_WPP); d.ldo = 256; d.mode = 0; }
    const int ntn = (d.N + 127) >> 7, tk = tile / ntn, tn = tile - tk * ntn; d.k0 = tk * 64; d.n0 = tn * 128;
    return d;
}
constexpr int NWT = 2660;
__device__ __forceinline__ void wt_load(const WtDesc& d, f32x4 (&r)[4]) {
    int t = threadIdx.x; asm volatile("" : "+v"(t));
    const int n = d.n0 + (t & 31) * 4;
#pragma unroll
    for (int i = 0; i < 4; ++i) {
        const int kk = d.k0 + (t >> 5) + 16 * i;
        f32x4 v = {0.f, 0.f, 0.f, 0.f};
        if (n < d.N) { v = __builtin_nontemporal_load((const f32x4*)(d.W + (long)kk * d.N + n)); if (d.g1) v *= (kk < d.ksplit ? d.g1[kk] : d.g2[kk - d.ksplit]); }
        r[i] = v;
    }
}
__device__ __forceinline__ void wt_store(const WtDesc& d, const f32x4 (&r)[4]) {
    float* tl = (float*)shm;
    int t = threadIdx.x; asm volatile("" : "+v"(t));
#pragma unroll
    for (int i = 0; i < 4; ++i) { float* q = tl + ((t >> 5) + 16 * i) * 129 + (t & 31) * 4; q[0] = r[i][0]; q[1] = r[i][1]; q[2] = r[i][2]; q[3] = r[i][3]; }
    __syncthreads();
#pragma unroll
    for (int i = 0; i < 2; ++i) {
        const int n = (t >> 3) + 64 * i, kc = (t & 7) * 8, nn = d.n0 + n;
        if (nn < d.N) {
            const int orow = d.mode == 0 ? nn : ((nn >> 7) * 256 + (d.mode == 2 ? 128 : 0) + (nn & 127));
            u32x4 w;
            w.x = pk_bf16(tl[(kc + 0) * 129 + n], tl[(kc + 1) * 129 + n]); w.y = pk_bf16(tl[(kc + 2) * 129 + n], tl[(kc + 3) * 129 + n]);
            w.z = pk_bf16(tl[(kc + 4) * 129 + n], tl[(kc + 5) * 129 + n]); w.w = pk_bf16(tl[(kc + 6) * 129 + n], tl[(kc + 7) * 129 + n]);
            *(u32x4*)(d.out + (long)orow * d.ldo + d.k0 + kc) = w;
        }
    }
    __syncthreads();
}

struct S5Mode { float lr, li, dt, cr, ci; };
__device__ __forceinline__ S5Mode s5_mode(const Params& P, int g, int p) {
    S5Mode m; m.lr = P.lam_re[g * 64 + p]; m.li = P.lam_im[g * 64 + p]; m.dt = __expf(P.log_dt[g]);
    float c, s; cisf(m.li * m.dt, c, s); const float e = __expf(m.lr * m.dt);
    const float nr = e * c - 1.f, ni = e * s, den = 1.f / (m.lr * m.lr + m.li * m.li);
    m.cr = (nr * m.lr + ni * m.li) * den; m.ci = (ni * m.lr - nr * m.li) * den;
    return m;
}
__device__ __forceinline__ void s5_pow(const S5Mode& m, float tau, float& zr, float& zi) {
    float c, s; cisf(m.li * m.dt * tau, c, s); const float e = __expf(m.lr * m.dt * tau); zr = e * c; zi = e * s;
}

__constant__ float c_inv_freq[16] = {1.0f, 0.5623413251903491f, 0.31622776601683794f, 0.1778279410038923f, 0.1f, 0.05623413251903491f, 0.03162277660168379f, 0.01778279410038923f,
    0.01f, 0.005623413251903491f, 0.0031622776601683794f, 0.0017782794100389228f, 0.001f, 0.0005623413251903491f, 0.00031622776601683794f, 0.00017782794100389227f};

typedef short s16x4 __attribute__((ext_vector_type(4)));
__device__ __forceinline__ u32x4 scale8(u32x4 w, float s) { u32x4 o;
    o.x = pk_bf16(bf_lo(w.x) * s, bf_hi(w.x) * s); o.y = pk_bf16(bf_lo(w.y) * s, bf_hi(w.y) * s); o.z = pk_bf16(bf_lo(w.z) * s, bf_hi(w.z) * s); o.w = pk_bf16(bf_lo(w.w) * s, bf_hi(w.w) * s); return o; }
__device__ __forceinline__ void attn_item(const Params& P, int bh, int qb) {
    int tid = threadIdx.x; asm volatile("" : "+v"(tid));
    const int w = tid >> 6, lane = tid & 63, l32 = lane & 31, hi = lane >> 5;
    const int b = bh >> 3, h = bh & 7;
    const bf16_t* kvraw = WSP(bf16_t, OFF_KVRAW) + (long)b * SEQ * 1024 + h * 128;
    const bf16_t* kfp = WSP(bf16_t, OFF_HBUF) + (long)bh * SEQ * 96;
    LAS unsigned char* lds = (LAS unsigned char*)shm;
    const int wq = __builtin_amdgcn_readfirstlane(w);
    const int q0 = qb * 256, qrow = q0 + w * 32 + l32, wmin = q0 + wq * 32;
    bf16x8 qf[6];
    {
        const long tokq = (long)b * SEQ + qrow;
        const bf16_t* qr = WSP(bf16_t, OFF_QRAW) + tokq * 768 + h * 96 + hi * 8;
        float qv[6][8]; float sq = 0.f;
#pragma unroll
        for (int ks = 0; ks < 6; ++ks) { ld8(qr + ks * 16, qv[ks]); sq += sq8(qv[ks]); }
        sq += __shfl_xor(sq, 32);
        const float rs = rsqrtf(sq * (1.f / 96.f) + EPS), qs = 0.10206207261596575f * 1.4426950408889634f;
        float cs[8], sn[8];
        ld8f(WSP(float, OFF_TAB) + tokq * 32 + hi * 8, cs); ld8f(WSP(float, OFF_TAB) + tokq * 32 + 16 + hi * 8, sn);
#pragma unroll
        for (int ks = 0; ks < 4; ++ks) { float g[8], gk[8]; ld8f(P.qkn_q + ks * 16 + hi * 8, g); ld8f(P.qkn_k + ks * 16 + hi * 8, gk);
#pragma unroll
            for (int i = 0; i < 8; ++i) qv[ks][i] *= rs * g[i] * gk[i] * qs; }
        { float g1[8], g2[8]; ld8f(P.qkn_q + 64 + hi * 8, g1); ld8f(P.qkn_q + 80 + hi * 8, g2);
#pragma unroll
            for (int i = 0; i < 8; ++i) { const float x1 = qv[4][i] * rs * g1[i] * qs, x2 = qv[5][i] * rs * g2[i] * qs; qv[4][i] = x1 * cs[i] - x2 * sn[i]; qv[5][i] = x1 * sn[i] + x2 * cs[i]; } }
#pragma unroll
        for (int ks = 0; ks < 6; ++ks) { union { bf16x8 v; unsigned u[4]; } t;
#pragma unroll
            for (int i = 0; i < 4; ++i) t.u[i] = pk_bf16(qv[ks][2 * i], qv[ks][2 * i + 1]);
            qf[ks] = t.v; }
    }
    f32x16 o0, o1;
#pragma unroll
    for (int r = 0; r < 16; ++r) { o0[r] = 0.f; o1[r] = 0.f; }
    f32x16 lacc;
#pragma unroll
    for (int r = 0; r < 16; ++r) lacc[r] = 0.f;
    bf16x8 ones8;
#pragma unroll
    for (int i = 0; i < 8; ++i) ones8[i] = (short)0x3F80;
    const int nkt = 4 * (qb + 1);
    constexpr int KSLOT = 12288, VSLOT = 8192, VRING = 3 * KSLOT;
    int kga0, kga1, vga;
    { const int p0 = 64 * wq + lane, k0_ = p0 / 12, c0_ = p0 - 12 * k0_; const int cc0 = (c0_ - ((k0_ >> 2) & 3) + 12) % 12; kga0 = k0_ * 96 + cc0 * 8;
      const int p1 = 64 * ((wq & 3) + 8) + lane, k1_ = p1 / 12, c1_ = p1 - 12 * k1_; const int cc1 = (c1_ - ((k1_ >> 2) & 3) + 12) % 12; kga1 = k1_ * 96 + cc1 * 8;
      const int vkey = 8 * wq + (lane >> 3), vc = (lane & 7) ^ (((vkey >> 1) & 1) << 1); vga = vkey * 1024 + 64 + vc * 8; }
#define ATT_DMA_K(kt_, slot_) do { const bf16_t* g_ = kfp + (long)(kt_) * 64 * 96; \
        __builtin_amdgcn_global_load_lds((const unsigned*)(g_ + kga0), (LAS unsigned*)(lds + (slot_) * KSLOT + wq * 1024), 16, 0, 0); \
        if (wq < 4) __builtin_amdgcn_global_load_lds((const unsigned*)(g_ + kga1), (LAS unsigned*)(lds + (slot_) * KSLOT + (wq + 8) * 1024), 16, 0, 0); } while (0)
#define ATT_DMA_V(kt_, slot_) do { const bf16_t* g_ = kvraw + (long)(kt_) * 64 * 1024; \
        __builtin_amdgcn_global_load_lds((const unsigned*)(g_ + vga), (LAS unsigned*)(lds + VRING + (slot_) * VSLOT + wq * 1024), 16, 0, 0); } while (0)
    int koff[6];
#pragma unroll
    for (int ks = 0; ks < 6; ++ks) koff[ks] = (l32 * 12 + ((2 * ks + hi + ((l32 >> 2) & 3)) % 12)) * 16;
    const int g16 = lane >> 4, dhalf = g16 & 1, tr_r = (lane & 15) >> 2, tr_c = lane & 3;
    const int vtr_off = (4 * hi + tr_r) * 128 + (((dhalf ^ ((tr_r >> 1) & 1)) * 2 + (tr_c >> 1)) * 16) + (tr_c & 1) * 8;
    const unsigned lds_base = (unsigned)(unsigned long long)lds;
#define TR_RD(dst, addr, off) asm volatile("ds_read_b64_tr_b16 %0, %1 offset:" #off : "=v"(dst) : "v"(addr))
#define QK_TILE(S0, S1, kslot_) do { bf16x8 kf[12]; const LAS unsigned char* kb_ = lds + (kslot_) * KSLOT; \
        _Pragma("unroll") for (int ks = 0; ks < 6; ++ks) { kf[2 * ks] = *(const LAS bf16x8*)(kb_ + koff[ks]); kf[2 * ks + 1] = *(const LAS bf16x8*)(kb_ + koff[ks] + 6144); } \
        __builtin_amdgcn_sched_barrier(0); \
        _Pragma("unroll") for (int r = 0; r < 16; ++r) { S0[r] = 0.f; S1[r] = 0.f; } \
        __builtin_amdgcn_s_setprio(1); \
        _Pragma("unroll") for (int ks = 0; ks < 6; ++ks) { \
            S0 = __builtin_amdgcn_mfma_f32_32x32x16_bf16(kf[2 * ks], qf[ks], S0, 0, 0, 0); \
            S1 = __builtin_amdgcn_mfma_f32_32x32x16_bf16(kf[2 * ks + 1], qf[ks], S1, 0, 0, 0); } \
        __builtin_amdgcn_s_setprio(0); \
        __builtin_amdgcn_sched_barrier(0); } while (0)
#define ATT_BODY(KT, GEN) do { const int kt = (KT); \
        { const int ktn = kt + 2 < nkt ? kt + 2 : nkt - 1; ATT_DMA_K(ktn, s2_); ATT_DMA_V(ktn, s2_); } \
        if (!(GEN) || kt * 64 <= wmin + 31) { \
            f32x16 S0, S1; \
            QK_TILE(S0, S1, s0_); \
            const unsigned vb = lds_base + VRING + s0_ * VSLOT + vtr_off; \
            s16x4 vf[16]; \
            TR_RD(vf[0], vb, 0); TR_RD(vf[1], vb, 1024); TR_RD(vf[2], vb, 64); TR_RD(vf[3], vb, 1088); \
            TR_RD(vf[4], vb, 2048); TR_RD(vf[5], vb, 3072); TR_RD(vf[6], vb, 2112); TR_RD(vf[7], vb, 3136); \
            TR_RD(vf[8], vb, 4096); TR_RD(vf[9], vb, 5120); TR_RD(vf[10], vb, 4160); TR_RD(vf[11], vb, 5184); \
            TR_RD(vf[12], vb, 6144); TR_RD(vf[13], vb, 7168); TR_RD(vf[14], vb, 6208); TR_RD(vf[15], vb, 7232); \
            __builtin_amdgcn_sched_barrier(0); \
            if ((GEN) && kt * 64 + 63 > wmin) { \
                _Pragma("unroll") for (int r = 0; r < 16; ++r) { \
                    const int key = kt * 64 + 8 * (r >> 2) + 4 * hi + (r & 3); \
                    if (key > qrow) S0[r] = -1e30f; \
                    if (key + 32 > qrow) S1[r] = -1e30f; } } \
              \
              \
            _Pragma("unroll") for (int r = 0; r < 16; ++r) { S0[r] = __builtin_amdgcn_exp2f(S0[r]); S1[r] = __builtin_amdgcn_exp2f(S1[r]); } \
            asm volatile("s_waitcnt lgkmcnt(0)" : "+v"(vf[0]), "+v"(vf[1]), "+v"(vf[2]), "+v"(vf[3]), "+v"(vf[4]), "+v"(vf[5]), "+v"(vf[6]), "+v"(vf[7]), \
                         "+v"(vf[8]), "+v"(vf[9]), "+v"(vf[10]), "+v"(vf[11]), "+v"(vf[12]), "+v"(vf[13]), "+v"(vf[14]), "+v"(vf[15]) :: "memory"); \
            _Pragma("unroll") for (int q = 0; q < 4; ++q) { \
                union { bf16x8 v; unsigned u[4]; } pf; \
                _Pragma("unroll") for (int i = 0; i < 4; ++i) pf.u[i] = (q >> 1) == 0 ? pk_bf16(S0[8 * (q & 1) + 2 * i], S0[8 * (q & 1) + 2 * i + 1]) : pk_bf16(S1[8 * (q & 1) + 2 * i], S1[8 * (q & 1) + 2 * i + 1]); \
                union { bf16x8 v; s16x4 h[2]; } va, vb2; \
                va.h[0] = vf[4 * q + 0]; va.h[1] = vf[4 * q + 1]; vb2.h[0] = vf[4 * q + 2]; vb2.h[1] = vf[4 * q + 3]; \
                o0 = __builtin_amdgcn_mfma_f32_32x32x16_bf16(va.v, pf.v, o0, 0, 0, 0); \
                o1 = __builtin_amdgcn_mfma_f32_32x32x16_bf16(vb2.v, pf.v, o1, 0, 0, 0); \
                lacc = __builtin_amdgcn_mfma_f32_32x32x16_bf16(ones8, pf.v, lacc, 0, 0, 0); } \
        } \
          \
        if (wq < 4) asm volatile("s_waitcnt vmcnt(3)" ::: "memory"); else asm volatile("s_waitcnt vmcnt(2)" ::: "memory"); \
        __builtin_amdgcn_s_barrier(); \
        { const int t_ = s0_; s0_ = s1_; s1_ = s2_; s2_ = t_; } } while (0)
    __syncthreads();
    ATT_DMA_K(0, 0); ATT_DMA_K(1, 1); ATT_DMA_V(0, 0); ATT_DMA_V(1, 1);
    asm volatile("s_waitcnt vmcnt(0)" ::: "memory");
    __builtin_amdgcn_s_barrier();
    int s0_ = 0, s1_ = 1, s2_ = 2;
    int kfull = (wmin + 1) >> 6; kfull = kfull < nkt ? kfull : nkt;
    int kti = 0;
    for (; kti < kfull; ++kti) ATT_BODY(kti, 0);
    for (; kti < nkt; ++kti) ATT_BODY(kti, 1);
    asm volatile("s_waitcnt vmcnt(0)" ::: "memory");
    __builtin_amdgcn_s_barrier();
#undef QK_TILE
#undef TR_RD
#undef ATT_BODY
#undef ATT_DMA_K
#undef ATT_DMA_V
    const float inv = 1.f / lacc[0];
    const long tok = (long)b * SEQ + qrow;
    bf16_t* ymix = ((bf16_t*)P.out) + tok * 1024 + 512 + h * 64;
    float sq = 0.f;
#pragma unroll
    for (int g4 = 0; g4 < 4; ++g4) {
        f32x4 a, c;
#pragma unroll
        for (int j = 0; j < 4; ++j) { a[j] = o0[g4 * 4 + j] * inv; c[j] = o1[g4 * 4 + j] * inv; sq += a[j] * a[j] + c[j] * c[j]; }
        store_bf4(ymix + 8 * g4 + 4 * hi, a);
        store_bf4(ymix + 32 + 8 * g4 + 4 * hi, c);
    }
    sq += __shfl_xor(sq, 32);
    if (hi == 0) unsafeAtomicAdd(WSP(float, OFF_SS) + ATOM_OFF + 7 * M_TOK + tok, sq);
}

__device__ __forceinline__ void s5_scan_task(const Params& P, int g, int b, float* T) {
    int tid = threadIdx.x; asm volatile("" : "+v"(tid));
    const int p = tid & 63, part = tid >> 6;
    const S5Mode md = s5_mode(P, g, p); float ar, ai, a16r, a16i; s5_pow(md, 32.f, ar, ai); s5_pow(md, 512.f, a16r, a16i);
    const float* E = WSP(float, OFF_E) + ((long)g * 1024 + b * 128 + part * 16) * 128;
    bf16_t* A2 = WSP(bf16_t, OFF_A2) + ((long)g * 1024 + b * 128 + part * 16) * 640 + 512;
    float er[16], ei[16], lr[16], li[16];
#pragma unroll
    for (int j = 0; j < 16; ++j) { er[j] = E[(long)j * 128 + p]; ei[j] = E[(long)j * 128 + 64 + p]; }
    float sr = 0.f, si = 0.f;
#pragma unroll
    for (int j = 0; j < 16; ++j) { lr[j] = sr; li[j] = si; const float nr = ar * sr - ai * si + er[j], ni = ar * si + ai * sr + ei[j]; sr = nr; si = ni; }
    __syncthreads();
    T[(part * 2 + 0) * 64 + p] = sr; T[(part * 2 + 1) * 64 + p] = si;
    __syncthreads();
    float wr_ = 0.f, wi_ = 0.f;
    for (int k = 0; k < part; ++k) { const float tr = T[(k * 2 + 0) * 64 + p], ti = T[(k * 2 + 1) * 64 + p]; const float nr = a16r * wr_ - a16i * wi_ + tr, ni = a16r * wi_ + a16i * wr_ + ti; wr_ = nr; wi_ = ni; }
#pragma unroll
    for (int j = 0; j < 16; ++j) {
        A2[(long)j * 640 + p] = (bf16_t)(pk_bf16(lr[j] + wr_, 0.f) & 0xffff); A2[(long)j * 640 + 64 + p] = (bf16_t)(pk_bf16(li[j] + wi_, 0.f) & 0xffff);
        const float nr = ar * wr_ - ai * wi_, ni = ar * wi_ + ai * wr_; wr_ = nr; wi_ = ni;
    }
    __syncthreads();
}

#define XB_TMO      128
#define XB_XCNT(j)  (256  + 64 * (j))
#define XB_XSUB(j)  (1280 + 64 * (j))
#define XB_XGEN(j)  (2304 + 64 * (j))
#define XB_TOP      3328
#define XB_TOPGEN   3392
#define XCD_BAR_WORDS 3456
#define XB_SPIN_CAP (1u << 18)

__device__ __forceinline__ unsigned xb_ld(unsigned* p)              { return __hip_atomic_load(p, __ATOMIC_RELAXED, __HIP_MEMORY_SCOPE_AGENT); }
__device__ __forceinline__ unsigned xb_add(unsigned* p, unsigned v) { return __hip_atomic_fetch_add(p, v, __ATOMIC_RELAXED, __HIP_MEMORY_SCOPE_AGENT); }
__device__ __forceinline__ unsigned xb_xcc_id() { return (unsigned)__builtin_amdgcn_s_getreg((3 << 11) | 20) & 0xFu; }
#define XB_SPIN(cond, bar) do { unsigned _sp = 0; while (cond) { __builtin_amdgcn_s_sleep(1); \
    if ((++_sp & 255u) == 0u) { if (xb_ld(&(bar)[XB_TMO])) break; if (_sp > XB_SPIN_CAP) { atomicAdd(&(bar)[XB_TMO], 1u); break; } } } } while (0)

struct XcdBarrier {
    unsigned* bar; unsigned x;
    volatile LAS unsigned* st;
};

__device__ __forceinline__ XcdBarrier xcd_barrier_post(unsigned* bar, volatile LAS unsigned* st) {
    XcdBarrier b; b.bar = bar; b.x = xb_xcc_id(); b.st = st;
    if (threadIdx.x == 0) (void)xb_add(&bar[XB_XCNT(b.x)], 1u);
    return b;
}
__device__ __forceinline__ void xcd_barrier_complete(unsigned* bar, unsigned x, unsigned& nloc, unsigned& nx) {
    const unsigned G = gridDim.x * gridDim.y * gridDim.z;
    unsigned sum, cnt, mine, sp = 0u;
    for (;;) {
        sum = 0u; cnt = 0u; mine = 0u;
#pragma unroll
        for (unsigned j = 0; j < 16; ++j) { const unsigned c = xb_ld(&bar[XB_XCNT(j)]); sum += c; cnt += (c > 0u) ? 1u : 0u; mine = (j == x) ? c : mine; }
        if (sum == G) break;
        __builtin_amdgcn_s_sleep(1);
        if ((++sp & 255u) == 0u) { if (xb_ld(&bar[XB_TMO])) break; if (sp > XB_SPIN_CAP) { atomicAdd(&bar[XB_TMO], 1u); break; } }
    }
    nloc = mine > 0u ? mine : 1u; nx = cnt > 0u ? cnt : 1u;
}

__device__ __forceinline__ void xcd_barrier(const XcdBarrier& b) {
    asm volatile("s_waitcnt vmcnt(0)" ::: "memory");
    __syncthreads();
    if (threadIdx.x == 0) {
        unsigned* bar = b.bar;
        __builtin_amdgcn_s_waitcnt(0);
        unsigned nloc = b.st[0], nx = b.st[1];
        if (nloc == 0u) { xcd_barrier_complete(bar, b.x, nloc, nx); b.st[0] = nloc; b.st[1] = nx; }
        const unsigned old = xb_add(&bar[XB_XSUB(b.x)], 1u);
        const unsigned gen = old / nloc;
        if (old + 1u == (gen + 1u) * nloc) {
            __builtin_amdgcn_fence(__ATOMIC_RELEASE, "agent");
            asm volatile("s_waitcnt vmcnt(0)" ::: "memory");
            const unsigned og = xb_add(&bar[XB_TOP], 1u);
            const unsigned tg = og / nx;
            if (og + 1u == (tg + 1u) * nx) xb_add(&bar[XB_TOPGEN], 1u);
            else XB_SPIN(xb_ld(&bar[XB_TOPGEN]) == tg, bar);
            __builtin_amdgcn_fence(__ATOMIC_ACQUIRE, "agent");
            xb_add(&bar[XB_XGEN(b.x)], 1u);
            asm volatile("s_waitcnt vmcnt(0)" ::: "memory");
        } else {
            XB_SPIN(xb_ld(&bar[XB_XGEN(b.x)]) == gen, bar);
            __builtin_amdgcn_fence(__ATOMIC_ACQUIRE, "agent");
            asm volatile("s_waitcnt vmcnt(0)" ::: "memory");
        }
    }
    __syncthreads();
}


__global__ void __launch_bounds__(512, 2) mega(Params P) {
    const int G = gridDim.x, cb = blockIdx.x;
    __shared__ uint4 xb_words;
    if (threadIdx.x == 0) xb_words = make_uint4(0u, 0u, 0u, 0u);
    __syncthreads();
    const XcdBarrier xbar = xcd_barrier_post((unsigned*)(P.ws + OFF_BAR), (volatile LAS unsigned*)&xb_words);
    for (int phr = P.ph_lo * 2; phr < P.ph_hi * 2; ++phr) {
        const int ph = phr >> 1;
        if ((phr & 1) && ph != PROBE_PH) continue;
        if (ph == 5) continue;
#if PROBE_PH >= 0
        __syncthreads(); if (threadIdx.x == 0) s_aoff = (phr & 1) ? (long)24 * M_TOK : 0; __syncthreads();
#endif
        if (phr > P.ph_lo * 2) { if (P.ph_lo < 0) cg::this_grid().sync(); else xcd_barrier(xbar); }
        int tid = threadIdx.x; asm volatile("" : "+v"(tid));
        if (ph == 0) {
            for (int task = cb; task < NWT; task += 2 * G) {
                const WtDesc d0 = wt_desc(P, task); f32x4 r0[4]; wt_load(d0, r0);
                const int t1 = task + G;
                if (t1 < NWT) { const WtDesc d1 = wt_desc(P, t1); f32x4 r1[4]; wt_load(d1, r1); wt_store(d0, r0); wt_store(d1, r1); }
                else wt_store(d0, r0);
            }
            constexpr int R8 = 0, R9 = R8 + 1024  , R10 = R9 + 512  , R11 = R10 + 120  , R12 = R11 + 1024  , R13 = R12 + 512  ,
                          R14 = R13 + 256  , R15 = R14 + 128  , R16 = R15 + 1  ;
            for (int task = cb; task < R16; task += G) {
                if (task < R9) {
                    const int lane = tid & 63, row0 = (task - R8) * 32 + (tid >> 6) * 4;
                    f32x4 v[4][4];
#pragma unroll
                    for (int rr = 0; rr < 4; ++rr)
#pragma unroll
                        for (int i = 0; i < 4; ++i) v[rr][i] = __builtin_nontemporal_load((const f32x4*)(P.x + (long)(row0 + rr) * DM + i * 256 + lane * 4));
#pragma unroll
                    for (int rr = 0; rr < 4; ++rr) {
                        bf16_t* xb = WSP(bf16_t, OFF_HB) + (long)(row0 + rr) * DM; float sq = 0.f;
#pragma unroll
                        for (int i = 0; i < 4; ++i) { const f32x4 a = v[rr][i]; sq += a[0] * a[0] + a[1] * a[1] + a[2] * a[2] + a[3] * a[3]; store_bf4(xb + i * 256 + lane * 4, a); }
#pragma unroll
                        for (int o = 32; o > 0; o >>= 1) sq += __shfl_xor(sq, o);
                        if (lane == 0) WSP(float, OFF_SS)[row0 + rr] = sq;
                    }
                } else if (task < R10) {
                    f32x4 a[4], b[4];
#pragma unroll
                    for (int i = 0; i < 4; ++i) { const long e = ((long)(task - R9) * 2048 + i * 512 + tid) * 8; a[i] = __builtin_nontemporal_load((const f32x4*)(P.p + e)); b[i] = __builtin_nontemporal_load((const f32x4*)(P.p + e + 4)); }
#pragma unroll
                    for (int i = 0; i < 4; ++i) { const long e = ((long)(task - R9) * 2048 + i * 512 + tid) * 8;
                        u32x4 w; w.x = pk_bf16(a[i][0], a[i][1]); w.y = pk_bf16(a[i][2], a[i][3]); w.z = pk_bf16(b[i][0], b[i][1]); w.w = pk_bf16(b[i][2], b[i][3]);
                        *(u32x4*)(WSP(bf16_t, OFF_PB) + e) = w; }
                } else if (task < R11) {
                    const int zt = task - R10;
                    const long e = (zt < 56 ? (long)M_TOK : (long)16 * M_TOK - (long)56 * 4096) + ((long)zt * 512 + tid) * 8;
                    const f32x4 z = {0.f, 0.f, 0.f, 0.f};
                    *(f32x4*)(WSP(float, OFF_SS) + e) = z; *(f32x4*)(WSP(float, OFF_SS) + e + 4) = z;
                } else if (task < R12) {
                    const int id = (task - R11) * 512 + tid, m = id >> 4, i = id & 15;
                    const double ang = (double)P.pos[m] * (double)c_inv_freq[i];
                    double r = ang * 0.15915494309189535; r -= floor(r);
                    float* tab = WSP(float, OFF_TAB) + (long)m * 32;
                    tab[i] = __builtin_amdgcn_cosf((float)r); tab[16 + i] = __builtin_amdgcn_sinf((float)r);
                } else if (task < R13) {
                    const int g = (task - R12) >> 4, tau0 = ((task - R12) & 15) * 2;
                    float* wre = (float*)shm; float* wim = wre + 2048; float* cre = wim + 2048; float* cim = cre + 1024;
                    __syncthreads();
#pragma unroll
                    for (int i = 0; i < 4; ++i) { const int idx = i * 512 + tid, hi_ = idx & 15, p = (idx >> 4) & 63, tl_ = idx >> 10;
                        const S5Mode md = s5_mode(P, g, p); float zr, zi; s5_pow(md, (float)(tau0 + tl_), zr, zi);
                        const float br = P.b_re[(g * 64 + p) * 16 + hi_], bi = P.b_im[(g * 64 + p) * 16 + hi_];
                        const float bbr = md.cr * br - md.ci * bi, bbi = md.cr * bi + md.ci * br;
                        wre[idx] = zr * bbr - zi * bbi; wim[idx] = zr * bbi + zi * bbr; }
#pragma unroll
                    for (int i = 0; i < 2; ++i) { const int idx = i * 512 + tid; cre[idx] = P.c_re[g * 1024 + idx]; cim[idx] = P.c_im[g * 1024 + idx]; }
                    __syncthreads();
                    const int hi_ = tid & 15, ho = (tid >> 4) & 15, tl_ = tid >> 8;
                    float a = 0.f;
#pragma unroll 8
                    for (int p = 0; p < 64; ++p) a += cre[ho * 64 + p] * wre[(tl_ * 64 + p) * 16 + hi_] - cim[ho * 64 + p] * wim[(tl_ * 64 + p) * 16 + hi_];
                    if (tau0 + tl_ == 0 && ho == hi_) a += P.ssm_d[g * 16 + ho];
                    WSP(float, OFF_KTAB)[((g * 32 + tau0 + tl_) * 16 + ho) * 16 + hi_] = a;
                    __syncthreads();
                } else if (task < R14) {
                    const int id = (task - R13) * 512 + tid, s = id & 31, j = (id >> 5) & 127, g = id >> 12, p = j & 63;
                    const S5Mode md = s5_mode(P, g, p); float zr, zi; s5_pow(md, (float)(31 - s), zr, zi);
                    float br[16], bi[16];
#pragma unroll
                    for (int q = 0; q < 4; ++q) { const f32x4 a = *(const f32x4*)(P.b_re + (g * 64 + p) * 16 + q * 4), b = *(const f32x4*)(P.b_im + (g * 64 + p) * 16 + q * 4);
#pragma unroll
                        for (int e = 0; e < 4; ++e) { br[q * 4 + e] = a[e]; bi[q * 4 + e] = b[e]; } }
                    float o[16];
#pragma unroll
                    for (int h = 0; h < 16; ++h) { const float bbr = md.cr * br[h] - md.ci * bi[h], bbi = md.cr * bi[h] + md.ci * br[h]; o[h] = j < 64 ? (zr * bbr - zi * bbi) : (zr * bbi + zi * bbr); }
                    bf16_t* dst = WSP(bf16_t, OFF_PM) + ((long)g * 128 + j) * 512 + s * 16;
                    u32x4 w0, w1; w0.x = pk_bf16(o[0], o[1]); w0.y = pk_bf16(o[2], o[3]); w0.z = pk_bf16(o[4], o[5]); w0.w = pk_bf16(o[6], o[7]);
                    w1.x = pk_bf16(o[8], o[9]); w1.y = pk_bf16(o[10], o[11]); w1.z = pk_bf16(o[12], o[13]); w1.w = pk_bf16(o[14], o[15]);
                    *(u32x4*)dst = w0; *(u32x4*)(dst + 8) = w1;
                } else if (task < R15) {
                    const int id = (task - R14) * 512 + tid, p = id & 63, t = (id >> 6) & 31, g = id >> 11;
                    const S5Mode md = s5_mode(P, g, p); float zr, zi; s5_pow(md, (float)(t + 1), zr, zi);
                    bf16_t* dst = WSP(bf16_t, OFF_MQ) + ((long)g * 512 + t * 16) * 640 + 512 + p;
#pragma unroll
                    for (int ho = 0; ho < 16; ++ho) { const float cr = P.c_re[(g * 16 + ho) * 64 + p], ci = P.c_im[(g * 16 + ho) * 64 + p];
                        dst[(long)ho * 640] = (bf16_t)(pk_bf16(cr * zr - ci * zi, 0.f) & 0xffff); dst[(long)ho * 640 + 64] = (bf16_t)(pk_bf16(-(cr * zi + ci * zr), 0.f) & 0xffff); }
                } else {
                    for (int e = tid; e < 96 * 1024 / 8; e += 512) { const u32x4 z = {0u, 0u, 0u, 0u}; *(u32x4*)(WSP(bf16_t, OFF_WIN) + (long)1184 * 1024 + (long)e * 8) = z; }
                }
            }
        } else if (ph == 4) {
            for (int task = cb; task < 2048; task += G) {
                const int id = task * 512 + tid, c8 = id & 63, rowq = (id >> 6) & 511, g = id >> 15;
                const int t = rowq >> 4, ho = rowq & 15, s = c8 >> 1, hi0 = (c8 & 1) * 8;
                u32x4 w = {0u, 0u, 0u, 0u};
                if (s <= t) { const float* kt = WSP(float, OFF_KTAB) + (((long)g * 32 + (t - s)) * 16 + ho) * 16 + hi0;
                    const f32x4 a = *(const f32x4*)kt, b = *(const f32x4*)(kt + 4);
                    w.x = pk_bf16(a[0], a[1]); w.y = pk_bf16(a[2], a[3]); w.z = pk_bf16(b[0], b[1]); w.w = pk_bf16(b[2], b[3]); }
                *(u32x4*)(WSP(bf16_t, OFF_MQ) + ((long)g * 512 + rowq) * 640 + c8 * 8) = w;
            }
        } else if (ph == 6) {
            for (int it = cb; it < 1024; it += G) {
                const int r = (it >> 6) & 3, j = it >> 8, bh = it & 63;
                const int qb = (j & 1) ? (15 - 4 * j - (3 - r)) : (15 - 4 * j - r);
                attn_item(P, bh, qb);
            }
        }
        switch (ph) {
            case 1: stream_gemm<E_SWIGLU>(P, WSP(bf16_t, OFF_HB), WSP(bf16_t, OFF_W1), 5632, 1024, 0); break;
            case 9: stream_gemm<E_SWIGLU>(P, WSP(bf16_t, OFF_HB), WSP(bf16_t, OFF_W2), 5632, 1024, 1); break;
            case 2: stream_gemm<E_DOWN>(P, WSP(bf16_t, OFF_ACT), WSP(bf16_t, OFF_WD1), 1024, 2816, 0); break;
            case 10: stream_gemm<E_DOWN>(P, WSP(bf16_t, OFF_ACT), WSP(bf16_t, OFF_WD2), 1024, 2816, 1); break;
            case 3: stream_gemm<E_WIN>(P, WSP(bf16_t, OFF_HB), WSP(bf16_t, OFF_WIN), 1280, 1024, 0); break;
            case 7: stream_gemm<E_GLU>(P, (const bf16_t*)P.out + (long)M_TOK * 1024, WSP(bf16_t, OFF_WGLU), 512, 512, 0); break;
            case 11: stream_gemm<E_PLE>(P, WSP(bf16_t, OFF_HB), WSP(bf16_t, OFF_WPG), 1024, 1024, 0); break;
            default: break;
        }
        int ntiles = 0;
        switch (ph) {
            case 4: ntiles = 128 * 3 + 128 * 4 + 128; break;
            case 6: ntiles = 256; break;
            case 8: ntiles = 128 * 4; break;
            case 3: ntiles = 128 * 4; break;
            default: break;
        }
        struct TD { const char *Ap, *Bp, *Ap2, *Bp2; int lda, ldb, nt, nt2, mode, aux, brow, bcol; };
        auto make_td = [&](int L) -> TD {
            const bf16_t *A = nullptr, *Bt = nullptr, *A2p = nullptr, *B2p = nullptr; int lda = 0, ldb = 0, nt = 0, mode = 0, aux = 0, pm = 0, pn = 0, nt2 = 0;
            switch (ph) {
                case 4:
                    if (L < 384) { tile_map(L, 128, 3, pm, pn); A = WSP(bf16_t, OFF_CQB); lda = 384; Bt = WSP(bf16_t, OFF_WUQ); ldb = 384; nt = 6; mode = E_QRAW; }
                    else if (L < 896) { tile_map(L - 384, 128, 4, pm, pn); A = WSP(bf16_t, OFF_CKVB); lda = 256; Bt = WSP(bf16_t, OFF_WUKV); ldb = 256; nt = 4; mode = E_KVRAW; }
                    else { const int tl = L - 896; aux = tl >> 2; pm = tl & 3; pn = 0; A = WSP(bf16_t, OFF_A2) + (long)aux * 1024 * 640; lda = 640; Bt = WSP(bf16_t, OFF_PM) + (long)aux * 128 * 512; ldb = 512; nt = 8; mode = E_S5E; }
                    break;
                case 6: { aux = L >> 3; pm = (L & 7) >> 1; pn = L & 1; A = WSP(bf16_t, OFF_A2) + (long)aux * 1024 * 640; lda = 640; Bt = WSP(bf16_t, OFF_MQ) + (long)aux * 512 * 640; ldb = 640; nt = 10; mode = E_S5Y; } break;
                case 8: tile_map(L, 128, 4, pm, pn); A = (const bf16_t*)P.out; lda = 1024; Bt = WSP(bf16_t, OFF_WOUT); ldb = 1024; nt = 8; nt2 = 8; A2p = A + 512; B2p = Bt + 512; mode = E_WOUT; break;
                case 3: { tile_map(L, 128, 4, pm, pn); A = WSP(bf16_t, OFF_PB); lda = 256; Bt = WSP(bf16_t, OFF_WPP); ldb = 256; nt = 4; mode = E_PP; } break;
                default: break;
            }
            TD d; d.lda = lda; d.ldb = ldb; d.nt = nt; d.nt2 = nt2; d.mode = mode; d.aux = aux; d.brow = pm * BM; d.bcol = pn * BM;
            d.Ap = (const char*)(A + (long)d.brow * lda); d.Bp = (const char*)(Bt + (long)d.bcol * ldb);
            d.Ap2 = nt2 ? (const char*)(A2p + (long)d.brow * lda) : d.Ap; d.Bp2 = nt2 ? (const char*)(B2p + (long)d.bcol * ldb) : d.Bp;
            return d;
        };
        TD cur{}; bool pre = false;
        int L0 = cb, Lstep = G;
        if (ph == 3) { Lstep = G / 2; if (cb >= G / 2) { L0 = cb - G / 2; ntiles = 3 * (G / 2) < ntiles ? 3 * (G / 2) : ntiles; } else L0 = 3 * (G / 2) + cb; }
        if (L0 < ntiles) cur = make_td(L0);
        for (int L = L0; L < ntiles; L += Lstep) {
            const int lda = cur.lda, ldb = cur.ldb, nt = cur.nt, nt2 = cur.nt2, mode = cur.mode, aux = cur.aux;
            const int brow = cur.brow, bcol = cur.bcol;
            f32x4 acc[2][2][4][2];
#pragma unroll
            for (int a = 0; a < 2; ++a)
#pragma unroll
                for (int b = 0; b < 2; ++b)
#pragma unroll
                    for (int m = 0; m < 4; ++m)
#pragma unroll
                        for (int n = 0; n < 2; ++n) acc[a][b][m][n] = (f32x4){0.f, 0.f, 0.f, 0.f};
            const char* Ap = cur.Ap; const char* Bp = cur.Bp; int ntc = nt;
            for (int part = 0; part < (nt2 ? 2 : 1); ++part) {
                gemm_loop(acc, Ap, lda, Bp, ldb, ntc, pre && part == 0);
                if (nt2 && part == 0) {
                    int tid_ = threadIdx.x; asm volatile("" : "+v"(tid_));
                    const int wid = tid_ >> 6, lane = tid_ & 63, wr = wid >> 2, fr = lane & 15;
                    const float* ss = WSP(float, OFF_SS);
#pragma unroll
                    for (int a = 0; a < 2; ++a)
#pragma unroll
                        for (int m = 0; m < 4; ++m) {
                            const int row = brow + a * HALF + wr * 64 + m * 16 + fr;
                            const float ratio = rsqrtf(ss[6 * M_TOK + row] * (1.f / 512.f) + EPS) / rsqrtf(ss[7 * M_TOK + row] * (1.f / 512.f) + EPS);
#pragma unroll
                            for (int b = 0; b < 2; ++b)
#pragma unroll
                                for (int n = 0; n < 2; ++n) acc[a][b][m][n] *= ratio;
                        }
                    Ap = cur.Ap2; Bp = cur.Bp2; ntc = nt2;
                }
            }
            TD nxt = cur; pre = false;
            if (L + Lstep < ntiles) { nxt = make_td(L + Lstep); gemm_pre(nxt.Ap, nxt.lda, nxt.Bp, nxt.ldb); pre = true; }
            switch (mode) {
                case E_SWIGLU: epilogue<E_SWIGLU>(acc, P, brow, bcol, aux); break;
                case E_DOWN: epilogue<E_DOWN>(acc, P, brow, bcol, aux); break;
                case E_WIN: epilogue<E_WIN>(acc, P, brow, bcol, aux); break;
                case E_QRAW: epilogue<E_QRAW>(acc, P, brow, bcol, aux); break;
                case E_KVRAW: epilogue_kv(acc, P, brow, bcol); break;
                case E_S5E: epilogue<E_S5E>(acc, P, brow, bcol, aux);
                    __syncthreads();
                    s5_scan_task(P, aux, 2 * (brow >> 8), (float*)((char*)shm + 32768)); s5_scan_task(P, aux, 2 * (brow >> 8) + 1, (float*)((char*)shm + 32768));
                    break;
                case E_S5Y: epilogue<E_S5Y>(acc, P, brow, bcol, aux); break;
                case E_GLU: epilogue<E_GLU>(acc, P, brow, bcol, aux); break;
                case E_WOUT: epilogue<E_WOUT>(acc, P, brow, bcol, aux); break;
                case E_PP: epilogue<E_PP>(acc, P, brow, bcol, aux); break;
                default: epilogue<E_PLE>(acc, P, brow, bcol, aux); break;
            }
            cur = nxt;
        }
    }
}

extern "C" void kernel_launch(void* const* d_in, const int* in_sizes, int n_in, void* d_out, int out_size, void* d_ws, size_t ws_size, hipStream_t stream) {
    static int grid = 0;
    if (grid == 0) {
        if (n_in != 35 || ws_size < OFF_BAR + 16384 || out_size != M_TOK * DM) { fprintf(stderr, "kernel_launch: unexpected problem (n_in %d, ws %zu need %zu, out %d)\n", n_in, ws_size, (size_t)WS_END, out_size); grid = -1; return; }
        int dev = 0, cus = 0, per_cu = 0;
        hipGetDevice(&dev); hipDeviceGetAttribute(&cus, hipDeviceAttributeMultiprocessorCount, dev);
        if (hipFuncSetAttribute((const void*)mega, hipFuncAttributeMaxDynamicSharedMemorySize, SHM_B) != hipSuccess) { fprintf(stderr, "kernel_launch: hipFuncSetAttribute failed\n"); grid = -1; return; }
        if (hipOccupancyMaxActiveBlocksPerMultiprocessor(&per_cu, (const void*)mega, 512, SHM_B) != hipSuccess || per_cu < 1) { fprintf(stderr, "kernel_launch: occupancy query failed (%d)\n", per_cu); (void)hipGetLastError(); per_cu = 1; }
        grid = cus * per_cu;
        if (grid > 256) grid = 256;
        grid &= ~7;
    }
    if (grid <= 0) return;
    Params P{};
    const float** fp = (const float**)&P.norm_ffn1;
    P.x = (const float*)d_in[0]; P.p = (const float*)d_in[1]; P.pos = (const int*)d_in[2];
    for (int i = 3; i < 35; ++i) fp[i - 3] = (const float*)d_in[i];
    P.out = (float*)d_out; P.ws = (char*)d_ws;
#if MK_MULTI
    for (int ph = 0; ph < 12; ++ph) { P.ph_lo = ph; P.ph_hi = ph + 1; hipLaunchKernelGGL(mega, dim3(grid), dim3(512), SHM_B, stream, P); }
#else
    P.ph_lo = 0; P.ph_hi = 12;
    (void)hipMemsetAsync((char*)d_ws + OFF_BAR, 0, 16384, stream);
    void* args[] = {&P};
    hipError_t e = hipLaunchCooperativeKernel((void*)mega, dim3(grid), dim3(512), args, SHM_B, stream);
    if (e != hipSuccess) fprintf(stderr, "cooperative launch failed: %s (grid %d)\n", hipGetErrorString(e), grid);
#endif
}
```

```cpp
#include <hip/hip_runtime.h>
#include <hip/hip_cooperative_groups.h>
#include <cstdint>
#include <cstdio>
namespace cg = cooperative_groups;

typedef unsigned short bf16_t;
typedef short bf16x8 __attribute__((ext_vector_type(8)));
typedef float f32x4 __attribute__((ext_vector_type(4)));
typedef float f32x16 __attribute__((ext_vector_type(16)));
typedef unsigned u32x2 __attribute__((ext_vector_type(2)));
typedef unsigned u32x4 __attribute__((ext_vector_type(4)));

#ifndef MK_MULTI
#define MK_MULTI 0
#endif
#ifndef PROBE_MASK
#define PROBE_MASK 0
#endif
#ifndef PROBE_SEL
#define PROBE_SEL 0
#endif

constexpr int M_TOK = 32768, DM = 1024, DFF = 2816, SEQ = 4096;
constexpr int BM = 256, BK = 64, HALF = 128, HT = HALF * BK, SHM_B = 8 * HT * 2;
constexpr float EPS = 1e-6f;

constexpr size_t SZ_SS = (size_t)48 * M_TOK * 4;
constexpr size_t OFF_SS = 0;
constexpr size_t OFF_W1 = OFF_SS + SZ_SS;
constexpr size_t OFF_WD1 = OFF_W1 + (size_t)5632 * 1024 * 2;
constexpr size_t OFF_W2 = OFF_WD1 + (size_t)1024 * 2816 * 2;
constexpr size_t OFF_WD2 = OFF_W2 + (size_t)5632 * 1024 * 2;
constexpr size_t OFF_WIN = OFF_WD2 + (size_t)1024 * 2816 * 2;
constexpr size_t OFF_WUQ = OFF_WIN + (size_t)1280 * 1024 * 2;
constexpr size_t OFF_WUKV = OFF_WUQ + (size_t)768 * 384 * 2;
constexpr size_t OFF_WGLU = OFF_WUKV + (size_t)1024 * 256 * 2;
constexpr size_t OFF_WOUT = OFF_WGLU + (size_t)512 * 512 * 2;
constexpr size_t OFF_WPG = OFF_WOUT + (size_t)1024 * 1024 * 2;
constexpr size_t OFF_WPP = OFF_WPG + (size_t)1024 * 1024 * 2;
constexpr size_t OFF_TAB = OFF_WPP + (size_t)1024 * 256 * 2;
constexpr size_t OFF_KTAB = OFF_TAB + (size_t)M_TOK * 32 * 4;
constexpr size_t OFF_PB = OFF_KTAB + (size_t)32 * 32 * 256 * 4;
constexpr size_t OFF_HB = OFF_PB + (size_t)M_TOK * 256 * 2;
constexpr size_t OFF_HBUF = OFF_HB + (size_t)M_TOK * 1024 * 2;
constexpr size_t OFF_S5 = OFF_HBUF + (size_t)M_TOK * 1024 * 4;
constexpr size_t OFF_MQ = OFF_S5;
constexpr size_t OFF_PM = OFF_MQ + (size_t)32 * 512 * 640 * 2;
constexpr size_t OFF_A2 = OFF_PM + (size_t)32 * 256 * 512 * 2;
constexpr size_t OFF_PP = OFF_HBUF + (size_t)64 * 1024 * 1024;
constexpr size_t OFF_ACT = OFF_A2 + (size_t)32 * 1024 * 640 * 2;
constexpr size_t OFF_CQB = OFF_ACT;
constexpr size_t OFF_CKVB = OFF_CQB + (size_t)M_TOK * 384 * 2;
constexpr size_t OFF_KPE = OFF_CKVB + (size_t)M_TOK * 256 * 2;
constexpr size_t OFF_QRAW = OFF_KPE + (size_t)M_TOK * 32 * 4;
constexpr size_t OFF_KVRAW = OFF_QRAW + (size_t)M_TOK * 768 * 2;
constexpr size_t OFF_E = OFF_KVRAW + (size_t)M_TOK * 1024 * 2;
constexpr size_t OFF_ACT_END = OFF_E + (size_t)32 * 1024 * 128 * 4;
constexpr size_t WS_END = OFF_ACT + (size_t)M_TOK * 2816 * 2;
static_assert(OFF_ACT_END <= WS_END, "act region overflow");
static_assert(OFF_PP + (size_t)M_TOK * 1024 * 2 <= OFF_S5, "pp overflow");
constexpr size_t OFF_BAR = WS_END;
static_assert(OFF_BAR + 16384 <= (size_t)536870912, "workspace too large");

struct Params {
    const float *x, *p; const int* pos;
    const float *norm_ffn1, *w1g, *w1u, *w1d, *norm_mix, *w_in, *lam_re, *lam_im, *log_dt, *b_re, *b_im, *c_re, *c_im, *ssm_d, *w_glu, *b_glu,
        *q_norm, *w_uq, *kv_norm, *w_ukv, *qkn_q, *qkn_k, *on_ssm, *on_att, *w_out, *norm_ffn2, *w2g, *w2u, *w2d, *norm_ple, *w_pg, *w_pp;
    float* out; char* ws;
    int ph_lo, ph_hi; long atom_off;
};

extern __shared__ __attribute__((aligned(16))) bf16_t shm[];
#ifndef PROBE_PH
#define PROBE_PH -1
#endif
#if PROBE_PH >= 0
__shared__ long s_aoff;
#define ATOM_OFF s_aoff
#else
#define ATOM_OFF 0
#endif

__device__ __forceinline__ unsigned pk_bf16(float lo, float hi) { unsigned r; asm volatile("v_cvt_pk_bf16_f32 %0, %1, %2" : "=v"(r) : "v"(lo), "v"(hi)); return r; }
__device__ __forceinline__ float bf_lo(unsigned u) { return __uint_as_float(u << 16); }
__device__ __forceinline__ float bf_hi(unsigned u) { return __uint_as_float(u & 0xffff0000u); }
__device__ __forceinline__ float sigmoidf_(float v) { return __builtin_amdgcn_rcpf(1.f + __expf(-v)); }
__device__ __forceinline__ void cisf(float ang, float& c, float& s) { float r = ang * 0.15915494309189535f; r -= floorf(r); c = __builtin_amdgcn_cosf(r); s = __builtin_amdgcn_sinf(r); }

__device__ __forceinline__ int lds_byte(int r, int c) { int st = (r >> 4) * 2 + (c >> 5), rr = r & 15, cc = c & 31, ob = rr * 64 + cc * 2; return st * 1024 + (ob ^ (((ob >> 9) & 1) << 5)); }
__device__ __forceinline__ void stage_rc(int b, int& R, int& C) { int st = b / 1024, sb = b % 1024, swz = sb ^ (((sb >> 9) & 1) << 5); R = (st >> 1) * 16 + swz / 64; C = (st & 1) * 32 + (swz % 64) / 2; }

#define LAS __attribute__((address_space(3)))
constexpr int HTB = HT * 2;
#define SA(b, h) (((b) * 2 + (h)) * HTB)
#define SB(b, h) ((4 + (b) * 2 + (h)) * HTB)
#define STAGE(bufoff, gbase, voff) do { _Pragma("unroll") for (int _i = 0; _i < 2; ++_i) \
    __builtin_amdgcn_global_load_lds((const unsigned*)((const char*)(gbase) + (voff)[_i]), (LAS unsigned*)(lds + (bufoff) + ldsw + _i * 8192), 16, 0, 0); } while (0)
#define LDA(dst, b, h) do { _Pragma("unroll") for (int m = 0; m < 4; ++m) _Pragma("unroll") for (int k = 0; k < 2; ++k) dst[m][k] = *(const LAS bf16x8*)(lds + SA(b, h) + aoff + m * 2048 + k * 1024); } while (0)
#define LDB(dst, b, h) do { _Pragma("unroll") for (int n = 0; n < 2; ++n) _Pragma("unroll") for (int k = 0; k < 2; ++k) dst[n][k] = *(const LAS bf16x8*)(lds + SB(b, h) + boff + n * 2048 + k * 1024); } while (0)
#define MMA(ai, bj, At_, Bt_) do { __builtin_amdgcn_s_setprio(1); _Pragma("unroll") for (int m = 0; m < 4; ++m) _Pragma("unroll") for (int n = 0; n < 2; ++n) _Pragma("unroll") for (int k = 0; k < 2; ++k) \
      acc[ai][bj][m][n] = __builtin_amdgcn_mfma_f32_16x16x32_bf16(Bt_[n][k], At_[m][k], acc[ai][bj][m][n], 0, 0, 0); \
    __builtin_amdgcn_s_setprio(0); } while (0)
#define WAIT_V(n) asm volatile("s_waitcnt vmcnt(" #n ")" ::: "memory")
#define WAIT_L(n) asm volatile("s_waitcnt lgkmcnt(" #n ")" ::: "memory")
#define BAR __builtin_amdgcn_s_barrier()
#define SCHED __builtin_amdgcn_sched_barrier(0)

__device__ __forceinline__ void gemm_pre(const char* cA, int lda, const char* cB, int ldb) {
    LAS unsigned char* lds = (LAS unsigned char*)shm;
    int tid = threadIdx.x; asm volatile("" : "+v"(tid));
    const int wid = __builtin_amdgcn_readfirstlane(tid >> 6);
    unsigned voffA[2], voffB[2];
#pragma unroll
    for (int i = 0; i < 2; ++i) { int R, C; stage_rc(tid * 16 + i * 8192, R, C); const int rho = R & 31, Rb = (R & ~31) + 8 * ((rho & 15) >> 2) + 4 * (rho >> 4) + (rho & 3);
        voffA[i] = (unsigned)(R * lda + C) * 2u; voffB[i] = (unsigned)(Rb * ldb + C) * 2u; }
    const size_t hA = (size_t)HALF * lda * 2, hB = (size_t)HALF * ldb * 2;
    const unsigned ldsw = (unsigned)wid * 1024u;
    STAGE(SB(0, 0), cB, voffB); STAGE(SA(0, 0), cA, voffA); STAGE(SB(0, 1), cB + hB, voffB); STAGE(SA(0, 1), cA + hA, voffA);
}
__device__ __forceinline__ void gemm_loop(f32x4 (&acc)[2][2][4][2], const char* cA, int lda, const char* cB, int ldb, int nt, bool pre) {
    LAS unsigned char* lds = (LAS unsigned char*)shm;
    int tid = threadIdx.x; asm volatile("" : "+v"(tid));
    const int wid = __builtin_amdgcn_readfirstlane(tid >> 6), lane = tid & 63, wr = wid >> 2, wc = wid & 3, fr = lane & 15, fq = lane >> 4;
    unsigned voffA[2], voffB[2];
#pragma unroll
    for (int i = 0; i < 2; ++i) { int R, C; stage_rc(tid * 16 + i * 8192, R, C); const int rho = R & 31, Rb = (R & ~31) + 8 * ((rho & 15) >> 2) + 4 * (rho >> 4) + (rho & 3);
        voffA[i] = (unsigned)(R * lda + C) * 2u; voffB[i] = (unsigned)(Rb * ldb + C) * 2u; }
    const size_t hA = (size_t)HALF * lda * 2, hB = (size_t)HALF * ldb * 2, kstep = BK * 2;
    const unsigned ldsw = (unsigned)wid * 1024u;
    const int aoff = lds_byte(wr * 64 + fr, fq * 8), boff = lds_byte(wc * 32 + fr, fq * 8);
    bf16x8 At[4][2], B0[2][2], B1[2][2];
    if (!pre) { STAGE(SB(0, 0), cB, voffB); STAGE(SA(0, 0), cA, voffA); STAGE(SB(0, 1), cB + hB, voffB); STAGE(SA(0, 1), cA + hA, voffA); }
    if (wr == 1) BAR;
    WAIT_V(4); BAR;
    STAGE(SB(1, 0), cB + kstep, voffB); STAGE(SA(1, 0), cA + kstep, voffA); STAGE(SB(1, 1), cB + hB + kstep, voffB);
    WAIT_V(6); BAR;
    for (int t = 0; t < nt - 2; t += 2) {
        const char* a1 = cA + (size_t)(t + 1) * kstep; const char* a2 = a1 + kstep; const char* a3 = a2 + kstep;
        const char* b2 = cB + (size_t)(t + 2) * kstep; const char* b3 = b2 + kstep;
        LDB(B0, 0, 0); SCHED; LDA(At, 0, 0); STAGE(SA(1, 1), a1 + hA, voffA);
        WAIT_L(8); BAR; WAIT_L(0); MMA(0, 0, At, B0); BAR; SCHED;
        LDB(B1, 0, 1); STAGE(SB(0, 0), b2, voffB);
        BAR; WAIT_L(0); MMA(0, 1, At, B1); BAR;
        LDA(At, 0, 1); STAGE(SA(0, 0), a2, voffA);
        BAR; WAIT_L(0); MMA(1, 0, At, B0); BAR; SCHED;
        STAGE(SB(0, 1), b2 + hB, voffB);
        WAIT_V(6); BAR; MMA(1, 1, At, B1); BAR;
        LDB(B0, 1, 0); SCHED; LDA(At, 1, 0); STAGE(SA(0, 1), a2 + hA, voffA);
        WAIT_L(8); BAR; WAIT_L(0); MMA(0, 0, At, B0); BAR; SCHED;
        LDB(B1, 1, 1); STAGE(SB(1, 0), b3, voffB);
        BAR; WAIT_L(0); MMA(0, 1, At, B1); BAR;
        LDA(At, 1, 1); STAGE(SA(1, 0), a3, voffA);
        BAR; WAIT_L(0); MMA(1, 0, At, B0); BAR; SCHED;
        STAGE(SB(1, 1), b3 + hB, voffB);
        WAIT_V(6); BAR; MMA(1, 1, At, B1); BAR;
    }
    { const char* a1 = cA + (size_t)(nt - 1) * kstep;
      LDB(B0, 0, 0); LDA(At, 0, 0); STAGE(SA(1, 1), a1 + hA, voffA);
      BAR; WAIT_L(0); MMA(0, 0, At, B0); BAR;
      LDB(B1, 0, 1); BAR; WAIT_L(0); MMA(0, 1, At, B1); BAR;
      LDA(At, 0, 1); WAIT_V(4); BAR; WAIT_L(0); MMA(1, 0, At, B0); MMA(1, 1, At, B1); BAR; }
    { LDB(B0, 1, 0); LDA(At, 1, 0); WAIT_V(2); BAR; WAIT_L(0); MMA(0, 0, At, B0); BAR;
      LDB(B1, 1, 1); WAIT_V(0); BAR; WAIT_L(0); MMA(0, 1, At, B1); BAR;
      LDA(At, 1, 1); BAR; WAIT_L(0); MMA(1, 0, At, B0); MMA(1, 1, At, B1); BAR; }
    if (wr == 0) BAR;
}

__device__ __forceinline__ void tile_map(int L, int nM, int nN, int& pm, int& pn) {
    const int nwg = nM * nN, q = nwg / 8, r = nwg % 8, xcd = L % 8, off = L / 8;
    const int wgid = (xcd < r ? xcd * (q + 1) : r * (q + 1) + (xcd - r) * q) + off;
    const int nig = 8 * nN, gid = wgid / nig, fm = gid * 8, gsz = (nM - fm) < 8 ? (nM - fm) : 8;
    pm = fm + ((wgid % nig) % gsz); pn = (wgid % nig) / gsz;
}

__device__ __forceinline__ void ld8(const bf16_t* p, float (&v)[8]) { const u32x4 w = *(const u32x4*)p;
    v[0] = bf_lo(w.x); v[1] = bf_hi(w.x); v[2] = bf_lo(w.y); v[3] = bf_hi(w.y); v[4] = bf_lo(w.z); v[5] = bf_hi(w.z); v[6] = bf_lo(w.w); v[7] = bf_hi(w.w); }
__device__ __forceinline__ void ld8f(const float* p, float (&v)[8]) { const f32x4 a = *(const f32x4*)p, b = *(const f32x4*)(p + 4);
    v[0] = a[0]; v[1] = a[1]; v[2] = a[2]; v[3] = a[3]; v[4] = b[0]; v[5] = b[1]; v[6] = b[2]; v[7] = b[3]; }
__device__ __forceinline__ void st8(bf16_t* p, const float (&v)[8]) { u32x4 w; w.x = pk_bf16(v[0], v[1]); w.y = pk_bf16(v[2], v[3]); w.z = pk_bf16(v[4], v[5]); w.w = pk_bf16(v[6], v[7]); *(u32x4*)p = w; }
__device__ __forceinline__ float sq8(const float (&v)[8]) { float s = 0.f;
#pragma unroll
    for (int i = 0; i < 8; ++i) s += v[i] * v[i]; return s; }


enum { E_SWIGLU = 0, E_DOWN, E_WIN, E_QRAW, E_KVRAW, E_S5E, E_S5Y, E_GLU, E_WOUT, E_PP, E_PLE };

#define WSP(T, off) ((T*)(P.ws + (off)))

__device__ __forceinline__ void store_bf4(bf16_t* p, f32x4 v) { u32x2 w; w.x = pk_bf16(v[0], v[1]); w.y = pk_bf16(v[2], v[3]); *(u32x2*)p = w; }

template <int MODE> __device__ __forceinline__ void epilogue(const f32x4 (&acc)[2][2][4][2], const Params& P, int brow, int bcol, int aux) {
    int tid_ = threadIdx.x; asm volatile("" : "+v"(tid_));
    const int wid = tid_ >> 6, lane = tid_ & 63, wr = wid >> 2, wc = wid & 3, fr = lane & 15, fq = lane >> 4;
    float* ss = WSP(float, OFF_SS);
#pragma unroll
    for (int ai = 0; ai < 2; ++ai)
#pragma unroll
        for (int m = 0; m < 4; ++m) {
            const int row = brow + ai * HALF + wr * 64 + m * 16 + fr;
            if constexpr (MODE == E_SWIGLU) {
                const float rs = rsqrtf(ss[(aux ? 2 : 0) * M_TOK + row] * (1.f / 1024.f) + EPS);
                bf16_t* act = WSP(bf16_t, OFF_ACT);
                float o[8];
#pragma unroll
                for (int n = 0; n < 2; ++n) {
                    const f32x4 g = acc[ai][0][m][n] * rs, u = acc[ai][1][m][n] * rs;
#pragma unroll
                    for (int j = 0; j < 4; ++j) o[n * 4 + j] = g[j] * sigmoidf_(g[j]) * u[j];
                }
                { u32x4 w_; w_.x = pk_bf16(o[0], o[1]); w_.y = pk_bf16(o[2], o[3]); w_.z = pk_bf16(o[4], o[5]); w_.w = pk_bf16(o[6], o[7]);
                  __builtin_nontemporal_store(w_, (u32x4*)(act + (long)row * DFF + (bcol >> 1) + wc * 32 + fq * 8)); }
            } else if constexpr (MODE == E_DOWN || MODE == E_WOUT) {
                bf16_t* hb = WSP(bf16_t, OFF_HB);
                float sc = 0.5f; int ssi = aux ? 3 : 1;
                if constexpr (MODE == E_WOUT) { sc = rsqrtf(ss[7 * M_TOK + row] * (1.f / 512.f) + EPS); ssi = 2; }
                float sq = 0.f;
                if constexpr (MODE == E_DOWN || MODE == E_WOUT) {
                    u32x4 rr8[2];
#pragma unroll
                    for (int bj = 0; bj < 2; ++bj) rr8[bj] = *(const u32x4*)(hb + (long)row * DM + bcol + bj * HALF + wc * 32 + fq * 8);
#pragma unroll
                    for (int bj = 0; bj < 2; ++bj) {
                        const f32x4 r0 = {bf_lo(rr8[bj].x), bf_hi(rr8[bj].x), bf_lo(rr8[bj].y), bf_hi(rr8[bj].y)}, r1 = {bf_lo(rr8[bj].z), bf_hi(rr8[bj].z), bf_lo(rr8[bj].w), bf_hi(rr8[bj].w)};
                        const f32x4 v0 = r0 + acc[ai][bj][m][0] * sc, v1 = r1 + acc[ai][bj][m][1] * sc;
                        u32x4 w; w.x = pk_bf16(v0[0], v0[1]); w.y = pk_bf16(v0[2], v0[3]); w.z = pk_bf16(v1[0], v1[1]); w.w = pk_bf16(v1[2], v1[3]);
                        __builtin_nontemporal_store(w, (u32x4*)(hb + (long)row * DM + bcol + bj * HALF + wc * 32 + fq * 8));
                        sq += v0[0] * v0[0] + v0[1] * v0[1] + v0[2] * v0[2] + v0[3] * v0[3] + v1[0] * v1[0] + v1[1] * v1[1] + v1[2] * v1[2] + v1[3] * v1[3];
                    }
                } else {
                u32x2 rr[2][2];
#pragma unroll
                for (int bj = 0; bj < 2; ++bj)
#pragma unroll
                    for (int n = 0; n < 2; ++n) rr[bj][n] = *(const u32x2*)(hb + (long)row * DM + bcol + bj * HALF + wc * 32 + n * 16 + fq * 4);
#pragma unroll
                for (int bj = 0; bj < 2; ++bj)
#pragma unroll
                    for (int n = 0; n < 2; ++n) {
                        const int col = bcol + bj * HALF + wc * 32 + n * 16 + fq * 4;
                        const f32x4 r = {bf_lo(rr[bj][n].x), bf_hi(rr[bj][n].x), bf_lo(rr[bj][n].y), bf_hi(rr[bj][n].y)};
                        const f32x4 v = r + acc[ai][bj][m][n] * sc;
                        store_bf4(hb + (long)row * DM + col, v);
                        sq += v[0] * v[0] + v[1] * v[1] + v[2] * v[2] + v[3] * v[3];
                    }
                }
                sq += __shfl_xor(sq, 16); sq += __shfl_xor(sq, 32);
                if (fq == 0) unsafeAtomicAdd(ss + ATOM_OFF + ssi * M_TOK + row, sq);
            } else if constexpr (MODE == E_WIN) {
                const float rs = rsqrtf(ss[1 * M_TOK + row] * (1.f / 1024.f) + EPS);
#pragma unroll
                for (int bj = 0; bj < 2; ++bj) {
                    const int seg = (bcol >> 7) + bj;
                    const int col0 = bcol + bj * HALF + wc * 32 + fq * 8;
                    const f32x4 v0 = acc[ai][bj][m][0] * rs, v1 = acc[ai][bj][m][1] * rs;
                    u32x4 w; w.x = pk_bf16(v0[0], v0[1]); w.y = pk_bf16(v0[2], v0[3]); w.z = pk_bf16(v1[0], v1[1]); w.w = pk_bf16(v1[2], v1[3]);
                    float sq = v0[0] * v0[0] + v0[1] * v0[1] + v0[2] * v0[2] + v0[3] * v0[3] + v1[0] * v1[0] + v1[1] * v1[1] + v1[2] * v1[2] + v1[3] * v1[3];
                    if (seg < 4) {
                        const int g = col0 >> 4, hi = col0 & 15;
                        __builtin_nontemporal_store(w, (u32x4*)(WSP(bf16_t, OFF_A2) + ((long)g * 1024 + (row >> 5)) * 640 + (row & 31) * 16 + hi));
                    } else if (seg < 7) {
                        __builtin_nontemporal_store(w, (u32x4*)(WSP(bf16_t, OFF_CQB) + (long)row * 384 + (col0 - 512)));
                    } else if (seg < 9) {
                        __builtin_nontemporal_store(w, (u32x4*)(WSP(bf16_t, OFF_CKVB) + (long)row * 256 + (col0 - 896)));
                    } else if (wc == 0) {
                        float mine[8] = {v0[0], v0[1], v0[2], v0[3], v1[0], v1[1], v1[2], v1[3]}, oth[8];
#pragma unroll
                        for (int i = 0; i < 8; ++i) oth[i] = __shfl_xor(mine[i], 32);
                        float q2 = sq; q2 += __shfl_xor(q2, 16); q2 += __shfl_xor(q2, 32);
                        if (fq == 0) ss[8 * M_TOK + row] = q2;
                        const int ib = (fq & 1) * 8;
                        float cs[8], sn[8], g1[8], g2[8], o[8];
                        ld8f(WSP(float, OFF_TAB) + (long)row * 32 + ib, cs); ld8f(WSP(float, OFF_TAB) + (long)row * 32 + 16 + ib, sn);
                        ld8f(P.qkn_k + 64 + ib, g1); ld8f(P.qkn_k + 80 + ib, g2);
#pragma unroll
                        for (int i = 0; i < 8; ++i) { const float x1 = (fq < 2 ? mine[i] : oth[i]) * g1[i], x2 = (fq < 2 ? oth[i] : mine[i]) * g2[i];
                            o[i] = fq < 2 ? (x1 * cs[i] - x2 * sn[i]) : (x1 * sn[i] + x2 * cs[i]); }
                        st8(WSP(bf16_t, OFF_KPE) + (long)row * 32 + (fq < 2 ? 0 : 16) + ib, o);
                    }
                    if (seg >= 4 && seg < 9) {
                        sq += __shfl_xor(sq, 16); sq += __shfl_xor(sq, 32);
                        if (fq == 0) unsafeAtomicAdd(ss + ATOM_OFF + (seg < 7 ? 4 : 5) * M_TOK + row, sq);
                    }
                }
            } else if constexpr (MODE == E_QRAW || MODE == E_KVRAW) {
                const float rs = (MODE == E_QRAW) ? rsqrtf(ss[4 * M_TOK + row] * (1.f / 384.f) + EPS) : rsqrtf(ss[5 * M_TOK + row] * (1.f / 256.f) + EPS);
                bf16_t* o = (MODE == E_QRAW) ? WSP(bf16_t, OFF_QRAW) : WSP(bf16_t, OFF_KVRAW);
                const int ld = (MODE == E_QRAW) ? 768 : 1024;
#pragma unroll
                for (int bj = 0; bj < 2; ++bj) {
                    const f32x4 v0 = acc[ai][bj][m][0] * rs, v1 = acc[ai][bj][m][1] * rs;
                    u32x4 w; w.x = pk_bf16(v0[0], v0[1]); w.y = pk_bf16(v0[2], v0[3]); w.z = pk_bf16(v1[0], v1[1]); w.w = pk_bf16(v1[2], v1[3]);
                    *(u32x4*)(o + (long)row * ld + bcol + bj * HALF + wc * 32 + fq * 8) = w;
                }
            } else if constexpr (MODE == E_S5E) {
                float* E = WSP(float, OFF_E) + (long)aux * 1024 * 128 + (long)row * 128 + wc * 32 + fq * 8;
                *(f32x4*)E = acc[ai][0][m][0]; *(f32x4*)(E + 4) = acc[ai][0][m][1];
            } else if constexpr (MODE == E_S5Y) {
                bf16_t* yg = (bf16_t*)P.out + (long)M_TOK * 1024;
#pragma unroll
                for (int bj = 0; bj < 2; ++bj) {
                    const int col = bcol + bj * HALF + wc * 32 + fq * 8, t = col >> 4, ho = col & 15;
                    float o[8];
#pragma unroll
                    for (int j = 0; j < 4; ++j) { const float a = acc[ai][bj][m][0][j], b = acc[ai][bj][m][1][j];
                        o[j] = a * sigmoidf_(1.5957691216f * (a + 0.044715f * a * a * a)); o[4 + j] = b * sigmoidf_(1.5957691216f * (b + 0.044715f * b * b * b)); }
                    st8(yg + ((long)row * 32 + t) * 512 + aux * 16 + ho, o);
                }
            } else if constexpr (MODE == E_GLU) {
                const bf16_t* yg = (const bf16_t*)P.out + (long)M_TOK * 1024; bf16_t* ymix = (bf16_t*)P.out;
                float sq = 0.f;
#pragma unroll
                for (int bj = 0; bj < 2; ++bj) {
                    const int col = bcol + bj * HALF + wc * 32 + fq * 8;
                    float bb[8], yy[8], o[8];
                    ld8f(P.b_glu + col, bb); ld8(yg + (long)row * 512 + col, yy);
#pragma unroll
                    for (int j = 0; j < 4; ++j) { o[j] = yy[j] * sigmoidf_(acc[ai][bj][m][0][j] + bb[j]); o[4 + j] = yy[4 + j] * sigmoidf_(acc[ai][bj][m][1][j] + bb[4 + j]); }
                    st8(ymix + (long)row * 1024 + col, o);
                    sq += sq8(o);
                }
                sq += __shfl_xor(sq, 16); sq += __shfl_xor(sq, 32);
                if (fq == 0) unsafeAtomicAdd(ss + ATOM_OFF + 6 * M_TOK + row, sq);
            } else if constexpr (MODE == E_PP) {
                bf16_t* pp = WSP(bf16_t, OFF_PP);
#pragma unroll
                for (int bj = 0; bj < 2; ++bj) {
                    const f32x4 v0 = acc[ai][bj][m][0], v1 = acc[ai][bj][m][1];
                    u32x4 w; w.x = pk_bf16(v0[0], v0[1]); w.y = pk_bf16(v0[2], v0[3]); w.z = pk_bf16(v1[0], v1[1]); w.w = pk_bf16(v1[2], v1[3]);
                    *(u32x4*)(pp + (long)row * 1024 + bcol + bj * HALF + wc * 32 + fq * 8) = w;
                }
            } else if constexpr (MODE == E_PLE) {
                const float rs = rsqrtf(ss[3 * M_TOK + row] * (1.f / 1024.f) + EPS);
                const bf16_t* pp = WSP(bf16_t, OFF_PP); const bf16_t* hb = WSP(bf16_t, OFF_HB);
#pragma unroll
                for (int bj = 0; bj < 2; ++bj) {
                    const int col = bcol + bj * HALF + wc * 32 + fq * 8;
                    float h8[8], p8[8];
                    ld8(hb + (long)row * DM + col, h8); ld8(pp + (long)row * 1024 + col, p8);
                    f32x4 o0, o1;
#pragma unroll
                    for (int j = 0; j < 4; ++j) { o0[j] = h8[j] + sigmoidf_(acc[ai][bj][m][0][j] * rs) * p8[j]; o1[j] = h8[4 + j] + sigmoidf_(acc[ai][bj][m][1][j] * rs) * p8[4 + j]; }
                    *(f32x4*)(P.out + (long)row * DM + col) = o0; *(f32x4*)(P.out + (long)row * DM + col + 4) = o1;
                }
            }
        }
}

__device__ __forceinline__ void epilogue_kv(const f32x4 (&acc)[2][2][4][2], const Params& P, int brow, int bcol) {
    int tid_ = threadIdx.x; asm volatile("" : "+v"(tid_));
    const int wid = tid_ >> 6, lane = tid_ & 63, wr = wid >> 2, wc = wid & 3, fr = lane & 15, fq = lane >> 4;
    const float* ss = WSP(float, OFF_SS);
    float* exch = (float*)((char*)shm + 32768);
    if (wc < 2) {
#pragma unroll
        for (int ai = 0; ai < 2; ++ai)
#pragma unroll
            for (int m = 0; m < 4; ++m) {
                const int rl = ai * HALF + wr * 64 + m * 16 + fr;
                const float rs = rsqrtf(ss[5 * M_TOK + brow + rl] * (1.f / 256.f) + EPS);
#pragma unroll
                for (int bj = 0; bj < 2; ++bj) {
                    float sq = 0.f;
#pragma unroll
                    for (int n = 0; n < 2; ++n) { const f32x4 v = acc[ai][bj][m][n] * rs; sq += v[0] * v[0] + v[1] * v[1] + v[2] * v[2] + v[3] * v[3]; }
                    sq += __shfl_xor(sq, 16); sq += __shfl_xor(sq, 32);
                    if (fq == 0) exch[(rl * 2 + bj) * 2 + wc] = sq;
                }
            }
    }
    __syncthreads();
#pragma unroll
    for (int ai = 0; ai < 2; ++ai)
#pragma unroll
        for (int m = 0; m < 4; ++m) {
            const int rl = ai * HALF + wr * 64 + m * 16 + fr, row = brow + rl, b = row >> 12, l = row & 4095;
            const float rs = rsqrtf(ss[5 * M_TOK + row] * (1.f / 256.f) + EPS), pe = ss[8 * M_TOK + row];
#pragma unroll
            for (int bj = 0; bj < 2; ++bj) {
                const int h = (bcol >> 7) + bj;
                const float rk = rsqrtf((exch[(rl * 2 + bj) * 2] + exch[(rl * 2 + bj) * 2 + 1] + pe) * (1.f / 96.f) + EPS);
                bf16_t* kf = WSP(bf16_t, OFF_HBUF) + ((long)(b * 8 + h) * SEQ + l) * 96;
                if (wc < 2) {
                    const f32x4 v0 = acc[ai][bj][m][0] * (rs * rk), v1 = acc[ai][bj][m][1] * (rs * rk);
                    u32x4 w; w.x = pk_bf16(v0[0], v0[1]); w.y = pk_bf16(v0[2], v0[3]); w.z = pk_bf16(v1[0], v1[1]); w.w = pk_bf16(v1[2], v1[3]);
                    *(u32x4*)(kf + wc * 32 + fq * 8) = w;
                } else {
                    const f32x4 v0 = acc[ai][bj][m][0] * rs, v1 = acc[ai][bj][m][1] * rs;
                    u32x4 w; w.x = pk_bf16(v0[0], v0[1]); w.y = pk_bf16(v0[2], v0[3]); w.z = pk_bf16(v1[0], v1[1]); w.w = pk_bf16(v1[2], v1[3]);
                    *(u32x4*)(WSP(bf16_t, OFF_KVRAW) + (long)row * 1024 + bcol + bj * HALF + wc * 32 + fq * 8) = w;
                    if (wc == 2 + bj) {
                        float kv[8]; ld8(WSP(bf16_t, OFF_KPE) + (long)row * 32 + fq * 8, kv);
#pragma unroll
                        for (int i = 0; i < 8; ++i) kv[i] *= rk;
                        st8(kf + 64 + fq * 8, kv);
                    }
                }
            }
        }
}

namespace pg8 {
#define PG8_LAS __attribute__((address_space(3)))
typedef unsigned short bf16_t;
typedef short bf16x8 __attribute__((ext_vector_type(8)));
typedef float f32x4 __attribute__((ext_vector_type(4)));
typedef unsigned u32x4 __attribute__((ext_vector_type(4)));
constexpr int BM = 256, BK = 64, HALF = 128, HTB = HALF * BK * 2  , STAGE_BYTES = 8 * HTB, NXCD = 8, WGM = 8;

__host__ __device__ __forceinline__ int lds_byte(int r, int c) { const int st = (r >> 4) * 2 + (c >> 5), rr = r & 15, cc = c & 31, ob = rr * 64 + cc * 2; return st * 1024 + (ob ^ (((ob >> 9) & 1) << 5)); }
__host__ __device__ __forceinline__ void stage_rc(int b, int& R, int& C) { const int st = b / 1024, sb = b % 1024, swz = sb ^ (((sb >> 9) & 1) << 5); R = (st >> 1) * 16 + swz / 64; C = (st & 1) * 32 + (swz % 64) / 2; }
__host__ __device__ __forceinline__ int perm32(int rho) { const int n = rho >> 4, i = rho & 15; return 8 * (i >> 2) + 4 * n + (i & 3); }

struct Unit { int pm, pn; };
struct Gemm { const bf16_t* A; const bf16_t* Bt; int M, N, K; };

struct StaticOrder {
    int nM, nN, nwg, G, c;
    __host__ __device__ void init(int M, int N, int G_, int c_) { nM = M / BM; nN = N / BM; nwg = nM * nN; G = G_; c = c_; }
    __host__ __device__ bool next(int i, Unit& u) const {
        const long L = (long)i * G + c; if (L >= nwg) return false;
        int wgid = (int)L; { const int q = nwg / NXCD, r = nwg % NXCD, xcd = wgid % NXCD, off = wgid / NXCD; wgid = (xcd < r ? xcd * (q + 1) : r * (q + 1) + (xcd - r) * q) + off; }
        const int nig = WGM * nN, gid = wgid / nig, fm = gid * WGM, gsz = (nM - fm) < WGM ? (nM - fm) : WGM;
        u.pm = fm + ((wgid % nig) % gsz); u.pn = (wgid % nig) / gsz; return true;
    }
    __device__ __forceinline__ void a_ready(const Unit&) const {}
    __device__ __forceinline__ void done(const Unit&) const {}
};
template <class Epi, class Sched, bool ALIGN_EPI = false, bool SP2 = false>
__device__ __forceinline__ void gemm_phase(PG8_LAS unsigned char* lds, const Gemm g, const Sched& S, const Epi& E) {
    int tid = threadIdx.x; asm volatile("" : "+v"(tid));
    const int wid = __builtin_amdgcn_readfirstlane(tid >> 6), lane = tid & 63, wr = wid >> 2, wc = wid & 3, fr = lane & 15, fq = lane >> 4;
    const int K = g.K, nt = K / BK;
    unsigned voffA[2], voffB[2];
#pragma unroll
    for (int i = 0; i < 2; ++i) { int R, C; stage_rc(tid * 16 + i * 8192, R, C); const int Rb = Epi::PERM ? ((R & ~31) + perm32(R & 31)) : R;
        voffA[i] = (unsigned)(R * K + C) * 2u; voffB[i] = (unsigned)(Rb * K + C) * 2u; }
    const size_t kstep = (size_t)(BK * 2);
    const size_t hstep = (size_t)HALF * K * 2;
    const size_t tstep = 2 * hstep;
    const unsigned ldsw = (unsigned)wid * 1024u;
    const int aoff = lds_byte(wr * 64 + fr, fq * 8), boff = lds_byte(wc * 32 + fr, fq * 8);
#define PG8_SA(b, h) (((b) * 2 + (h)) * HTB)
#define PG8_SB(b, h) ((4 + (b) * 2 + (h)) * HTB)
#define PG8_STAGE(bufoff, gbase, voff) do { _Pragma("unroll") for (int _i = 0; _i < 2; ++_i) \
        __builtin_amdgcn_global_load_lds((const unsigned*)((const char*)(gbase) + (voff)[_i]), (PG8_LAS unsigned*)(lds + (bufoff) + ldsw + _i * 8192), 16, 0, 0); } while (0)
#define PG8_LDA(dst, b, h) do { _Pragma("unroll") for (int m = 0; m < 4; ++m) _Pragma("unroll") for (int k = 0; k < 2; ++k) dst[m][k] = *(const PG8_LAS bf16x8*)(lds + PG8_SA(b, h) + aoff + m * 2048 + k * 1024); } while (0)
#define PG8_LDB(dst, b, h) do { _Pragma("unroll") for (int n = 0; n < 2; ++n) _Pragma("unroll") for (int k = 0; k < 2; ++k) dst[n][k] = *(const PG8_LAS bf16x8*)(lds + PG8_SB(b, h) + boff + n * 2048 + k * 1024); } while (0)
#define PG8_MMA(ai, bj, At, Bt) do { __builtin_amdgcn_s_setprio(1); _Pragma("unroll") for (int m = 0; m < 4; ++m) _Pragma("unroll") for (int n = 0; n < 2; ++n) _Pragma("unroll") for (int k = 0; k < 2; ++k) \
        acc[ai][bj][m][n] = __builtin_amdgcn_mfma_f32_16x16x32_bf16(Bt[n][k], At[m][k], acc[ai][bj][m][n], 0, 0, 0); __builtin_amdgcn_s_setprio(0); } while (0)
#define PG8_WAIT_V(n) asm volatile("s_waitcnt vmcnt(" #n ")" ::: "memory")
#define PG8_WAIT_L(n) asm volatile("s_waitcnt lgkmcnt(" #n ")" ::: "memory")
#define PG8_BAR __builtin_amdgcn_s_barrier()
#define PG8_SCHED __builtin_amdgcn_sched_barrier(0)
    Unit cur, nxt; int ui = 0;
    if (!S.next(0, cur)) return;
    f32x4 acc[2][2][4][2];
#pragma unroll
    for (int a = 0; a < 2; ++a)
#pragma unroll
        for (int b = 0; b < 2; ++b)
#pragma unroll
            for (int m = 0; m < 4; ++m)
#pragma unroll
                for (int n = 0; n < 2; ++n) acc[a][b][m][n] = (f32x4){0.f, 0.f, 0.f, 0.f};
    bf16x8 At[4][2], B0[2][2], B1[2][2];
    const char* cA = (const char*)g.A + (size_t)cur.pm * tstep; const char* cB = (const char*)g.Bt + (size_t)cur.pn * tstep;
    S.a_ready(cur);
    if constexpr (SP2) {
        PG8_STAGE(PG8_SB(0, 0), cB, voffB); PG8_STAGE(PG8_SB(0, 1), cB + hstep, voffB); PG8_STAGE(PG8_SA(0, 0), cA, voffA); PG8_STAGE(PG8_SA(0, 1), cA + hstep, voffA);
        if (wr == 1) PG8_BAR;
        PG8_WAIT_V(2); PG8_BAR;
        PG8_STAGE(PG8_SB(1, 0), cB + kstep, voffB); PG8_STAGE(PG8_SA(1, 0), cA + kstep, voffA); PG8_STAGE(PG8_SB(1, 1), cB + hstep + kstep, voffB);
        PG8_WAIT_V(6); PG8_BAR;
    } else {
        PG8_STAGE(PG8_SB(0, 0), cB, voffB); PG8_STAGE(PG8_SA(0, 0), cA, voffA); PG8_STAGE(PG8_SB(0, 1), cB + hstep, voffB); PG8_STAGE(PG8_SA(0, 1), cA + hstep, voffA);
        if (wr == 1) PG8_BAR;
        PG8_WAIT_V(4); PG8_BAR;
        PG8_STAGE(PG8_SB(1, 0), cB + kstep, voffB); PG8_STAGE(PG8_SA(1, 0), cA + kstep, voffA); PG8_STAGE(PG8_SB(1, 1), cB + hstep + kstep, voffB);
        PG8_WAIT_V(6); PG8_BAR;
    }
    for (;;) {
        const bool has_next = S.next(ui + 1, nxt);
        const char* nA = has_next ? (const char*)g.A + (size_t)nxt.pm * tstep : cA; const char* nB = has_next ? (const char*)g.Bt + (size_t)nxt.pn * tstep : cB;
        for (int t = 0; t < nt; t += 2) {
            const bool last = (t == nt - 2);
            const char* a1 = cA + (size_t)(t + 1) * kstep;
            const char* a2 = last ? nA : cA + (size_t)(t + 2) * kstep; const char* b2 = last ? nB : cB + (size_t)(t + 2) * kstep;
            const char* a3 = a2 + kstep; const char* b3 = b2 + kstep;
            if (last && has_next) S.a_ready(nxt);
            if constexpr (SP2) {
            PG8_LDB(B0, 0, 0); PG8_LDB(B1, 0, 1); PG8_SCHED; PG8_LDA(At, 0, 0); PG8_STAGE(PG8_SA(1, 1), a1 + hstep, voffA);
            PG8_WAIT_V(8); PG8_WAIT_L(0); PG8_BAR; PG8_MMA(0, 0, At, B0); PG8_MMA(0, 1, At, B1); PG8_BAR; PG8_SCHED;
            PG8_LDA(At, 0, 1); PG8_STAGE(PG8_SB(0, 0), b2, voffB); PG8_STAGE(PG8_SB(0, 1), b2 + hstep, voffB); PG8_STAGE(PG8_SA(0, 0), a2, voffA);
            PG8_WAIT_V(8); PG8_WAIT_L(0); PG8_BAR; PG8_MMA(1, 0, At, B0); PG8_MMA(1, 1, At, B1); PG8_BAR; PG8_SCHED;
            PG8_LDB(B0, 1, 0); PG8_LDB(B1, 1, 1); PG8_SCHED; PG8_LDA(At, 1, 0); PG8_STAGE(PG8_SA(0, 1), a2 + hstep, voffA);
            PG8_WAIT_V(8); PG8_WAIT_L(0); PG8_BAR; PG8_MMA(0, 0, At, B0); PG8_MMA(0, 1, At, B1); PG8_BAR; PG8_SCHED;
            PG8_LDA(At, 1, 1); PG8_STAGE(PG8_SB(1, 0), b3, voffB); PG8_STAGE(PG8_SB(1, 1), b3 + hstep, voffB); PG8_STAGE(PG8_SA(1, 0), a3, voffA);
            PG8_WAIT_V(8); PG8_WAIT_L(0); PG8_BAR; PG8_MMA(1, 0, At, B0); PG8_MMA(1, 1, At, B1); PG8_BAR; PG8_SCHED;
            } else {
            PG8_LDB(B0, 0, 0); PG8_SCHED; PG8_LDA(At, 0, 0); PG8_STAGE(PG8_SA(1, 1), a1 + hstep, voffA);
            PG8_WAIT_L(8); PG8_BAR; PG8_WAIT_L(0); PG8_MMA(0, 0, At, B0); PG8_BAR; PG8_SCHED;
            PG8_LDB(B1, 0, 1); PG8_STAGE(PG8_SB(0, 0), b2, voffB);
            PG8_BAR; PG8_WAIT_L(0); PG8_MMA(0, 1, At, B1); PG8_BAR;
            PG8_LDA(At, 0, 1); PG8_STAGE(PG8_SA(0, 0), a2, voffA);
            PG8_BAR; PG8_WAIT_L(0); PG8_MMA(1, 0, At, B0); PG8_BAR; PG8_SCHED;
            PG8_STAGE(PG8_SB(0, 1), b2 + hstep, voffB);
            PG8_WAIT_V(6); PG8_BAR; PG8_MMA(1, 1, At, B1); PG8_BAR;
            PG8_LDB(B0, 1, 0); PG8_SCHED; PG8_LDA(At, 1, 0); PG8_STAGE(PG8_SA(0, 1), a2 + hstep, voffA);
            PG8_WAIT_L(8); PG8_BAR; PG8_WAIT_L(0); PG8_MMA(0, 0, At, B0); PG8_BAR; PG8_SCHED;
            PG8_LDB(B1, 1, 1); PG8_STAGE(PG8_SB(1, 0), b3, voffB);
            PG8_BAR; PG8_WAIT_L(0); PG8_MMA(0, 1, At, B1); PG8_BAR;
            PG8_LDA(At, 1, 1); PG8_STAGE(PG8_SA(1, 0), a3, voffA);
            PG8_BAR; PG8_WAIT_L(0); PG8_MMA(1, 0, At, B0); PG8_BAR; PG8_SCHED;
            PG8_STAGE(PG8_SB(1, 1), b3 + hstep, voffB);
            PG8_WAIT_V(6); PG8_BAR; PG8_MMA(1, 1, At, B1); PG8_BAR;
            }
        }
        if constexpr (ALIGN_EPI) { if (wr == 0) PG8_BAR; }
        if constexpr (!Epi::AFTER_DRAIN) { E(acc, cur, wr, wc, fr, fq); S.done(cur); }
        if (!has_next) break;
#pragma unroll
        for (int a = 0; a < 2; ++a)
#pragma unroll
            for (int b = 0; b < 2; ++b)
#pragma unroll
                for (int m = 0; m < 4; ++m)
#pragma unroll
                    for (int n = 0; n < 2; ++n) acc[a][b][m][n] = (f32x4){0.f, 0.f, 0.f, 0.f};
        cur = nxt; cA = nA; cB = nB; ++ui;
        if constexpr (ALIGN_EPI) { if (wr == 1) PG8_BAR; }
    }
    PG8_WAIT_V(0);
    if constexpr (!ALIGN_EPI) { if (wr == 0) PG8_BAR; }
    PG8_BAR;
    if constexpr (Epi::AFTER_DRAIN) { E.fused(acc, cur, wr, wc, fr, fq, lds, wid, lane); S.done(cur); }
#undef PG8_SA
#undef PG8_SB
#undef PG8_STAGE
#undef PG8_LDA
#undef PG8_LDB
#undef PG8_MMA
#undef PG8_WAIT_V
#undef PG8_WAIT_L
#undef PG8_BAR
#undef PG8_SCHED
}
}

template <int MODE> struct EpiAd {
    static constexpr bool PERM = true, AFTER_DRAIN = false;
    const Params& P; int aux;
    __device__ __forceinline__ void operator()(const f32x4 (&acc)[2][2][4][2], const pg8::Unit& u, int, int, int, int) const { epilogue<MODE>(acc, P, u.pm * 256, u.pn * 256, aux); }
};
template <int MODE> __device__ __forceinline__ void stream_gemm(const Params& P, const bf16_t* A, const bf16_t* Bt, int N, int K, int aux) {
    pg8::Gemm g; g.A = A; g.Bt = Bt; g.M = M_TOK; g.N = N; g.K = K;
    pg8::StaticOrder S; S.init(M_TOK, N, (int)gridDim.x, (int)blockIdx.x);
    const EpiAd<MODE> E{P, aux};
    pg8::gemm_phase<EpiAd<MODE>, pg8::StaticOrder, true, true>((PG8_LAS unsigned char*)shm, g, S, E);
}

struct WtDesc { const float* W; const float* g1; const float* g2; bf16_t* out; int N, ksplit, ldo, mode, k0, n0; };
__device__ __forceinline__ WtDesc wt_desc(const Params& P, int task) {
    WtDesc d; int tile;
    if (task < 2112) { const int wsel = task / 352; tile = task % 352; const int f2 = wsel >= 3, k = wsel % 3;
        const float* nf = f2 ? P.norm_ffn2 : P.norm_ffn1;
        if (k == 2) { d.W = f2 ? P.w2d : P.w1d; d.N = 1024; d.g1 = nullptr; d.g2 = nullptr; d.ksplit = 0; d.out = WSP(bf16_t, f2 ? OFF_WD2 : OFF_WD1); d.ldo = 2816; d.mode = 0; }
        else { d.W = k == 0 ? (f2 ? P.w2g : P.w1g) : (f2 ? P.w2u : P.w1u); d.N = 2816; d.g1 = nf; d.g2 = nf; d.ksplit = 1024; d.out = WSP(bf16_t, f2 ? OFF_W2 : OFF_W1); d.ldo = 1024; d.mode = k == 0 ? 1 : 2; }
    } else if (task < 2272) { tile = task - 2112; d.W = P.w_in; d.N = 1184; d.g1 = P.norm_mix; d.g2 = P.norm_mix; d.ksplit = 1024; d.out = WSP(bf16_t, OFF_WIN); d.ldo = 1024; d.mode = 0; }
    else if (task < 2308) { tile = task - 2272; d.W = P.w_uq; d.N = 768; d.g1 = P.q_norm; d.g2 = P.q_norm; d.ksplit = 384; d.out = WSP(bf16_t, OFF_WUQ); d.ldo = 384; d.mode = 0; }
    else if (task < 2340) { tile = task - 2308; d.W = P.w_ukv; d.N = 1024; d.g1 = P.kv_norm; d.g2 = P.kv_norm; d.ksplit = 256; d.out = WSP(bf16_t, OFF_WUKV); d.ldo = 256; d.mode = 0; }
    else if (task < 2372) { tile = task - 2340; d.W = P.w_glu; d.N = 512; d.g1 = nullptr; d.g2 = nullptr; d.ksplit = 0; d.out = WSP(bf16_t, OFF_WGLU); d.ldo = 512; d.mode = 0; }
    else if (task < 2500) { tile = task - 2372; d.W = P.w_out; d.N = 1024; d.g1 = P.on_ssm; d.g2 = P.on_att; d.ksplit = 512; d.out = WSP(bf16_t, OFF_WOUT); d.ldo = 1024; d.mode = 0; }
    else if (task < 2628) { tile = task - 2500; d.W = P.w_pg; d.N = 1024; d.g1 = P.norm_ple; d.g2 = P.norm_ple; d.ksplit = 1024; d.out = WSP(bf16_t, OFF_WPG); d.ldo = 1024; d.mode = 0; }
    else { tile = task - 2628; d.W = P.w_pp; d.N = 1024; d.g1 = nullptr; d.g2 = nullptr; d.ksplit = 0; d.out = WSP(bf16_t, OFF_WPP); d.ldo = 256; d.mode = 0; }
    const int ntn = (d.N + 127) >> 7, tk = tile / ntn, tn = tile - tk * ntn; d.k0 = tk * 64; d.n0 = tn * 128;
    return d;
}
constexpr int NWT = 2660;
__device__ __forceinline__ void wt_load(const WtDesc& d, f32x4 (&r)[4]) {
    int t = threadIdx.x; asm volatile("" : "+v"(t));
    const int n = d.n0 + (t & 31) * 4;
#pragma unroll
    for (int i = 0; i < 4; ++i) {
        const int kk = d.k0 + (t >> 5) + 16 * i;
        f32x4 v = {0.f, 0.f, 0.f, 0.f};
        if (n < d.N) { v = __builtin_nontemporal_load((const f32x4*)(d.W + (long)kk * d.N + n)); if (d.g1) v *= (kk < d.ksplit ? d.g1[kk] : d.g2[kk - d.ksplit]); }
        r[i] = v;
    }
}
__device__ __forceinline__ void wt_store(const WtDesc& d, const f32x4 (&r)[4]) {
    float* tl = (float*)shm;
    int t = threadIdx.x; asm volatile("" : "+v"(t));
#pragma unroll
    for (int i = 0; i < 4; ++i) { float* q = tl + ((t >> 5) + 16 * i) * 129 + (t & 31) * 4; q[0] = r[i][0]; q[1] = r[i][1]; q[2] = r[i][2]; q[3] = r[i][3]; }
    __syncthreads();
#pragma unroll
    for (int i = 0; i < 2; ++i) {
        const int n = (t >> 3) + 64 * i, kc = (t & 7) * 8, nn = d.n0 + n;
        if (nn < d.N) {
            const int orow = d.mode == 0 ? nn : ((nn >> 7) * 256 + (d.mode == 2 ? 128 : 0) + (nn & 127));
            u32x4 w;
            w.x = pk_bf16(tl[(kc + 0) * 129 + n], tl[(kc + 1) * 129 + n]); w.y = pk_bf16(tl[(kc + 2) * 129 + n], tl[(kc + 3) * 129 + n]);
            w.z = pk_bf16(tl[(kc + 4) * 129 + n], tl[(kc + 5) * 129 + n]); w.w = pk_bf16(tl[(kc + 6) * 129 + n], tl[(kc + 7) * 129 + n]);
            *(u32x4*)(d.out + (long)orow * d.ldo + d.k0 + kc) = w;
        }
    }
    __syncthreads();
}

struct S5Mode { float lr, li, dt, cr, ci; };
__device__ __forceinline__ S5Mode s5_mode(const Params& P, int g, int p) {
    S5Mode m; m.lr = P.lam_re[g * 64 + p]; m.li = P.lam_im[g * 64 + p]; m.dt = __expf(P.log_dt[g]);
    float c, s; cisf(m.li * m.dt, c, s); const float e = __expf(m.lr * m.dt);
    const float nr = e * c - 1.f, ni = e * s, den = 1.f / (m.lr * m.lr + m.li * m.li);
    m.cr = (nr * m.lr + ni * m.li) * den; m.ci = (ni * m.lr - nr * m.li) * den;
    return m;
}
__device__ __forceinline__ void s5_pow(const S5Mode& m, float tau, float& zr, float& zi) {
    float c, s; cisf(m.li * m.dt * tau, c, s); const float e = __expf(m.lr * m.dt * tau); zr = e * c; zi = e * s;
}

__constant__ float c_inv_freq[16] = {1.0f, 0.5623413251903491f, 0.31622776601683794f, 0.1778279410038923f, 0.1f, 0.05623413251903491f, 0.03162277660168379f, 0.01778279410038923f,
    0.01f, 0.005623413251903491f, 0.0031622776601683794f, 0.0017782794100389228f, 0.001f, 0.0005623413251903491f, 0.00031622776601683794f, 0.00017782794100389227f};

typedef short s16x4 __attribute__((ext_vector_type(4)));
__device__ __forceinline__ u32x4 scale8(u32x4 w, float s) { u32x4 o;
    o.x = pk_bf16(bf_lo(w.x) * s, bf_hi(w.x) * s); o.y = pk_bf16(bf_lo(w.y) * s, bf_hi(w.y) * s); o.z = pk_bf16(bf_lo(w.z) * s, bf_hi(w.z) * s); o.w = pk_bf16(bf_lo(w.w) * s, bf_hi(w.w) * s); return o; }
__device__ __forceinline__ void attn_item(const Params& P, int bh, int qb) {
    int tid = threadIdx.x; asm volatile("" : "+v"(tid));
    const int w = tid >> 6, lane = tid & 63, l32 = lane & 31, hi = lane >> 5;
    const int b = bh >> 3, h = bh & 7;
    const bf16_t* kvraw = WSP(bf16_t, OFF_KVRAW) + (long)b * SEQ * 1024 + h * 128;
    const bf16_t* kfp = WSP(bf16_t, OFF_HBUF) + (long)bh * SEQ * 96;
    LAS unsigned char* lds = (LAS unsigned char*)shm;
    const int wq = __builtin_amdgcn_readfirstlane(w);
    const int q0 = qb * 256, qrow = q0 + w * 32 + l32, wmin = q0 + wq * 32;
    bf16x8 qf[6];
    {
        const long tokq = (long)b * SEQ + qrow;
        const bf16_t* qr = WSP(bf16_t, OFF_QRAW) + tokq * 768 + h * 96 + hi * 8;
        float qv[6][8]; float sq = 0.f;
#pragma unroll
        for (int ks = 0; ks < 6; ++ks) { ld8(qr + ks * 16, qv[ks]); sq += sq8(qv[ks]); }
        sq += __shfl_xor(sq, 32);
        const float rs = rsqrtf(sq * (1.f / 96.f) + EPS), qs = 0.10206207261596575f * 1.4426950408889634f;
        float cs[8], sn[8];
        ld8f(WSP(float, OFF_TAB) + tokq * 32 + hi * 8, cs); ld8f(WSP(float, OFF_TAB) + tokq * 32 + 16 + hi * 8, sn);
#pragma unroll
        for (int ks = 0; ks < 4; ++ks) { float g[8], gk[8]; ld8f(P.qkn_q + ks * 16 + hi * 8, g); ld8f(P.qkn_k + ks * 16 + hi * 8, gk);
#pragma unroll
            for (int i = 0; i < 8; ++i) qv[ks][i] *= rs * g[i] * gk[i] * qs; }
        { float g1[8], g2[8]; ld8f(P.qkn_q + 64 + hi * 8, g1); ld8f(P.qkn_q + 80 + hi * 8, g2);
#pragma unroll
            for (int i = 0; i < 8; ++i) { const float x1 = qv[4][i] * rs * g1[i] * qs, x2 = qv[5][i] * rs * g2[i] * qs; qv[4][i] = x1 * cs[i] - x2 * sn[i]; qv[5][i] = x1 * sn[i] + x2 * cs[i]; } }
#pragma unroll
        for (int ks = 0; ks < 6; ++ks) { union { bf16x8 v; unsigned u[4]; } t;
#pragma unroll
            for (int i = 0; i < 4; ++i) t.u[i] = pk_bf16(qv[ks][2 * i], qv[ks][2 * i + 1]);
            qf[ks] = t.v; }
    }
    f32x16 o0, o1;
#pragma unroll
    for (int r = 0; r < 16; ++r) { o0[r] = 0.f; o1[r] = 0.f; }
    f32x16 lacc;
#pragma unroll
    for (int r = 0; r < 16; ++r) lacc[r] = 0.f;
    bf16x8 ones8;
#pragma unroll
    for (int i = 0; i < 8; ++i) ones8[i] = (short)0x3F80;
    const int nkt = 4 * (qb + 1);
    constexpr int KSLOT = 12288, VSLOT = 8192, VRING = 3 * KSLOT;
    int kga0, kga1, vga;
    { const int p0 = 64 * wq + lane, k0_ = p0 / 12, c0_ = p0 - 12 * k0_; const int cc0 = (c0_ - ((k0_ >> 2) & 3) + 12) % 12; kga0 = k0_ * 96 + cc0 * 8;
      const int p1 = 64 * ((wq & 3) + 8) + lane, k1_ = p1 / 12, c1_ = p1 - 12 * k1_; const int cc1 = (c1_ - ((k1_ >> 2) & 3) + 12) % 12; kga1 = k1_ * 96 + cc1 * 8;
      const int vkey = 8 * wq + (lane >> 3), vc = (lane & 7) ^ (((vkey >> 1) & 1) << 1); vga = vkey * 1024 + 64 + vc * 8; }
#define ATT_DMA_K(kt_, slot_) do { const bf16_t* g_ = kfp + (long)(kt_) * 64 * 96; \
        __builtin_amdgcn_global_load_lds((const unsigned*)(g_ + kga0), (LAS unsigned*)(lds + (slot_) * KSLOT + wq * 1024), 16, 0, 0); \
        if (wq < 4) __builtin_amdgcn_global_load_lds((const unsigned*)(g_ + kga1), (LAS unsigned*)(lds + (slot_) * KSLOT + (wq + 8) * 1024), 16, 0, 0); } while (0)
#define ATT_DMA_V(kt_, slot_) do { const bf16_t* g_ = kvraw + (long)(kt_) * 64 * 1024; \
        __builtin_amdgcn_global_load_lds((const unsigned*)(g_ + vga), (LAS unsigned*)(lds + VRING + (slot_) * VSLOT + wq * 1024), 16, 0, 0); } while (0)
    int koff[6];
#pragma unroll
    for (int ks = 0; ks < 6; ++ks) koff[ks] = (l32 * 12 + ((2 * ks + hi + ((l32 >> 2) & 3)) % 12)) * 16;
    const int g16 = lane >> 4, dhalf = g16 & 1, tr_r = (lane & 15) >> 2, tr_c = lane & 3;
    const int vtr_off = (4 * hi + tr_r) * 128 + (((dhalf ^ ((tr_r >> 1) & 1)) * 2 + (tr_c >> 1)) * 16) + (tr_c & 1) * 8;
    const unsigned lds_base = (unsigned)(unsigned long long)lds;
#define TR_RD(dst, addr, off) asm volatile("ds_read_b64_tr_b16 %0, %1 offset:" #off : "=v"(dst) : "v"(addr))
#define QK_TILE(S0, S1, kslot_) do { bf16x8 kf[12]; const LAS unsigned char* kb_ = lds + (kslot_) * KSLOT; \
        _Pragma("unroll") for (int ks = 0; ks < 6; ++ks) { kf[2 * ks] = *(const LAS bf16x8*)(kb_ + koff[ks]); kf[2 * ks + 1] = *(const LAS bf16x8*)(kb_ + koff[ks] + 6144); } \
        __builtin_amdgcn_sched_barrier(0); \
        _Pragma("unroll") for (int r = 0; r < 16; ++r) { S0[r] = 0.f; S1[r] = 0.f; } \
        __builtin_amdgcn_s_setprio(1); \
        _Pragma("unroll") for (int ks = 0; ks < 6; ++ks) { \
            S0 = __builtin_amdgcn_mfma_f32_32x32x16_bf16(kf[2 * ks], qf[ks], S0, 0, 0, 0); \
            S1 = __builtin_amdgcn_mfma_f32_32x32x16_bf16(kf[2 * ks + 1], qf[ks], S1, 0, 0, 0); } \
        __builtin_amdgcn_s_setprio(0); \
        __builtin_amdgcn_sched_barrier(0); } while (0)
#define ATT_BODY(KT, GEN) do { const int kt = (KT); \
        { const int ktn = kt + 2 < nkt ? kt + 2 : nkt - 1; ATT_DMA_K(ktn, s2_); ATT_DMA_V(ktn, s2_); } \
        if (!(GEN) || kt * 64 <= wmin + 31) { \
            f32x16 S0, S1; \
            QK_TILE(S0, S1, s0_); \
            const unsigned vb = lds_base + VRING + s0_ * VSLOT + vtr_off; \
            s16x4 vf[16]; \
            TR_RD(vf[0], vb, 0); TR_RD(vf[1], vb, 1024); TR_RD(vf[2], vb, 64); TR_RD(vf[3], vb, 1088); \
            TR_RD(vf[4], vb, 2048); TR_RD(vf[5], vb, 3072); TR_RD(vf[6], vb, 2112); TR_RD(vf[7], vb, 3136); \
            TR_RD(vf[8], vb, 4096); TR_RD(vf[9], vb, 5120); TR_RD(vf[10], vb, 4160); TR_RD(vf[11], vb, 5184); \
            TR_RD(vf[12], vb, 6144); TR_RD(vf[13], vb, 7168); TR_RD(vf[14], vb, 6208); TR_RD(vf[15], vb, 7232); \
            __builtin_amdgcn_sched_barrier(0); \
            if ((GEN) && kt * 64 + 63 > wmin) { \
                _Pragma("unroll") for (int r = 0; r < 16; ++r) { \
                    const int key = kt * 64 + 8 * (r >> 2) + 4 * hi + (r & 3); \
                    if (key > qrow) S0[r] = -1e30f; \
                    if (key + 32 > qrow) S1[r] = -1e30f; } } \
              \
              \
            _Pragma("unroll") for (int r = 0; r < 16; ++r) { S0[r] = __builtin_amdgcn_exp2f(S0[r]); S1[r] = __builtin_amdgcn_exp2f(S1[r]); } \
            asm volatile("s_waitcnt lgkmcnt(0)" : "+v"(vf[0]), "+v"(vf[1]), "+v"(vf[2]), "+v"(vf[3]), "+v"(vf[4]), "+v"(vf[5]), "+v"(vf[6]), "+v"(vf[7]), \
                         "+v"(vf[8]), "+v"(vf[9]), "+v"(vf[10]), "+v"(vf[11]), "+v"(vf[12]), "+v"(vf[13]), "+v"(vf[14]), "+v"(vf[15]) :: "memory"); \
            _Pragma("unroll") for (int q = 0; q < 4; ++q) { \
                union { bf16x8 v; unsigned u[4]; } pf; \
                _Pragma("unroll") for (int i = 0; i < 4; ++i) pf.u[i] = (q >> 1) == 0 ? pk_bf16(S0[8 * (q & 1) + 2 * i], S0[8 * (q & 1) + 2 * i + 1]) : pk_bf16(S1[8 * (q & 1) + 2 * i], S1[8 * (q & 1) + 2 * i + 1]); \
                union { bf16x8 v; s16x4 h[2]; } va, vb2; \
                va.h[0] = vf[4 * q + 0]; va.h[1] = vf[4 * q + 1]; vb2.h[0] = vf[4 * q + 2]; vb2.h[1] = vf[4 * q + 3]; \
                o0 = __builtin_amdgcn_mfma_f32_32x32x16_bf16(va.v, pf.v, o0, 0, 0, 0); \
                o1 = __builtin_amdgcn_mfma_f32_32x32x16_bf16(vb2.v, pf.v, o1, 0, 0, 0); \
                lacc = __builtin_amdgcn_mfma_f32_32x32x16_bf16(ones8, pf.v, lacc, 0, 0, 0); } \
        } \
          \
        if (wq < 4) asm volatile("s_waitcnt vmcnt(3)" ::: "memory"); else asm volatile("s_waitcnt vmcnt(2)" ::: "memory"); \
        __builtin_amdgcn_s_barrier(); \
        { const int t_ = s0_; s0_ = s1_; s1_ = s2_; s2_ = t_; } } while (0)
    __syncthreads();
    ATT_DMA_K(0, 0); ATT_DMA_K(1, 1); ATT_DMA_V(0, 0); ATT_DMA_V(1, 1);
    asm volatile("s_waitcnt vmcnt(0)" ::: "memory");
    __builtin_amdgcn_s_barrier();
    int s0_ = 0, s1_ = 1, s2_ = 2;
    int kfull = (wmin + 1) >> 6; kfull = kfull < nkt ? kfull : nkt;
    int kti = 0;
    for (; kti < kfull; ++kti) ATT_BODY(kti, 0);
    for (; kti < nkt; ++kti) ATT_BODY(kti, 1);
    asm volatile("s_waitcnt vmcnt(0)" ::: "memory");
    __builtin_amdgcn_s_barrier();
#undef QK_TILE
#undef TR_RD
#undef ATT_BODY
#undef ATT_DMA_K
#undef ATT_DMA_V
    const float inv = 1.f / lacc[0];
    const long tok = (long)b * SEQ + qrow;
    bf16_t* ymix = ((bf16_t*)P.out) + tok * 1024 + 512 + h * 64;
    float sq = 0.f;
#pragma unroll
    for (int g4 = 0; g4 < 4; ++g4) {
        f32x4 a, c;
#pragma unroll
        for (int j = 0; j < 4; ++j) { a[j] = o0[g4 * 4 + j] * inv; c[j] = o1[g4 * 4 + j] * inv; sq += a[j] * a[j] + c[j] * c[j]; }
        store_bf4(ymix + 8 * g4 + 4 * hi, a);
        store_bf4(ymix + 32 + 8 * g4 + 4 * hi, c);
    }
    sq += __shfl_xor(sq, 32);
    if (hi == 0) unsafeAtomicAdd(WSP(float, OFF_SS) + ATOM_OFF + 7 * M_TOK + tok, sq);
}

__device__ __forceinline__ void s5_scan_task(const Params& P, int g, int b, float* T) {
    int tid = threadIdx.x; asm volatile("" : "+v"(tid));
    const int p = tid & 63, part = tid >> 6;
    const S5Mode md = s5_mode(P, g, p); float ar, ai, a16r, a16i; s5_pow(md, 32.f, ar, ai); s5_pow(md, 512.f, a16r, a16i);
    const float* E = WSP(float, OFF_E) + ((long)g * 1024 + b * 128 + part * 16) * 128;
    bf16_t* A2 = WSP(bf16_t, OFF_A2) + ((long)g * 1024 + b * 128 + part * 16) * 640 + 512;
    float er[16], ei[16], lr[16], li[16];
#pragma unroll
    for (int j = 0; j < 16; ++j) { er[j] = E[(long)j * 128 + p]; ei[j] = E[(long)j * 128 + 64 + p]; }
    float sr = 0.f, si = 0.f;
#pragma unroll
    for (int j = 0; j < 16; ++j) { lr[j] = sr; li[j] = si; const float nr = ar * sr - ai * si + er[j], ni = ar * si + ai * sr + ei[j]; sr = nr; si = ni; }
    __syncthreads();
    T[(part * 2 + 0) * 64 + p] = sr; T[(part * 2 + 1) * 64 + p] = si;
    __syncthreads();
    float wr_ = 0.f, wi_ = 0.f;
    for (int k = 0; k < part; ++k) { const float tr = T[(k * 2 + 0) * 64 + p], ti = T[(k * 2 + 1) * 64 + p]; const float nr = a16r * wr_ - a16i * wi_ + tr, ni = a16r * wi_ + a16i * wr_ + ti; wr_ = nr; wi_ = ni; }
#pragma unroll
    for (int j = 0; j < 16; ++j) {
        A2[(long)j * 640 + p] = (bf16_t)(pk_bf16(lr[j] + wr_, 0.f) & 0xffff); A2[(long)j * 640 + 64 + p] = (bf16_t)(pk_bf16(li[j] + wi_, 0.f) & 0xffff);
        const float nr = ar * wr_ - ai * wi_, ni = ar * wi_ + ai * wr_; wr_ = nr; wi_ = ni;
    }
    __syncthreads();
}

#define XB_TMO      128
#define XB_XCNT(j)  (256  + 64 * (j))
#define XB_XSUB(j)  (1280 + 64 * (j))
#define XB_XGEN(j)  (2304 + 64 * (j))
#define XB_TOP      3328
#define XB_TOPGEN   3392
#define XCD_BAR_WORDS 3456
#define XB_SPIN_CAP (1u << 18)

__device__ __forceinline__ unsigned xb_ld(unsigned* p)              { return __hip_atomic_load(p, __ATOMIC_RELAXED, __HIP_MEMORY_SCOPE_AGENT); }
__device__ __forceinline__ unsigned xb_add(unsigned* p, unsigned v) { return __hip_atomic_fetch_add(p, v, __ATOMIC_RELAXED, __HIP_MEMORY_SCOPE_AGENT); }
__device__ __forceinline__ unsigned xb_xcc_id() { return (unsigned)__builtin_amdgcn_s_getreg((3 << 11) | 20) & 0xFu; }
#define XB_SPIN(cond, bar) do { unsigned _sp = 0; while (cond) { __builtin_amdgcn_s_sleep(1); \
    if ((++_sp & 255u) == 0u) { if (xb_ld(&(bar)[XB_TMO])) break; if (_sp > XB_SPIN_CAP) { atomicAdd(&(bar)[XB_TMO], 1u); break; } } } } while (0)

struct XcdBarrier {
    unsigned* bar; unsigned x;
    volatile LAS unsigned* st;
};

__device__ __forceinline__ XcdBarrier xcd_barrier_post(unsigned* bar, volatile LAS unsigned* st) {
    XcdBarrier b; b.bar = bar; b.x = xb_xcc_id(); b.st = st;
    if (threadIdx.x == 0) (void)xb_add(&bar[XB_XCNT(b.x)], 1u);
    return b;
}
__device__ __forceinline__ void xcd_barrier_complete(unsigned* bar, unsigned x, unsigned& nloc, unsigned& nx) {
    const unsigned G = gridDim.x * gridDim.y * gridDim.z;
    unsigned sum, cnt, mine, sp = 0u;
    for (;;) {
        sum = 0u; cnt = 0u; mine = 0u;
#pragma unroll
        for (unsigned j = 0; j < 16; ++j) { const unsigned c = xb_ld(&bar[XB_XCNT(j)]); sum += c; cnt += (c > 0u) ? 1u : 0u; mine = (j == x) ? c : mine; }
        if (sum == G) break;
        __builtin_amdgcn_s_sleep(1);
        if ((++sp & 255u) == 0u) { if (xb_ld(&bar[XB_TMO])) break; if (sp > XB_SPIN_CAP) { atomicAdd(&bar[XB_TMO], 1u); break; } }
    }
    nloc = mine > 0u ? mine : 1u; nx = cnt > 0u ? cnt : 1u;
}

__device__ __forceinline__ void xcd_barrier(const XcdBarrier& b) {
    asm volatile("s_waitcnt vmcnt(0)" ::: "memory");
    __syncthreads();
    if (threadIdx.x == 0) {
        unsigned* bar = b.bar;
        __builtin_amdgcn_s_waitcnt(0);
        unsigned nloc = b.st[0], nx = b.st[1];
        if (nloc == 0u) { xcd_barrier_complete(bar, b.x, nloc, nx); b.st[0] = nloc; b.st[1] = nx; }
        const unsigned old = xb_add(&bar[XB_XSUB(b.x)], 1u);
        const unsigned gen = old / nloc;
        if (old + 1u == (gen + 1u) * nloc) {
            __builtin_amdgcn_fence(__ATOMIC_RELEASE, "agent");
            asm volatile("s_waitcnt vmcnt(0)" ::: "memory");
            const unsigned og = xb_add(&bar[XB_TOP], 1u);
            const unsigned tg = og / nx;
            if (og + 1u == (tg + 1u) * nx) xb_add(&bar[XB_TOPGEN], 1u);
            else XB_SPIN(xb_ld(&bar[XB_TOPGEN]) == tg, bar);
            __builtin_amdgcn_fence(__ATOMIC_ACQUIRE, "agent");
            xb_add(&bar[XB_XGEN(b.x)], 1u);
            asm volatile("s_waitcnt vmcnt(0)" ::: "memory");
        } else {
            XB_SPIN(xb_ld(&bar[XB_XGEN(b.x)]) == gen, bar);
            __builtin_amdgcn_fence(__ATOMIC_ACQUIRE, "agent");
            asm volatile("s_waitcnt vmcnt(0)" ::: "memory");
        }
    }
    __syncthreads();
}


__global__ void __launch_bounds__(512, 2) mega(Params P) {
    const int G = gridDim.x, cb = blockIdx.x;
    __shared__ uint4 xb_words;
    if (threadIdx.x == 0) xb_words = make_uint4(0u, 0u, 0u, 0u);
    __syncthreads();
    const XcdBarrier xbar = xcd_barrier_post((unsigned*)(P.ws + OFF_BAR), (volatile LAS unsigned*)&xb_words);
    for (int phr = P.ph_lo * 2; phr < P.ph_hi * 2; ++phr) {
        const int ph = phr >> 1;
        if ((phr & 1) && ph != PROBE_PH) continue;
        if (ph == 5) continue;
#if PROBE_PH >= 0
        __syncthreads(); if (threadIdx.x == 0) s_aoff = (phr & 1) ? (long)24 * M_TOK : 0; __syncthreads();
#endif
        if (phr > P.ph_lo * 2) { if (P.ph_lo < 0) cg::this_grid().sync(); else xcd_barrier(xbar); }
        int tid = threadIdx.x; asm volatile("" : "+v"(tid));
        if (ph == 0) {
            for (int task = cb; task < NWT; task += 2 * G) {
                const WtDesc d0 = wt_desc(P, task); f32x4 r0[4]; wt_load(d0, r0);
                const int t1 = task + G;
                if (t1 < NWT) { const WtDesc d1 = wt_desc(P, t1); f32x4 r1[4]; wt_load(d1, r1); wt_store(d0, r0); wt_store(d1, r1); }
                else wt_store(d0, r0);
            }
            constexpr int R8 = 0, R9 = R8 + 1024  , R10 = R9 + 512  , R11 = R10 + 120  , R12 = R11 + 1024  , R13 = R12 + 512  ,
                          R14 = R13 + 256  , R15 = R14 + 128  , R16 = R15 + 1  ;
            for (int task = cb; task < R16; task += G) {
                if (task < R9) {
                    const int lane = tid & 63, row0 = (task - R8) * 32 + (tid >> 6) * 4;
                    f32x4 v[4][4];
#pragma unroll
                    for (int rr = 0; rr < 4; ++rr)
#pragma unroll
                        for (int i = 0; i < 4; ++i) v[rr][i] = __builtin_nontemporal_load((const f32x4*)(P.x + (long)(row0 + rr) * DM + i * 256 + lane * 4));
#pragma unroll
                    for (int rr = 0; rr < 4; ++rr) {
                        bf16_t* xb = WSP(bf16_t, OFF_HB) + (long)(row0 + rr) * DM; float sq = 0.f;
#pragma unroll
                        for (int i = 0; i < 4; ++i) { const f32x4 a = v[rr][i]; sq += a[0] * a[0] + a[1] * a[1] + a[2] * a[2] + a[3] * a[3]; store_bf4(xb + i * 256 + lane * 4, a); }
#pragma unroll
                        for (int o = 32; o > 0; o >>= 1) sq += __shfl_xor(sq, o);
                        if (lane == 0) WSP(float, OFF_SS)[row0 + rr] = sq;
                    }
                } else if (task < R10) {
                    f32x4 a[4], b[4];
#pragma unroll
                    for (int i = 0; i < 4; ++i) { const long e = ((long)(task - R9) * 2048 + i * 512 + tid) * 8; a[i] = __builtin_nontemporal_load((const f32x4*)(P.p + e)); b[i] = __builtin_nontemporal_load((const f32x4*)(P.p + e + 4)); }
#pragma unroll
                    for (int i = 0; i < 4; ++i) { const long e = ((long)(task - R9) * 2048 + i * 512 + tid) * 8;
                        u32x4 w; w.x = pk_bf16(a[i][0], a[i][1]); w.y = pk_bf16(a[i][2], a[i][3]); w.z = pk_bf16(b[i][0], b[i][1]); w.w = pk_bf16(b[i][2], b[i][3]);
                        *(u32x4*)(WSP(bf16_t, OFF_PB) + e) = w; }
                } else if (task < R11) {
                    const int zt = task - R10;
                    const long e = (zt < 56 ? (long)M_TOK : (long)16 * M_TOK - (long)56 * 4096) + ((long)zt * 512 + tid) * 8;
                    const f32x4 z = {0.f, 0.f, 0.f, 0.f};
                    *(f32x4*)(WSP(float, OFF_SS) + e) = z; *(f32x4*)(WSP(float, OFF_SS) + e + 4) = z;
                } else if (task < R12) {
                    const int id = (task - R11) * 512 + tid, m = id >> 4, i = id & 15;
                    const double ang = (double)P.pos[m] * (double)c_inv_freq[i];
                    double r = ang * 0.15915494309189535; r -= floor(r);
                    float* tab = WSP(float, OFF_TAB) + (long)m * 32;
                    tab[i] = __builtin_amdgcn_cosf((float)r); tab[16 + i] = __builtin_amdgcn_sinf((float)r);
                } else if (task < R13) {
                    const int g = (task - R12) >> 4, tau0 = ((task - R12) & 15) * 2;
                    float* wre = (float*)shm; float* wim = wre + 2048; float* cre = wim + 2048; float* cim = cre + 1024;
                    __syncthreads();
#pragma unroll
                    for (int i = 0; i < 4; ++i) { const int idx = i * 512 + tid, hi_ = idx & 15, p = (idx >> 4) & 63, tl_ = idx >> 10;
                        const S5Mode md = s5_mode(P, g, p); float zr, zi; s5_pow(md, (float)(tau0 + tl_), zr, zi);
                        const float br = P.b_re[(g * 64 + p) * 16 + hi_], bi = P.b_im[(g * 64 + p) * 16 + hi_];
                        const float bbr = md.cr * br - md.ci * bi, bbi = md.cr * bi + md.ci * br;
                        wre[idx] = zr * bbr - zi * bbi; wim[idx] = zr * bbi + zi * bbr; }
#pragma unroll
                    for (int i = 0; i < 2; ++i) { const int idx = i * 512 + tid; cre[idx] = P.c_re[g * 1024 + idx]; cim[idx] = P.c_im[g * 1024 + idx]; }
                    __syncthreads();
                    const int hi_ = tid & 15, ho = (tid >> 4) & 15, tl_ = tid >> 8;
                    float a = 0.f;
#pragma unroll 8
                    for (int p = 0; p < 64; ++p) a += cre[ho * 64 + p] * wre[(tl_ * 64 + p) * 16 + hi_] - cim[ho * 64 + p] * wim[(tl_ * 64 + p) * 16 + hi_];
                    if (tau0 + tl_ == 0 && ho == hi_) a += P.ssm_d[g * 16 + ho];
                    WSP(float, OFF_KTAB)[((g * 32 + tau0 + tl_) * 16 + ho) * 16 + hi_] = a;
                    __syncthreads();
                } else if (task < R14) {
                    const int id = (task - R13) * 512 + tid, s = id & 31, j = (id >> 5) & 127, g = id >> 12, p = j & 63;
                    const S5Mode md = s5_mode(P, g, p); float zr, zi; s5_pow(md, (float)(31 - s), zr, zi);
                    float br[16], bi[16];
#pragma unroll
                    for (int q = 0; q < 4; ++q) { const f32x4 a = *(const f32x4*)(P.b_re + (g * 64 + p) * 16 + q * 4), b = *(const f32x4*)(P.b_im + (g * 64 + p) * 16 + q * 4);
#pragma unroll
                        for (int e = 0; e < 4; ++e) { br[q * 4 + e] = a[e]; bi[q * 4 + e] = b[e]; } }
                    float o[16];
#pragma unroll
                    for (int h = 0; h < 16; ++h) { const float bbr = md.cr * br[h] - md.ci * bi[h], bbi = md.cr * bi[h] + md.ci * br[h]; o[h] = j < 64 ? (zr * bbr - zi * bbi) : (zr * bbi + zi * bbr); }
                    bf16_t* dst = WSP(bf16_t, OFF_PM) + ((long)g * 128 + j) * 512 + s * 16;
                    u32x4 w0, w1; w0.x = pk_bf16(o[0], o[1]); w0.y = pk_bf16(o[2], o[3]); w0.z = pk_bf16(o[4], o[5]); w0.w = pk_bf16(o[6], o[7]);
                    w1.x = pk_bf16(o[8], o[9]); w1.y = pk_bf16(o[10], o[11]); w1.z = pk_bf16(o[12], o[13]); w1.w = pk_bf16(o[14], o[15]);
                    *(u32x4*)dst = w0; *(u32x4*)(dst + 8) = w1;
                } else if (task < R15) {
                    const int id = (task - R14) * 512 + tid, p = id & 63, t = (id >> 6) & 31, g = id >> 11;
                    const S5Mode md = s5_mode(P, g, p); float zr, zi; s5_pow(md, (float)(t + 1), zr, zi);
                    bf16_t* dst = WSP(bf16_t, OFF_MQ) + ((long)g * 512 + t * 16) * 640 + 512 + p;
#pragma unroll
                    for (int ho = 0; ho < 16; ++ho) { const float cr = P.c_re[(g * 16 + ho) * 64 + p], ci = P.c_im[(g * 16 + ho) * 64 + p];
                        dst[(long)ho * 640] = (bf16_t)(pk_bf16(cr * zr - ci * zi, 0.f) & 0xffff); dst[(long)ho * 640 + 64] = (bf16_t)(pk_bf16(-(cr * zi + ci * zr), 0.f) & 0xffff); }
                } else {
                    for (int e = tid; e < 96 * 1024 / 8; e += 512) { const u32x4 z = {0u, 0u, 0u, 0u}; *(u32x4*)(WSP(bf16_t, OFF_WIN) + (long)1184 * 1024 + (long)e * 8) = z; }
                }
            }
        } else if (ph == 4) {
            for (int task = cb; task < 2048; task += G) {
                const int id = task * 512 + tid, c8 = id & 63, rowq = (id >> 6) & 511, g = id >> 15;
                const int t = rowq >> 4, ho = rowq & 15, s = c8 >> 1, hi0 = (c8 & 1) * 8;
                u32x4 w = {0u, 0u, 0u, 0u};
                if (s <= t) { const float* kt = WSP(float, OFF_KTAB) + (((long)g * 32 + (t - s)) * 16 + ho) * 16 + hi0;
                    const f32x4 a = *(const f32x4*)kt, b = *(const f32x4*)(kt + 4);
                    w.x = pk_bf16(a[0], a[1]); w.y = pk_bf16(a[2], a[3]); w.z = pk_bf16(b[0], b[1]); w.w = pk_bf16(b[2], b[3]); }
                *(u32x4*)(WSP(bf16_t, OFF_MQ) + ((long)g * 512 + rowq) * 640 + c8 * 8) = w;
            }
        } else if (ph == 6) {
            for (int it = cb; it < 1024; it += G) {
                const int r = (it >> 6) & 3, j = it >> 8, bh = it & 63;
                const int qb = (j & 1) ? (15 - 4 * j - (3 - r)) : (15 - 4 * j - r);
                attn_item(P, bh, qb);
            }
        }
        switch (ph) {
            case 1: stream_gemm<E_SWIGLU>(P, WSP(bf16_t, OFF_HB), WSP(bf16_t, OFF_W1), 5632, 1024, 0); break;
            case 9: stream_gemm<E_SWIGLU>(P, WSP(bf16_t, OFF_HB), WSP(bf16_t, OFF_W2), 5632, 1024, 1); break;
            case 2: stream_gemm<E_DOWN>(P, WSP(bf16_t, OFF_ACT), WSP(bf16_t, OFF_WD1), 1024, 2816, 0); break;
            case 10: stream_gemm<E_DOWN>(P, WSP(bf16_t, OFF_ACT), WSP(bf16_t, OFF_WD2), 1024, 2816, 1); break;
            case 3: stream_gemm<E_WIN>(P, WSP(bf16_t, OFF_HB), WSP(bf16_t, OFF_WIN), 1280, 1024, 0); break;
            case 7: stream_gemm<E_GLU>(P, (const bf16_t*)P.out + (long)M_TOK * 1024, WSP(bf16_t, OFF_WGLU), 512, 512, 0); break;
            case 11: stream_gemm<E_PLE>(P, WSP(bf16_t, OFF_HB), WSP(bf16_t, OFF_WPG), 1024, 1024, 0); break;
            default: break;
        }
        int ntiles = 0;
        switch (ph) {
            case 4: ntiles = 128 * 3 + 128 * 4 + 128; break;
            case 6: ntiles = 256; break;
            case 8: ntiles = 128 * 4; break;
            case 3: ntiles = 128 * 4; break;
            default: break;
        }
        struct TD { const char *Ap, *Bp, *Ap2, *Bp2; int lda, ldb, nt, nt2, mode, aux, brow, bcol; };
        auto make_td = [&](int L) -> TD {
            const bf16_t *A = nullptr, *Bt = nullptr, *A2p = nullptr, *B2p = nullptr; int lda = 0, ldb = 0, nt = 0, mode = 0, aux = 0, pm = 0, pn = 0, nt2 = 0;
            switch (ph) {
                case 4:
                    if (L < 384) { tile_map(L, 128, 3, pm, pn); A = WSP(bf16_t, OFF_CQB); lda = 384; Bt = WSP(bf16_t, OFF_WUQ); ldb = 384; nt = 6; mode = E_QRAW; }
                    else if (L < 896) { tile_map(L - 384, 128, 4, pm, pn); A = WSP(bf16_t, OFF_CKVB); lda = 256; Bt = WSP(bf16_t, OFF_WUKV); ldb = 256; nt = 4; mode = E_KVRAW; }
                    else { const int tl = L - 896; aux = tl >> 2; pm = tl & 3; pn = 0; A = WSP(bf16_t, OFF_A2) + (long)aux * 1024 * 640; lda = 640; Bt = WSP(bf16_t, OFF_PM) + (long)aux * 128 * 512; ldb = 512; nt = 8; mode = E_S5E; }
                    break;
                case 6: { aux = L >> 3; pm = (L & 7) >> 1; pn = L & 1; A = WSP(bf16_t, OFF_A2) + (long)aux * 1024 * 640; lda = 640; Bt = WSP(bf16_t, OFF_MQ) + (long)aux * 512 * 640; ldb = 640; nt = 10; mode = E_S5Y; } break;
                case 8: tile_map(L, 128, 4, pm, pn); A = (const bf16_t*)P.out; lda = 1024; Bt = WSP(bf16_t, OFF_WOUT); ldb = 1024; nt = 8; nt2 = 8; A2p = A + 512; B2p = Bt + 512; mode = E_WOUT; break;
                case 3: { tile_map(L, 128, 4, pm, pn); A = WSP(bf16_t, OFF_PB); lda = 256; Bt = WSP(bf16_t, OFF_WPP); ldb = 256; nt = 4; mode = E_PP; } break;
                default: break;
            }
            TD d; d.lda = lda; d.ldb = ldb; d.nt = nt; d.nt2 = nt2; d.mode = mode; d.aux = aux; d.brow = pm * BM; d.bcol = pn * BM;
            d.Ap = (const char*)(A + (long)d.brow * lda); d.Bp = (const char*)(Bt + (long)d.bcol * ldb);
            d.Ap2 = nt2 ? (const char*)(A2p + (long)d.brow * lda) : d.Ap; d.Bp2 = nt2 ? (const char*)(B2p + (long)d.bcol * ldb) : d.Bp;
            return d;
        };
        TD cur{}; bool pre = false;
        int L0 = cb, Lstep = G;
        if (ph == 3) { Lstep = G / 2; if (cb >= G / 2) { L0 = cb - G / 2; ntiles = 3 * (G / 2) < ntiles ? 3 * (G / 2) : ntiles; } else L0 = 3 * (G / 2) + cb; }
        if (L0 < ntiles) cur = make_td(L0);
        for (int L = L0; L < ntiles; L += Lstep) {
            const int lda = cur.lda, ldb = cur.ldb, nt = cur.nt, nt2 = cur.nt2, mode = cur.mode, aux = cur.aux;
            const int brow = cur.brow, bcol = cur.bcol;
            f32x4 acc[2][2][4][2];
#pragma unroll
            for (int a = 0; a < 2; ++a)
#pragma unroll
                for (int b = 0; b < 2; ++b)
#pragma unroll
                    for (int m = 0; m < 4; ++m)
#pragma unroll
                        for (int n = 0; n < 2; ++n) acc[a][b][m][n] = (f32x4){0.f, 0.f, 0.f, 0.f};
            const char* Ap = cur.Ap; const char* Bp = cur.Bp; int ntc = nt;
            for (int part = 0; part < (nt2 ? 2 : 1); ++part) {
                gemm_loop(acc, Ap, lda, Bp, ldb, ntc, pre && part == 0);
                if (nt2 && part == 0) {
                    int tid_ = threadIdx.x; asm volatile("" : "+v"(tid_));
                    const int wid = tid_ >> 6, lane = tid_ & 63, wr = wid >> 2, fr = lane & 15;
                    const float* ss = WSP(float, OFF_SS);
#pragma unroll
                    for (int a = 0; a < 2; ++a)
#pragma unroll
                        for (int m = 0; m < 4; ++m) {
                            const int row = brow + a * HALF + wr * 64 + m * 16 + fr;
                            const float ratio = rsqrtf(ss[6 * M_TOK + row] * (1.f / 512.f) + EPS) / rsqrtf(ss[7 * M_TOK + row] * (1.f / 512.f) + EPS);
#pragma unroll
                            for (int b = 0; b < 2; ++b)
#pragma unroll
                                for (int n = 0; n < 2; ++n) acc[a][b][m][n] *= ratio;
                        }
                    Ap = cur.Ap2; Bp = cur.Bp2; ntc = nt2;
                }
            }
            TD nxt = cur; pre = false;
            if (L + Lstep < ntiles) { nxt = make_td(L + Lstep); gemm_pre(nxt.Ap, nxt.lda, nxt.Bp, nxt.ldb); pre = true; }
            switch (mode) {
                case E_SWIGLU: epilogue<E_SWIGLU>(acc, P, brow, bcol, aux); break;
                case E_DOWN: epilogue<E_DOWN>(acc, P, brow, bcol, aux); break;
                case E_WIN: epilogue<E_WIN>(acc, P, brow, bcol, aux); break;
                case E_QRAW: epilogue<E_QRAW>(acc, P, brow, bcol, aux); break;
                case E_KVRAW: epilogue_kv(acc, P, brow, bcol); break;
                case E_S5E: epilogue<E_S5E>(acc, P, brow, bcol, aux);
                    __syncthreads();
                    s5_scan_task(P, aux, 2 * (brow >> 8), (float*)((char*)shm + 32768)); s5_scan_task(P, aux, 2 * (brow >> 8) + 1, (float*)((char*)shm + 32768));
                    break;
                case E_S5Y: epilogue<E_S5Y>(acc, P, brow, bcol, aux); break;
                case E_GLU: epilogue<E_GLU>(acc, P, brow, bcol, aux); break;
                case E_WOUT: epilogue<E_WOUT>(acc, P, brow, bcol, aux); break;
                case E_PP: epilogue<E_PP>(acc, P, brow, bcol, aux); break;
                default: epilogue<E_PLE>(acc, P, brow, bcol, aux); break;
            }
            cur = nxt;
        }
    }
}

extern "C" void kernel_launch(void* const* d_in, const int* in_sizes, int n_in, void* d_out, int out_size, void* d_ws, size_t ws_size, hipStream_t stream) {
    static int grid = 0;
    if (grid == 0) {
        if (n_in != 35 || ws_size < OFF_BAR + 16384 || out_size != M_TOK * DM) { fprintf(stderr, "kernel_launch: unexpected problem (n_in %d, ws %zu need %zu, out %d)\n", n_in, ws_size, (size_t)WS_END, out_size); grid = -1; return; }
        int dev = 0, cus = 0, per_cu = 0;
        hipGetDevice(&dev); hipDeviceGetAttribute(&cus, hipDeviceAttributeMultiprocessorCount, dev);
        if (hipFuncSetAttribute((const void*)mega, hipFuncAttributeMaxDynamicSharedMemorySize, SHM_B) != hipSuccess) { fprintf(stderr, "kernel_launch: hipFuncSetAttribute failed\n"); grid = -1; return; }
        if (hipOccupancyMaxActiveBlocksPerMultiprocessor(&per_cu, (const void*)mega, 512, SHM_B) != hipSuccess || per_cu < 1) { fprintf(stderr, "kernel_launch: occupancy query failed (%d)\n", per_cu); (void)hipGetLastError(); per_cu = 1; }
        grid = cus * per_cu;
        if (grid > 256) grid = 256;
        grid &= ~7;
    }
    if (grid <= 0) return;
    Params P{};
    const float** fp = (const float**)&P.norm_ffn1;
    P.x = (const float*)d_in[0]; P.p = (const float*)d_in[1]; P.pos = (const int*)d_in[2];
    for (int i = 3; i < 35; ++i) fp[i - 3] = (const float*)d_in[i];
    P.out = (float*)d_out; P.ws = (char*)d_ws;
#if MK_MULTI
    for (int ph = 0; ph < 12; ++ph) { P.ph_lo = ph; P.ph_hi = ph + 1; hipLaunchKernelGGL(mega, dim3(grid), dim3(512), SHM_B, stream, P); }
#else
    P.ph_lo = 0; P.ph_hi = 12;
    (void)hipMemsetAsync((char*)d_ws + OFF_BAR, 0, 16384, stream);
    void* args[] = {&P};
    hipError_t e = hipLaunchCooperativeKernel((void*)mega, dim3(grid), dim3(512), args, SHM_B, stream);
    if (e != hipSuccess) fprintf(stderr, "cooperative launch failed: %s (grid %d)\n", hipGetErrorString(e), grid);
#endif
}
```
